# Optimizing an MI355X kernel written in HIP

```python
import jax, jax.numpy as jnp
from jax import lax
import numpy as np

D_MODEL = 1024
BATCH = 4
SEQ = 4096
DEPTH = 4

N_Q_A = 8
N_KV_A = 2
HEAD_DIM_A = 64
W_A = N_Q_A * HEAD_DIM_A
W_KV_A = N_KV_A * HEAD_DIM_A
WINDOW = 128
BLOCK = 128
N_HEADS_B = 4
HEAD_DIM_B = 128
W_B = N_HEADS_B * HEAD_DIM_B
N_HEADS_C = 4
DK_C = 128
DV_C = 256
WK_C = N_HEADS_C * DK_C
WV_C = N_HEADS_C * DV_C
GATE_RANK = 16
GATE_TEMP = 16.0
N_MEM = 256
N_HEADS_M = 4
HEAD_DIM_M = 128
W_M = N_HEADS_M * HEAD_DIM_M

CHUNK = 16
EPS = 1e-6
MASK_VALUE = -1e30
MIN_GATE = 1e-30
N_EVEN = (DEPTH + 1) // 2
N_ODD = DEPTH // 2
EVEN_SIZES = (W_A, W_KV_A, W_KV_A, W_A, W_B, W_B, W_B, W_B, W_B, W_M, W_M)
ODD_SIZES = (WK_C, WK_C, WV_C, WV_C, GATE_RANK, GATE_RANK, W_M, W_M)
EVEN_IN = sum(EVEN_SIZES)
ODD_IN = sum(ODD_SIZES)
MIX_EVEN = W_A + W_B + W_M
MIX_ODD = WV_C + W_M

kernel_name = "hybrid_bidir_swa_hgrn2_gla_mem"


def rmsnorm(x, g):
    xf = x.astype(jnp.float32)
    y = xf * lax.rsqrt(jnp.mean(xf * xf, axis=-1, keepdims=True) + EPS)
    return (y * g.astype(jnp.float32)).astype(x.dtype)


def split_cols(t, sizes):
    return jnp.split(t, [int(s) for s in np.cumsum(sizes)[:-1]], axis=-1)


def split_heads(t, n_heads):
    B, T, W = t.shape
    return t.reshape(B, T, n_heads, W // n_heads).transpose(0, 2, 1, 3)


def merge_heads(t):
    B, H, T, d = t.shape
    return t.transpose(0, 2, 1, 3).reshape(B, T, H * d)


def group_rmsnorm(o, g, n_heads):
    B, T, W = o.shape
    y = rmsnorm(o.reshape(B, T, n_heads, W // n_heads), g.reshape(n_heads, W // n_heads))
    return y.reshape(B, T, W)


def alibi_slopes(n):
    return 2.0 ** (-8.0 * jnp.arange(1, n + 1, dtype=jnp.float32) / n)


def window_attention(q, k, v, sink):
    f32 = jnp.float32
    B, Hq, T, d = q.shape
    Hkv = k.shape[1]
    G = Hq // Hkv
    nb = T // BLOCK

    def key_blocks(t):
        tp = jnp.pad(t.astype(f32), ((0, 0), (0, 0), (BLOCK, BLOCK), (0, 0)))
        tp = tp.reshape(B, Hkv, nb + 2, BLOCK, d)
        return jnp.concatenate([tp[:, :, :-2], tp[:, :, 1:-1], tp[:, :, 2:]], axis=3)

    kb, vb = key_blocks(k), key_blocks(v)
    qb = q.astype(f32).reshape(B, Hkv, G, nb, BLOCK, d)
    s = jnp.einsum('bngcid,bncjd->bngcij', qb, kb) * (d ** -0.5)
    i = jnp.arange(BLOCK)[:, None]
    j = jnp.arange(3 * BLOCK)[None, :]
    dist = jnp.abs(i - j + BLOCK).astype(f32)
    kpos = (jnp.arange(nb)[:, None, None] - 1) * BLOCK + j[None]
    valid = (dist <= WINDOW)[None] & (kpos >= 0) & (kpos < T)
    slopes = alibi_slopes(Hq).reshape(Hkv, G, 1, 1, 1)
    s = jnp.where(valid, s - slopes * dist, MASK_VALUE)
    sk = sink.astype(f32).reshape(Hkv, G, 1, 1, 1)
    m = jnp.maximum(jnp.max(s, axis=-1, keepdims=True), sk)
    p = jnp.where(valid, jnp.exp(s - m), 0.0)
    denom = jnp.sum(p, axis=-1, keepdims=True) + jnp.exp(sk - m)
    o = jnp.einsum('bngcij,bncjd->bngcid', p, vb) / denom
    return o.reshape(B, Hq, T, d)


def chunked_gated_scan(q, k, v, log_f):
    f32 = jnp.float32
    B, H, T, dk = q.shape
    dv = v.shape[-1]
    n = T // CHUNK

    def to_chunks(t):
        return t.astype(f32).reshape(B, H, n, CHUNK, t.shape[-1]).transpose(2, 0, 1, 3, 4)

    qc, kc, vc, gc = to_chunks(q), to_chunks(k), to_chunks(v), to_chunks(log_f)
    lower = jnp.tril(jnp.ones((CHUNK, CHUNK), dtype=bool))[:, :, None]

    def step(S, inp):
        qi, ki, vi, gi = inp
        b = jnp.cumsum(gi, axis=-2)
        b_last = b[:, :, -1:, :]
        o_inter = jnp.einsum('bhtk,bhkv->bhtv', qi * jnp.exp(b), S)
        diff = b[:, :, :, None, :] - b[:, :, None, :, :]
        decay = jnp.where(lower, jnp.exp(jnp.where(lower, diff, 0.0)), 0.0)
        A = jnp.einsum('bhtk,bhtsk,bhsk->bhts', qi, decay, ki)
        o_intra = jnp.einsum('bhts,bhsv->bhtv', A, vi)
        S_new = jnp.exp(b_last)[:, :, 0, :, None] * S + jnp.einsum(
            'bhsk,bhsv->bhkv', ki * jnp.exp(b_last - b), vi)
        return S_new, o_inter + o_intra

    S0 = jnp.zeros((B, H, dk, dv), f32)
    _, oc = lax.scan(step, S0, (qc, kc, vc, gc))
    return oc.transpose(1, 2, 0, 3, 4).reshape(B, H, T, dv)


def bidir_scan(q, k_fwd, k_bwd, v, lf_fwd, lf_bwd):
    flip = lambda t: jnp.flip(t, axis=2)
    fwd = chunked_gated_scan(q, k_fwd, v, lf_fwd)
    bwd = flip(chunked_gated_scan(flip(q), flip(k_bwd), flip(v), flip(lf_bwd)))
    return fwd + bwd


def hgrn_forget(z, lb):
    zf = z.astype(jnp.float32)
    f = lb + (1.0 - lb) * jax.nn.sigmoid(zf)
    log_f = jnp.log(jnp.maximum(f, MIN_GATE))
    k = (1.0 - lb) * jax.nn.sigmoid(-zf)
    return log_f, k


def memory_attention(q, mem_n, w_kv):
    f32 = jnp.float32
    k, v = jnp.split(mem_n @ w_kv, 2, axis=-1)
    qh = split_heads(q, N_HEADS_M).astype(f32)
    kh = split_heads(k, N_HEADS_M).astype(f32)
    vh = split_heads(v, N_HEADS_M).astype(f32)
    p = jax.nn.softmax(jnp.einsum('bhtd,bhsd->bhts', qh, kh) * (HEAD_DIM_M ** -0.5), axis=-1)
    return merge_heads(jnp.einsum('bhts,bhsd->bhtd', p, vh)).astype(q.dtype)


def even_layer(x, g_norm, w_in, sink, lb, hgrn_g, w_out, mem_n, w_kv):
    h = rmsnorm(x, g_norm)
    qA, kA, vA, gA, qB, zBf, zBb, iB, gB, qM, gM = split_cols(h @ w_in, EVEN_SIZES)
    a = window_attention(split_heads(qA, N_Q_A), split_heads(kA, N_KV_A),
                         split_heads(vA, N_KV_A), sink)
    a = merge_heads(a).astype(x.dtype) * jax.nn.silu(gA)
    lf_f, k_f = hgrn_forget(zBf, lb[0])
    lf_b, k_b = hgrn_forget(zBb, lb[1])
    sh = lambda t: split_heads(t, N_HEADS_B)
    o = bidir_scan(sh(jax.nn.silu(qB)), sh(k_f), sh(k_b), sh(iB), sh(lf_f), sh(lf_b))
    o = group_rmsnorm(merge_heads(o).astype(x.dtype), hgrn_g, N_HEADS_B) * jax.nn.silu(gB)
    mo = memory_attention(qM, mem_n, w_kv) * jax.nn.silu(gM)
    return jnp.concatenate([a, o, mo], axis=-1) @ w_out


def odd_layer(x, g_norm, w_in, w_up, b_gate, gla_g, w_out, mem_n, w_kv):
    h = rmsnorm(x, g_norm)
    qC, kC, vC, gC, rf, rb, qM, gM = split_cols(h @ w_in, ODD_SIZES)
    lf_f = jax.nn.log_sigmoid((rf @ w_up[0] + b_gate[0]).astype(jnp.float32)) / GATE_TEMP
    lf_b = jax.nn.log_sigmoid((rb @ w_up[1] + b_gate[1]).astype(jnp.float32)) / GATE_TEMP
    sh = lambda t: split_heads(t, N_HEADS_C)
    kh = sh(kC)
    o = bidir_scan(sh(qC * (DK_C ** -0.5)), kh, kh, sh(vC), sh(lf_f), sh(lf_b))
    o = group_rmsnorm(merge_heads(o).astype(x.dtype), gla_g, N_HEADS_C) * jax.nn.silu(gC)
    mo = memory_attention(qM, mem_n, w_kv) * jax.nn.silu(gM)
    return jnp.concatenate([o, mo], axis=-1) @ w_out


def setup_inputs(seed: int = 0) -> dict:
    key = jax.random.key(seed)
    ks = jax.random.split(key, 18)
    nrm = lambda k, shape, scale: jax.random.normal(k, shape, jnp.float32) * scale
    return {
        "x": nrm(ks[0], (BATCH, SEQ, D_MODEL), 1.0),
        "mem": nrm(ks[1], (BATCH, N_MEM, D_MODEL), 1.0),
        "norm_even": 1.0 + nrm(ks[2], (N_EVEN, D_MODEL), 0.02),
        "w_in_even": nrm(ks[3], (N_EVEN, D_MODEL, EVEN_IN), D_MODEL ** -0.5),
        "sink": nrm(ks[4], (N_EVEN, N_Q_A), 0.5),
        "lb_param": nrm(ks[5], (N_EVEN, 2, W_B), 0.5),
        "hgrn_norm": 1.0 + nrm(ks[6], (N_EVEN, W_B), 0.02),
        "w_out_even": nrm(ks[7], (N_EVEN, MIX_EVEN, D_MODEL), MIX_EVEN ** -0.5),
        "norm_odd": 1.0 + nrm(ks[8], (N_ODD, D_MODEL), 0.02),
        "w_in_odd": nrm(ks[9], (N_ODD, D_MODEL, ODD_IN), D_MODEL ** -0.5),
        "w_gate_up": nrm(ks[10], (N_ODD, 2, GATE_RANK, WK_C), GATE_RANK ** -0.5),
        "b_gate": nrm(ks[11], (N_ODD, 2, WK_C), 0.1),
        "gla_norm": 1.0 + nrm(ks[12], (N_ODD, WV_C), 0.02),
        "w_out_odd": nrm(ks[13], (N_ODD, MIX_ODD, D_MODEL), MIX_ODD ** -0.5),
        "mem_norm": 1.0 + nrm(ks[14], (D_MODEL,), 0.02),
        "w_mem_kv": nrm(ks[15], (DEPTH, D_MODEL, 2 * W_M), D_MODEL ** -0.5),
        "final_norm": 1.0 + nrm(ks[16], (D_MODEL,), 0.02),
    }


def reference(x, mem, norm_even, w_in_even, sink, lb_param, hgrn_norm, w_out_even,
              norm_odd, w_in_odd, w_gate_up, b_gate, gla_norm, w_out_odd,
              mem_norm, w_mem_kv, final_norm):
    mem_n = rmsnorm(mem, mem_norm)
    lbs = jax.nn.softmax(lb_param.astype(jnp.float32), axis=0)
    lower = jnp.cumsum(lbs, axis=0) - lbs[0]
    for l in range(DEPTH):
        i = l // 2
        if l % 2 == 0:
            x = x + even_layer(x, norm_even[i], w_in_even[i], sink[i], lower[i],
                               hgrn_norm[i], w_out_even[i], mem_n, w_mem_kv[l])
        else:
            x = x + odd_layer(x, norm_odd[i], w_in_odd[i], w_gate_up[i], b_gate[i],
                              gla_norm[i], w_out_odd[i], mem_n, w_mem_kv[l])
    return rmsnorm(x, final_norm)
```

```cpp
#include <hip/hip_runtime.h>
#include <cstdio>
#include <cstdint>

#ifndef TEST_MASK
#define TEST_MASK 0xFFFF
#endif
#ifndef MK_ONE_LAUNCH
#define MK_ONE_LAUNCH 0
#endif

#define GAS __attribute__((address_space(1)))
#define LAS __attribute__((address_space(3)))
typedef unsigned short bf16;
typedef unsigned v4u __attribute__((ext_vector_type(4)));
typedef float f32x4 __attribute__((ext_vector_type(4)));
typedef GAS unsigned gu32;
#define RLX_AGENT __ATOMIC_RELAXED, __HIP_MEMORY_SCOPE_AGENT
#define LDS_WAIT() asm volatile("s_waitcnt lgkmcnt(0)" ::: "memory")
#define VM_WAIT() asm volatile("s_waitcnt vmcnt(0)" ::: "memory")

constexpr int NWAVES = 8, NTHR = 512;
constexpr int BATCH = 4, T = 4096, D = 1024, M = BATCH * T, DEPTH = 4;
constexpr int NMEM = 256;
constexpr int NP_E = 3328, NP_O = 2816, NMIX = 1536, NIN_E = 4864, NIN_O = 4352, NIN_O_SRC = 4128;
constexpr int E_QA = 0, E_KA = 512, E_VA = 640, E_QB = 768, E_ZF = 1280, E_ZB = 1792, E_IB = 2304, E_QM = 2816;
constexpr int O_QC = 0, O_KC = 512, O_VC = 1024, O_QM = 2048, O_RF = 2560, O_RB = 2576;
constexpr int X_GA = 0, X_GB = 512, X_GM = 1024, X_GC = 0;
constexpr float EPS = 1e-6f;

constexpr size_t MiB = 1u << 20;
constexpr size_t WS_CTL = 0, CTL_ZERO_BYTES = 1 * MiB;
constexpr size_t WS_WIN = 2 * MiB;
constexpr size_t WS_WOUT = 12 * MiB;
constexpr size_t WS_WKV = 24 * MiB;
constexpr size_t WS_MEMK = 32 * MiB;
constexpr size_t WS_MEMVT = 36 * MiB;
constexpr size_t WS_MEMN = 40 * MiB;
constexpr size_t WS_MIX = 43 * MiB;
constexpr size_t WS_P = 91 * MiB;
constexpr size_t WS_HN = 195 * MiB;
constexpr size_t WS_OE = 195 * MiB;
constexpr size_t WS_OO = 192 * MiB;
constexpr size_t WS_END = 256 * MiB;

constexpr int CW_BAR = 4096;

__device__ __forceinline__ float bf2f(bf16 v) { return __uint_as_float(((unsigned)v) << 16); }
__device__ __forceinline__ unsigned f2bf(float f) { unsigned u = __float_as_uint(f); return (u + 0x7fffu + ((u >> 16) & 1u)) >> 16; }
__device__ __forceinline__ unsigned pk2(float lo, float hi) { return f2bf(lo) | (f2bf(hi) << 16); }
__device__ __forceinline__ float wave_sum(float v) {
#pragma unroll
    for (int o = 1; o < 64; o <<= 1) v += __shfl_xor(v, o);
    return v;
}
__device__ __forceinline__ float wave_max(float v) {
#pragma unroll
    for (int o = 1; o < 64; o <<= 1) v = fmaxf(v, __shfl_xor(v, o));
    return v;
}
__device__ __forceinline__ float sigmoidf_(float z) { return 1.f / (1.f + __expf(-z)); }
__device__ __forceinline__ float siluf_(float z) { return z / (1.f + __expf(-z)); }

#define XB_TMO      128
#define XB_XCNT(j)  (256  + 64 * (j))
#define XB_XSUB(j)  (1280 + 64 * (j))
#define XB_XGEN(j)  (2304 + 64 * (j))
#define XB_TOP      3328
#define XB_TOPGEN   3392
#define XCD_BAR_WORDS 3456
#define XB_SPIN_CAP (1u << 22)
__device__ __forceinline__ unsigned xb_ld(unsigned* p)              { return __hip_atomic_load(p, __ATOMIC_RELAXED, __HIP_MEMORY_SCOPE_AGENT); }
__device__ __forceinline__ unsigned xb_add(unsigned* p, unsigned v) { return __hip_atomic_fetch_add(p, v, __ATOMIC_RELAXED, __HIP_MEMORY_SCOPE_AGENT); }
__device__ __forceinline__ unsigned xb_xcc_id() { return (unsigned)__builtin_amdgcn_s_getreg((3 << 11) | 20) & 0xFu; }
#define XB_SPIN(cond, bar) do { unsigned _sp = 0; while (cond) { __builtin_amdgcn_s_sleep(1); \
    if ((++_sp & 255u) == 0u) { if (xb_ld(&(bar)[XB_TMO])) break; if (_sp > XB_SPIN_CAP) { atomicAdd(&(bar)[XB_TMO], 1u); break; } } } } while (0)
struct XcdBarrier { unsigned* bar; unsigned x; volatile LAS unsigned* st; };
__device__ __forceinline__ XcdBarrier xcd_barrier_post(unsigned* bar, volatile LAS unsigned* st) {
    XcdBarrier b; b.bar = bar; b.x = xb_xcc_id(); b.st = st;
    if (threadIdx.x == 0) (void)xb_add(&bar[XB_XCNT(b.x)], 1u);
    return b;
}
__device__ __forceinline__ void xcd_barrier_complete(unsigned* bar, unsigned x, unsigned& nloc, unsigned& nx) {
    const unsigned G = gridDim.x * gridDim.y * gridDim.z;
    unsigned sum, cnt, mine, sp = 0u;
    for (;;) {
        sum = 0u; cnt = 0u; mine = 0u;
#pragma unroll
        for (unsigned j = 0; j < 16; ++j) { const unsigned c = xb_ld(&bar[XB_XCNT(j)]); sum += c; cnt += (c > 0u) ? 1u : 0u; mine = (j == x) ? c : mine; }
        if (sum == G) break;
        __builtin_amdgcn_s_sleep(1);
        if ((++sp & 255u) == 0u) { if (xb_ld(&bar[XB_TMO])) break; if (sp > XB_SPIN_CAP) { atomicAdd(&bar[XB_TMO], 1u); break; } }
    }
    nloc = mine > 0u ? mine : 1u; nx = cnt > 0u ? cnt : 1u;
}
__device__ __forceinline__ void xcd_barrier(const XcdBarrier& b) {
    asm volatile("s_waitcnt vmcnt(0)" ::: "memory");
    __syncthreads();
    if (threadIdx.x == 0) {
        unsigned* bar = b.bar;
        __builtin_amdgcn_s_waitcnt(0);
        unsigned nloc = b.st[0], nx = b.st[1];
        if (nloc == 0u) { xcd_barrier_complete(bar, b.x, nloc, nx); b.st[0] = nloc; b.st[1] = nx; }
        const unsigned old = xb_add(&bar[XB_XSUB(b.x)], 1u);
        const unsigned gen = old / nloc;
        if (old + 1u == (gen + 1u) * nloc) {
            __builtin_amdgcn_fence(__ATOMIC_RELEASE, "agent");
            asm volatile("s_waitcnt vmcnt(0)" ::: "memory");
            const unsigned og = xb_add(&bar[XB_TOP], 1u);
            const unsigned tg = og / nx;
            if (og + 1u == (tg + 1u) * nx) xb_add(&bar[XB_TOPGEN], 1u);
            else XB_SPIN(xb_ld(&bar[XB_TOPGEN]) == tg, bar);
            __builtin_amdgcn_fence(__ATOMIC_ACQUIRE, "agent");
            xb_add(&bar[XB_XGEN(b.x)], 1u);
            asm volatile("s_waitcnt vmcnt(0)" ::: "memory");
        } else {
            XB_SPIN(xb_ld(&bar[XB_XGEN(b.x)]) == gen, bar);
            __builtin_amdgcn_fence(__ATOMIC_ACQUIRE, "agent");
            asm volatile("s_waitcnt vmcnt(0)" ::: "memory");
        }
    }
    __syncthreads();
}

constexpr int RING_BYTES = 131072;
constexpr int MISC_OFF = RING_BYTES + 320;
constexpr int LDS_BYTES = 147456;

struct Args { const float* in[17]; float* out; unsigned char* ws; int ph_lo, ph_hi; };
static_assert(sizeof(Args) == 17 * 8 + 8 + 8 + 8, "Args has no padding");

struct Ctx {
    LAS unsigned char* lds;
    int tid, lane, wave, G, bid;
    float* out; unsigned char* ws;
};

__device__ __forceinline__ void transpose_item(const float* W, int K, int N, bf16* WT, int k0, int n0, int drow0, LAS float* scr, int lane) {
#pragma unroll 8
    for (int i = 0; i < 32; ++i) { const int kk = 2 * i + (lane >> 5); scr[kk * 33 + (lane & 31)] = W[(size_t)(k0 + kk) * N + n0 + (lane & 31)]; }
    LDS_WAIT(); asm volatile("" ::: "memory");
    const int c = lane & 7;
#pragma unroll
    for (int j = 0; j < 4; ++j) { const int n = (lane >> 3) + 8 * j; const LAS float* s = scr + (8 * c) * 33 + n;
        v4u o; o.x = pk2(s[0 * 33], s[1 * 33]); o.y = pk2(s[2 * 33], s[3 * 33]); o.z = pk2(s[4 * 33], s[5 * 33]); o.w = pk2(s[6 * 33], s[7 * 33]);
        *(GAS v4u*)(WT + (size_t)(drow0 + n) * K + k0 + 8 * c) = o; }
    LDS_WAIT(); asm volatile("" ::: "memory");
}
__device__ __forceinline__ int map_even(int n0) {
    if (n0 < 768) return n0;
    if (n0 < 1280) return NP_E + X_GA + (n0 - 768);
    if (n0 < 3328) return E_QB + (n0 - 1280);
    if (n0 < 3840) return NP_E + X_GB + (n0 - 3328);
    if (n0 < 4352) return E_QM + (n0 - 3840);
    return NP_E + X_GM + (n0 - 4352);
}
__device__ __forceinline__ int map_odd(int n0) {
    if (n0 < 2048) return n0;
    if (n0 < 3072) return NP_O + X_GC + (n0 - 2048);
    if (n0 < 3104) return O_RF + (n0 - 3072);
    if (n0 < 3616) return O_QM + (n0 - 3104);
    return NP_O + X_GM + (n0 - 3616);
}
__device__ __forceinline__ int win_items(int l) { return (l & 1) ? (16 * (NIN_O_SRC / 32) + 224) : (16 * (NIN_E / 32)); }
__device__ __forceinline__ void win_item(const Ctx& C, const float* w_even, const float* w_odd, int l, int it, LAS float* scr) {
    bf16* WT = (bf16*)(C.ws + WS_WIN);
    if (l & 1) {
        const int nconv = 16 * (NIN_O_SRC / 32);
        if (it < nconv) { const int nb = it % (NIN_O_SRC / 32), kb = it / (NIN_O_SRC / 32);
            transpose_item(w_odd + (size_t)(l >> 1) * D * NIN_O_SRC, D, NIN_O_SRC, WT, kb * 64, nb * 32, map_odd(nb * 32), scr, C.lane); }
        else { const int r = 2592 + (it - nconv);
            GAS v4u* p = (GAS v4u*)(WT + (size_t)r * D); v4u z = {0u, 0u, 0u, 0u}; p[C.lane] = z; p[C.lane + 64] = z; }
    } else {
        const int nb = it % (NIN_E / 32), kb = it / (NIN_E / 32);
        transpose_item(w_even + (size_t)(l >> 1) * D * NIN_E, D, NIN_E, WT, kb * 64, nb * 32, map_even(nb * 32), scr, C.lane);
    }
}
__device__ __forceinline__ void rms_row_to_bf16(const float* xrow, const float* g, bf16* orow, int lane) {
    const GAS f32x4* xr = (const GAS f32x4*)xrow + lane; const GAS f32x4* gr = (const GAS f32x4*)g + lane;
    f32x4 v[4]; float s = 0.f;
#pragma unroll
    for (int j = 0; j < 4; ++j) { v[j] = xr[64 * j]; s += (v[j].x * v[j].x + v[j].y * v[j].y) + (v[j].z * v[j].z + v[j].w * v[j].w); }
    const float rstd = 1.f / sqrtf(wave_sum(s) * (1.f / D) + EPS);
    GAS unsigned long long* o8 = (GAS unsigned long long*)orow + lane;
#pragma unroll
    for (int j = 0; j < 4; ++j) { const f32x4 gg = gr[64 * j];
        o8[64 * j] = (unsigned long long)pk2(v[j].x * rstd * gg.x, v[j].y * rstd * gg.y) | ((unsigned long long)pk2(v[j].z * rstd * gg.z, v[j].w * rstd * gg.w) << 32); }
}
__device__ __forceinline__ void rms_row_to_f32(const float* xrow, const float* g, float* orow, int lane) {
    const GAS f32x4* xr = (const GAS f32x4*)xrow + lane; const GAS f32x4* gr = (const GAS f32x4*)g + lane;
    f32x4 v[4]; float s = 0.f;
#pragma unroll
    for (int j = 0; j < 4; ++j) { v[j] = xr[64 * j]; s += (v[j].x * v[j].x + v[j].y * v[j].y) + (v[j].z * v[j].z + v[j].w * v[j].w); }
    const float rstd = 1.f / sqrtf(wave_sum(s) * (1.f / D) + EPS);
    GAS f32x4* o = (GAS f32x4*)orow + lane;
#pragma unroll
    for (int j = 0; j < 4; ++j) { const f32x4 gg = gr[64 * j]; o[64 * j] = v[j] * rstd * gg; }
}

__device__ __forceinline__ void phase_prep(const Ctx& C, const Args& A) {
    LAS float* scr = (LAS float*)(C.lds + C.wave * 16384);
    const int gw = C.bid * NWAVES + C.wave, NGW = C.G * NWAVES;
    constexpr int I_OUT = (1536 / 64) * (1024 / 32), I_KV = (1024 / 64) * (1024 / 32);
    const int I_IN = win_items(0);
    const int total = 4 * I_OUT + 4 * I_KV + I_IN + 1024 + M;
    for (int it = gw; it < total; it += NGW) {
        int r = it;
        if (r < 4 * I_OUT) { const int l = r / I_OUT; r -= l * I_OUT; const int nb = r % 32, kb = r / 32;
            const float* W = (l & 1) ? A.in[13] + (size_t)(l >> 1) * 1536 * 1024 : A.in[7] + (size_t)(l >> 1) * 1536 * 1024;
            transpose_item(W, 1536, 1024, (bf16*)(C.ws + WS_WOUT) + (size_t)l * 1024 * 1536, kb * 64, nb * 32, nb * 32, scr, C.lane); continue; }
        r -= 4 * I_OUT;
        if (r < 4 * I_KV) { const int l = r / I_KV; r -= l * I_KV; const int nb = r % 32, kb = r / 32;
            transpose_item(A.in[15] + (size_t)l * 1024 * 1024, 1024, 1024, (bf16*)(C.ws + WS_WKV) + (size_t)l * 1024 * 1024, kb * 64, nb * 32, nb * 32, scr, C.lane); continue; }
        r -= 4 * I_KV;
        if (r < I_IN) { win_item(C, A.in[3], A.in[9], 0, r, scr); continue; }
        r -= I_IN;
        if (r < 1024) { rms_row_to_bf16(A.in[1] + (size_t)r * D, A.in[14], (bf16*)(C.ws + WS_MEMN) + (size_t)r * D, C.lane); continue; }
        r -= 1024;
        rms_row_to_bf16(A.in[0] + (size_t)r * D, A.in[2], (bf16*)(C.ws + WS_HN) + (size_t)r * D, C.lane);
    }
}

template <class Epi>
__device__ __forceinline__ void gemm_naive(const Ctx& C, const bf16* A, int lda, const bf16* Bt, int ldb, int Mr, int Nr, int K, int tile0, int tstride, const Epi& E) {
    LAS float* As = (LAS float*)C.lds;
    LAS float* Bs = As + 32 * 132;
    const int tid = C.tid, ty = tid >> 4, tx = tid & 15;
    const int nMt = Mr / 128, nNt = Nr / 128, ntiles = nMt * nNt;
    for (int tile = tile0; tile < ntiles; tile += tstride) {
        const int tm = tile % nMt, tn = tile / nMt;
        float acc[4][8];
#pragma unroll
        for (int i = 0; i < 4; ++i)
#pragma unroll
            for (int j = 0; j < 8; ++j) acc[i][j] = 0.f;
        const int lr = tid >> 2, lk = (tid & 3) * 8;
        for (int k0 = 0; k0 < K; k0 += 32) {
            const v4u av = *(const GAS v4u*)(A + (size_t)(tm * 128 + lr) * lda + k0 + lk);
            const v4u bv = *(const GAS v4u*)(Bt + (size_t)(tn * 128 + lr) * ldb + k0 + lk);
            __syncthreads();
#pragma unroll
            for (int j = 0; j < 4; ++j) {
                As[(lk + 2 * j) * 132 + lr] = __uint_as_float(av[j] << 16); As[(lk + 2 * j + 1) * 132 + lr] = __uint_as_float(av[j] & 0xffff0000u);
                Bs[(lk + 2 * j) * 132 + lr] = __uint_as_float(bv[j] << 16); Bs[(lk + 2 * j + 1) * 132 + lr] = __uint_as_float(bv[j] & 0xffff0000u);
            }
            __syncthreads();
#pragma unroll 2
            for (int k = 0; k < 32; ++k) {
                const f32x4 a = *(const LAS f32x4*)(As + k * 132 + ty * 4);
                const f32x4 b0 = *(const LAS f32x4*)(Bs + k * 132 + tx * 8), b1 = *(const LAS f32x4*)(Bs + k * 132 + tx * 8 + 4);
#pragma unroll
                for (int i = 0; i < 4; ++i) {
                    acc[i][0] += a[i] * b0[0]; acc[i][1] += a[i] * b0[1]; acc[i][2] += a[i] * b0[2]; acc[i][3] += a[i] * b0[3];
                    acc[i][4] += a[i] * b1[0]; acc[i][5] += a[i] * b1[1]; acc[i][6] += a[i] * b1[2]; acc[i][7] += a[i] * b1[3];
                }
            }
        }
#pragma unroll
        for (int i = 0; i < 4; ++i) E(tm * 128 + ty * 4 + i, tn * 128 + tx * 8, acc[i]);
    }
    __syncthreads();
}
struct EpiStoreBf16 {
    bf16* O; int ldc;
    __device__ __forceinline__ void operator()(int m, int n0, const float (&v)[8]) const {
        v4u w; w.x = pk2(v[0], v[1]); w.y = pk2(v[2], v[3]); w.z = pk2(v[4], v[5]); w.w = pk2(v[6], v[7]);
        *(GAS v4u*)(O + (size_t)m * ldc + n0) = w; }
};
struct EpiInProj {
    bf16* P; bf16* MIX; int NP;
    __device__ __forceinline__ void operator()(int m, int n0, const float (&v)[8]) const {
        v4u w; w.x = pk2(v[0], v[1]); w.y = pk2(v[2], v[3]); w.z = pk2(v[4], v[5]); w.w = pk2(v[6], v[7]);
        if (n0 < NP) *(GAS v4u*)(P + (size_t)m * NP + n0) = w; else *(GAS v4u*)(MIX + (size_t)m * NMIX + (n0 - NP)) = w; }
};
struct EpiResid {
    const float* xi; float* xo;
    __device__ __forceinline__ void operator()(int m, int n0, const float (&v)[8]) const {
        const f32x4 a = *(const GAS f32x4*)(xi + (size_t)m * D + n0), b = *(const GAS f32x4*)(xi + (size_t)m * D + n0 + 4);
        f32x4 o0 = {a[0] + v[0], a[1] + v[1], a[2] + v[2], a[3] + v[3]}, o1 = {b[0] + v[4], b[1] + v[5], b[2] + v[6], b[3] + v[7]};
        *(GAS f32x4*)(xo + (size_t)m * D + n0) = o0; *(GAS f32x4*)(xo + (size_t)m * D + n0 + 4) = o1; }
};

__device__ __forceinline__ float dot8(const v4u w, const LAS float* q) {
    const f32x4 q0 = *(const LAS f32x4*)q, q1 = *(const LAS f32x4*)(q + 4);
    return (__uint_as_float(w[0] << 16) * q0[0] + __uint_as_float(w[0] & 0xffff0000u) * q0[1]) + (__uint_as_float(w[1] << 16) * q0[2] + __uint_as_float(w[1] & 0xffff0000u) * q0[3])
         + (__uint_as_float(w[2] << 16) * q1[0] + __uint_as_float(w[2] & 0xffff0000u) * q1[1]) + (__uint_as_float(w[3] << 16) * q1[2] + __uint_as_float(w[3] & 0xffff0000u) * q1[3]);
}
__device__ __forceinline__ void naive_winattn_item(const Ctx& C, const float* sink, int item, LAS float* pw) {
    const bf16* P = (const bf16*)(C.ws + WS_P); bf16* MIX = (bf16*)(C.ws + WS_MIX);
    const int lane = C.lane, hq = item & 7, m = item >> 3, t = m & (T - 1), b = m >> 12, n = hq >> 2;
    const float slope = exp2f(-(float)(hq + 1)), sk = sink[hq];
    LAS float* qs = pw + 320;
    qs[lane] = bf2f(P[(size_t)m * NP_E + E_QA + hq * 64 + lane]);
    LDS_WAIT(); asm volatile("" ::: "memory");
    float mx = -3e38f;
#pragma unroll 1
    for (int i = 0; i < 5; ++i) {
        const int j = lane + 64 * i, s = t - 128 + j; const bool valid = (j <= 256) && (s >= 0) && (s < T);
        float acc = -3e38f;
        if (valid) { const GAS v4u* kp = (const GAS v4u*)(P + (size_t)(b * T + s) * NP_E + E_KA + n * 64); acc = 0.f;
#pragma unroll
            for (int jj = 0; jj < 8; ++jj) acc += dot8(kp[jj], qs + 8 * jj);
            acc = acc * 0.125f - slope * fabsf((float)(t - s)); mx = fmaxf(mx, acc); }
        if (j <= 256) pw[j] = acc;
    }
    mx = fmaxf(wave_max(mx), sk);
    LDS_WAIT(); asm volatile("" ::: "memory");
    float sum = 0.f;
#pragma unroll 1
    for (int i = 0; i < 5; ++i) { const int j = lane + 64 * i; if (j <= 256) { const float sc = pw[j]; const float p = (sc > -1e38f) ? __expf(sc - mx) : 0.f; sum += p; pw[j] = p; } }
    sum = wave_sum(sum) + __expf(sk - mx);
    LDS_WAIT(); asm volatile("" ::: "memory");
    float o = 0.f;
    for (int j = 0; j <= 256; ++j) { const int s = t - 128 + j; if (s < 0 || s >= T) continue;
        o += pw[j] * bf2f(P[(size_t)(b * T + s) * NP_E + E_VA + n * 64 + lane]); }
    o /= sum;
    bf16* gp = MIX + (size_t)m * NMIX + X_GA + hq * 64 + lane;
    *gp = (bf16)f2bf(o * siluf_(bf2f(*gp)));
    LDS_WAIT(); asm volatile("" ::: "memory");
}
__device__ __forceinline__ void naive_memattn_item(const Ctx& C, int l, int item, LAS float* pw) {
    const int NP = (l & 1) ? NP_O : NP_E, QOFF = (l & 1) ? O_QM : E_QM;
    const bf16* P = (const bf16*)(C.ws + WS_P); bf16* MIX = (bf16*)(C.ws + WS_MIX);
    const bf16* MK = (const bf16*)(C.ws + WS_MEMK) + (size_t)l * 1024 * 512; const bf16* MVT = (const bf16*)(C.ws + WS_MEMVT) + (size_t)l * 512 * 1024;
    const int lane = C.lane, h = item & 3, m = item >> 2, b = m >> 12;
    LAS float* qs = pw + 320;
    qs[lane] = bf2f(P[(size_t)m * NP + QOFF + h * 128 + lane]); qs[lane + 64] = bf2f(P[(size_t)m * NP + QOFF + h * 128 + lane + 64]);
    LDS_WAIT(); asm volatile("" ::: "memory");
    float mx = -3e38f;
#pragma unroll 1
    for (int i = 0; i < 4; ++i) { const int s = lane + 64 * i;
        const GAS v4u* kp = (const GAS v4u*)(MK + (size_t)(b * NMEM + s) * 512 + h * 128); float acc = 0.f;
#pragma unroll
        for (int jj = 0; jj < 16; ++jj) acc += dot8(kp[jj], qs + 8 * jj);
        acc *= 0.08838834764831845f; mx = fmaxf(mx, acc); pw[s] = acc; }
    mx = wave_max(mx);
    LDS_WAIT(); asm volatile("" ::: "memory");
    float sum = 0.f;
#pragma unroll 1
    for (int i = 0; i < 4; ++i) { const int s = lane + 64 * i; const float p = __expf(pw[s] - mx); sum += p; pw[s] = p; }
    sum = wave_sum(sum);
    LDS_WAIT(); asm volatile("" ::: "memory");
#pragma unroll 1
    for (int dd = 0; dd < 2; ++dd) { const int d = lane + 64 * dd; const bf16* vp = MVT + (size_t)(h * 128 + d) * 1024 + b * NMEM; float o = 0.f;
#pragma unroll 4
        for (int s = 0; s < NMEM; s += 8) o += dot8(*(const GAS v4u*)(vp + s), pw + s);
        o /= sum;
        bf16* gp = MIX + (size_t)m * NMIX + X_GM + h * 128 + d;
        *gp = (bf16)f2bf(o * siluf_(bf2f(*gp))); }
    LDS_WAIT(); asm volatile("" ::: "memory");
}
template <int ODD>
__device__ __forceinline__ void naive_scan_item(const Ctx& C, const float* lbp, const float* wgu, const float* bgp, int l, int item, LAS float* scr) {
    constexpr int DV = ODD ? 256 : 128, NCG = DV / 32, NP = ODD ? NP_O : NP_E, VOFF = ODD ? O_VC : E_IB, TS = 8;
    const int li = l >> 1, lane = C.lane, kh = lane >> 5;
    const int cg = item % NCG, h = (item / NCG) & 3, b = item / (NCG * 4);
    const bf16* P = (const bf16*)(C.ws + WS_P);
    float* O = (float*)(C.ws + (ODD ? WS_OO : WS_OE));
    LAS float* fq = scr; LAS float* fk = scr + TS * 128; LAS float* ff = scr + 2 * TS * 128;
    const int col = h * DV + cg * 32 + (lane & 31);
    for (int dir = 0; dir < 2; ++dir) {
        float lbv[2] = {0.f, 0.f}, bg[2] = {0.f, 0.f};
#pragma unroll
        for (int c = 0; c < 2; ++c) { const int ch = h * 128 + lane + 64 * c;
            if (!ODD) { if (li == 1) { const float p0 = lbp[(0 * 2 + dir) * 512 + ch], p1 = lbp[(1 * 2 + dir) * 512 + ch]; lbv[c] = 1.f / (1.f + __expf(p0 - p1)); } }
            else bg[c] = bgp[(li * 2 + dir) * 512 + ch]; }
        const float* wup = wgu + (size_t)(li * 2 + dir) * 16 * 512 + h * 128 + lane;
        float S[64];
#pragma unroll
        for (int k = 0; k < 64; ++k) S[k] = 0.f;
        for (int tb = 0; tb < T; tb += TS) {
#pragma unroll 1
            for (int s = 0; s < TS; ++s) { const int t = dir ? (T - 1 - (tb + s)) : (tb + s); const size_t m = (size_t)b * T + t; const bf16* row = P + m * NP;
#pragma unroll
                for (int c = 0; c < 2; ++c) { const int k = lane + 64 * c, ch = h * 128 + k; float qv, kv, fv;
                    if (!ODD) { const float z = bf2f(row[(dir ? E_ZB : E_ZF) + ch]); const float sg = sigmoidf_(z);
                        fv = lbv[c] + (1.f - lbv[c]) * sg; kv = (1.f - lbv[c]) * (1.f - sg); qv = siluf_(bf2f(row[E_QB + ch])); }
                    else { float pre = bg[c];
#pragma unroll
                        for (int r = 0; r < 16; ++r) pre += bf2f(row[(dir ? O_RB : O_RF) + r]) * wup[r * 512 + 64 * c];
                        const float ls = fminf(pre, 0.f) - log1pf(__expf(-fabsf(pre)));
                        fv = __expf(ls * (1.f / 16.f)); kv = bf2f(row[O_KC + ch]); qv = bf2f(row[O_QC + ch]) * 0.08838834764831845f; }
                    fq[s * 128 + k] = qv; fk[s * 128 + k] = kv; ff[s * 128 + k] = fv; } }
            LDS_WAIT(); asm volatile("" ::: "memory");
#pragma unroll 1
            for (int s = 0; s < TS; ++s) { const int t = dir ? (T - 1 - (tb + s)) : (tb + s); const size_t m = (size_t)b * T + t;
                const float v = bf2f(P[m * NP + VOFF + col]); float o = 0.f;
                const LAS float* pf = ff + s * 128 + kh * 64; const LAS float* pk = fk + s * 128 + kh * 64; const LAS float* pq = fq + s * 128 + kh * 64;
#pragma unroll
                for (int k4 = 0; k4 < 16; ++k4) { const f32x4 f4 = *(const LAS f32x4*)(pf + 4 * k4), k4v = *(const LAS f32x4*)(pk + 4 * k4), q4 = *(const LAS f32x4*)(pq + 4 * k4);
#pragma unroll
                    for (int e = 0; e < 4; ++e) { S[4 * k4 + e] = f4[e] * S[4 * k4 + e] + k4v[e] * v; o += q4[e] * S[4 * k4 + e]; }
                    if ((k4 & 3) == 3) asm volatile("" ::: "memory"); }
                o += __shfl_xor(o, 32);
                float* op = O + m * (4 * DV) + col;
                if (kh == 0) { if (dir) *op += o; else *op = o; } }
            LDS_WAIT(); asm volatile("" ::: "memory");
        }
    }
}
template <int ODD>
__device__ __forceinline__ void naive_gnorm_item(const Ctx& C, const float* gw_, int l, int item) {
    constexpr int DV = ODD ? 256 : 128, NC = DV / 64, GOFF = ODD ? X_GC : X_GB;
    const int li = l >> 1, lane = C.lane, h = item & 3, m = item >> 2;
    const float* O = (const float*)(C.ws + (ODD ? WS_OO : WS_OE)) + (size_t)m * (4 * DV) + h * DV;
    const float* g = gw_ + li * (4 * DV) + h * DV;
    bf16* MIX = (bf16*)(C.ws + WS_MIX) + (size_t)m * NMIX + GOFF + h * DV;
    float v[NC]; float s = 0.f;
#pragma unroll
    for (int c = 0; c < NC; ++c) { v[c] = O[lane + 64 * c]; s += v[c] * v[c]; }
    const float rstd = 1.f / sqrtf(wave_sum(s) * (1.f / DV) + EPS);
#pragma unroll
    for (int c = 0; c < NC; ++c) { bf16* gp = MIX + lane + 64 * c; *gp = (bf16)f2bf(v[c] * rstd * g[lane + 64 * c] * siluf_(bf2f(*gp))); }
}

constexpr int STEPS_PER_LAYER = 5, NSTEPS = 2 + DEPTH * STEPS_PER_LAYER;

__global__ void __launch_bounds__(NTHR, 2) mk_fwd(Args args) {
    extern __shared__ __attribute__((aligned(16))) unsigned char lds_raw[];
    Ctx C;
    C.lds = (LAS unsigned char*)lds_raw;
    C.tid = threadIdx.x; C.lane = C.tid & 63; C.wave = __builtin_amdgcn_readfirstlane(C.tid >> 6);
    C.G = gridDim.x; C.bid = blockIdx.x;
    C.out = args.out; C.ws = args.ws;
    volatile LAS unsigned* MISC = (volatile LAS unsigned*)(C.lds + MISC_OFF);
    for (int u = C.tid; u < (LDS_BYTES - RING_BYTES) / 4; u += NTHR) ((LAS unsigned*)(C.lds + RING_BYTES))[u] = 0u;
    __syncthreads();
    XcdBarrier bar; bar.bar = (unsigned*)(C.ws + WS_CTL) + CW_BAR; bar.x = 0; bar.st = nullptr;
    const int lo = args.ph_lo, hi = args.ph_hi;
    if (hi - lo > 1) bar = xcd_barrier_post((unsigned*)(C.ws + WS_CTL) + CW_BAR, MISC + 8);
    int step = 0;
#define PHASE_BEGIN if (step >= lo && step < hi) { { unsigned char* _w = args.ws; float* _o = args.out; asm volatile("" : "+s"(_w), "+s"(_o)); C.ws = _w; C.out = _o; \
        P = (bf16*)(C.ws + WS_P); MIX = (bf16*)(C.ws + WS_MIX); HN = (bf16*)(C.ws + WS_HN); }
#define PHASE_END   if (step + 1 < hi) xcd_barrier(bar); } ++step;

    const int gw = C.bid * NWAVES + C.wave, NGW = C.G * NWAVES;
    LAS float* wscr = (LAS float*)(C.lds + C.wave * 16384);
    bf16* P = (bf16*)(C.ws + WS_P); bf16* MIX = (bf16*)(C.ws + WS_MIX); bf16* HN = (bf16*)(C.ws + WS_HN);

    PHASE_BEGIN if (TEST_MASK & 1) phase_prep(C, args); PHASE_END
    PHASE_BEGIN
#pragma unroll 1
        for (int l = 0; l < DEPTH; ++l) {
            const bf16* WKV = (const bf16*)(C.ws + WS_WKV) + (size_t)l * 1024 * 1024; const bf16* MEMN = (const bf16*)(C.ws + WS_MEMN);
            EpiStoreBf16 ek{(bf16*)(C.ws + WS_MEMK) + (size_t)l * 1024 * 512, 512};
            gemm_naive(C, MEMN, 1024, WKV, 1024, 1024, 512, 1024, (C.bid + 32 * l) % C.G, C.G, ek);
            EpiStoreBf16 ev{(bf16*)(C.ws + WS_MEMVT) + (size_t)l * 512 * 1024, 1024};
            gemm_naive(C, WKV + (size_t)512 * 1024, 1024, MEMN, 1024, 512, 1024, 1024, (C.bid + 32 * l + 128) % C.G, C.G, ev);
        }
    PHASE_END

#pragma unroll 1
    for (int l = 0; l < DEPTH; ++l) {
        const int odd = l & 1, li = l >> 1;
        PHASE_BEGIN
            EpiInProj e{P, MIX, odd ? NP_O : NP_E};
            if (TEST_MASK & 2) gemm_naive(C, HN, 1024, (const bf16*)(C.ws + WS_WIN), 1024, M, odd ? NIN_O : NIN_E, 1024, C.bid, C.G, e);
        PHASE_END
        PHASE_BEGIN
            const int nscan = odd ? 128 : 64;
            if (gw < nscan) { if (TEST_MASK & 4) { if (odd) naive_scan_item<1>(C, args.in[5], args.in[10], args.in[11], l, gw, wscr); else naive_scan_item<0>(C, args.in[5], args.in[10], args.in[11], l, gw, wscr); } }
            else {
                const int w2 = gw - nscan, NW2 = NGW - nscan;
                const int nA = odd ? 0 : M * 8, nM = M * 4, nW = (l + 1 < DEPTH) ? win_items(l + 1) : 0;
                for (int it = w2; it < nA + nM + nW; it += NW2) {
                    if (!(TEST_MASK & 8)) {} else if (it < nA) naive_winattn_item(C, args.in[4] + li * 8, it, wscr);
                    else if (it < nA + nM) naive_memattn_item(C, l, it - nA, wscr);
                    else win_item(C, args.in[3], args.in[9], l + 1, it - nA - nM, wscr);
                }
            }
        PHASE_END
        PHASE_BEGIN
            if (TEST_MASK & 16) for (int it = gw; it < M * 4; it += NGW) { if (odd) naive_gnorm_item<1>(C, args.in[12], l, it); else naive_gnorm_item<0>(C, args.in[6], l, it); }
        PHASE_END
        PHASE_BEGIN
            EpiResid e{l == 0 ? args.in[0] : C.out, C.out};
            if (TEST_MASK & 2) gemm_naive(C, MIX, NMIX, (const bf16*)(C.ws + WS_WOUT) + (size_t)l * 1024 * 1536, 1536, M, 1024, 1536, C.bid, C.G, e);
        PHASE_END
        PHASE_BEGIN
            if (!(TEST_MASK & 32)) {} else if (l + 1 < DEPTH) { const float* g = ((l + 1) & 1) ? args.in[8] + ((l + 1) >> 1) * D : args.in[2] + ((l + 1) >> 1) * D;
                for (int r = gw; r < M; r += NGW) rms_row_to_bf16(C.out + (size_t)r * D, g, HN + (size_t)r * D, C.lane); }
            else { for (int r = gw; r < M; r += NGW) rms_row_to_f32(C.out + (size_t)r * D, args.in[16], C.out + (size_t)r * D, C.lane); }
        PHASE_END
    }
#undef PHASE_BEGIN
#undef PHASE_END
}

extern "C" void kernel_launch(void* const* d_in, const int* in_sizes, int n_in, void* d_out, int out_size, void* d_ws, size_t ws_size, hipStream_t stream) {
    static int grid = 0;
    if (grid == 0) {
        if (n_in != 17 || out_size != M * D || ws_size < WS_END) { fprintf(stderr, "kernel_launch: unexpected shapes n_in %d out %d ws %zu\n", n_in, out_size, ws_size); grid = -1; return; }
        int dev = 0, cus = 0, per_cu = 0;
        if (hipGetDevice(&dev) != hipSuccess || hipDeviceGetAttribute(&cus, hipDeviceAttributeMultiprocessorCount, dev) != hipSuccess) { grid = -1; return; }
        if (hipFuncSetAttribute((const void*)mk_fwd, hipFuncAttributeMaxDynamicSharedMemorySize, LDS_BYTES) != hipSuccess) { fprintf(stderr, "kernel_launch: hipFuncSetAttribute failed\n"); grid = -1; return; }
        if (hipOccupancyMaxActiveBlocksPerMultiprocessor(&per_cu, (const void*)mk_fwd, NTHR, LDS_BYTES) != hipSuccess || per_cu < 1)
            fprintf(stderr, "kernel_launch: occupancy query reports %d blocks per CU\n", per_cu);
        (void)hipGetLastError();
        grid = cus;
    }
    if (grid < 0) return;
    if (hipMemsetAsync((char*)d_ws + WS_CTL, 0, CTL_ZERO_BYTES, stream) != hipSuccess) return;
    Args a{};
    for (int i = 0; i < 17; ++i) a.in[i] = (const float*)d_in[i];
    a.out = (float*)d_out; a.ws = (unsigned char*)d_ws;
#if MK_ONE_LAUNCH
    a.ph_lo = 0; a.ph_hi = NSTEPS;
    hipLaunchKernelGGL(mk_fwd, dim3(grid), dim3(NTHR), LDS_BYTES, stream, a);
#else
    for (int s = 0; s < NSTEPS; ++s) { a.ph_lo = s; a.ph_hi = s + 1; hipLaunchKernelGGL(mk_fwd, dim3(grid), dim3(NTHR), LDS_BYTES, stream, a); }
#endif
}
```

```cpp
#include <hip/hip_runtime.h>
#include <cstdio>
#include <cstdint>

#ifndef TEST_MASK
#define TEST_MASK 0xFFFF
#endif
#ifndef MK_ONE_LAUNCH
#define MK_ONE_LAUNCH 1
#endif

#define GAS __attribute__((address_space(1)))
#define LAS __attribute__((address_space(3)))
typedef unsigned short bf16;
typedef unsigned v4u __attribute__((ext_vector_type(4)));
typedef float f32x4 __attribute__((ext_vector_type(4)));
typedef GAS unsigned gu32;
#define RLX_AGENT __ATOMIC_RELAXED, __HIP_MEMORY_SCOPE_AGENT
#define LDS_WAIT() asm volatile("s_waitcnt lgkmcnt(0)" ::: "memory")
#define VM_WAIT() asm volatile("s_waitcnt vmcnt(0)" ::: "memory")

constexpr int NWAVES = 8, NTHR = 512;
constexpr int BATCH = 4, T = 4096, D = 1024, M = BATCH * T, DEPTH = 4;
constexpr int NMEM = 256;
constexpr int NP_E = 3328, NP_O = 2816, NMIX = 1536, NIN_E = 4864, NIN_O = 4352, NIN_O_SRC = 4128;
constexpr int E_QA = 0, E_KA = 512, E_VA = 640, E_QB = 768, E_ZF = 1280, E_ZB = 1792, E_IB = 2304, E_QM = 2816;
constexpr int O_QC = 0, O_KC = 512, O_VC = 1024, O_QM = 2048, O_RF = 2560, O_RB = 2576;
constexpr int X_GA = 0, X_GB = 512, X_GM = 1024, X_GC = 0;
constexpr float EPS = 1e-6f;

constexpr size_t MiB = 1u << 20;
constexpr size_t WS_CTL = 0, CTL_ZERO_BYTES = 1 * MiB;
constexpr size_t WS_WIN = 2 * MiB;
constexpr size_t WS_WOUT = 12 * MiB;
constexpr size_t WS_WKV = 24 * MiB;
constexpr size_t WS_MEMK = 32 * MiB;
constexpr size_t WS_MEMVT = 36 * MiB;
constexpr size_t WS_MEMN = 40 * MiB;
constexpr size_t WS_MIX = 43 * MiB;
constexpr size_t WS_P = 91 * MiB;
constexpr size_t WS_HN = 195 * MiB;
constexpr size_t WS_OE = 195 * MiB;
constexpr size_t WS_OO = 192 * MiB;
constexpr size_t WS_END = 256 * MiB;

constexpr int CW_BAR = 4096;

__device__ __forceinline__ float bf2f(bf16 v) { return __uint_as_float(((unsigned)v) << 16); }
__device__ __forceinline__ unsigned f2bf(float f) { unsigned u = __float_as_uint(f); return (u + 0x7fffu + ((u >> 16) & 1u)) >> 16; }
__device__ __forceinline__ unsigned pk2(float lo, float hi) { return f2bf(lo) | (f2bf(hi) << 16); }
__device__ __forceinline__ float wave_sum(float v) {
#pragma unroll
    for (int o = 1; o < 64; o <<= 1) v += __shfl_xor(v, o);
    return v;
}
__device__ __forceinline__ float wave_max(float v) {
#pragma unroll
    for (int o = 1; o < 64; o <<= 1) v = fmaxf(v, __shfl_xor(v, o));
    return v;
}
__device__ __forceinline__ float sigmoidf_(float z) { return 1.f / (1.f + __expf(-z)); }
__device__ __forceinline__ float siluf_(float z) { return z / (1.f + __expf(-z)); }

#define XB_TMO      128
#define XB_XCNT(j)  (256  + 64 * (j))
#define XB_XSUB(j)  (1280 + 64 * (j))
#define XB_XGEN(j)  (2304 + 64 * (j))
#define XB_TOP      3328
#define XB_TOPGEN   3392
#define XCD_BAR_WORDS 3456
#define XB_SPIN_CAP (1u << 22)
__device__ __forceinline__ unsigned xb_ld(unsigned* p)              { return __hip_atomic_load(p, __ATOMIC_RELAXED, __HIP_MEMORY_SCOPE_AGENT); }
__device__ __forceinline__ unsigned xb_add(unsigned* p, unsigned v) { return __hip_atomic_fetch_add(p, v, __ATOMIC_RELAXED, __HIP_MEMORY_SCOPE_AGENT); }
__device__ __forceinline__ unsigned xb_xcc_id() { return (unsigned)__builtin_amdgcn_s_getreg((3 << 11) | 20) & 0xFu; }
#define XB_SPIN(cond, bar) do { unsigned _sp = 0; while (cond) { __builtin_amdgcn_s_sleep(1); \
    if ((++_sp & 255u) == 0u) { if (xb_ld(&(bar)[XB_TMO])) break; if (_sp > XB_SPIN_CAP) { atomicAdd(&(bar)[XB_TMO], 1u); break; } } } } while (0)
struct XcdBarrier { unsigned* bar; unsigned x; volatile LAS unsigned* st; };
__device__ __forceinline__ XcdBarrier xcd_barrier_post(unsigned* bar, volatile LAS unsigned* st) {
    XcdBarrier b; b.bar = bar; b.x = xb_xcc_id(); b.st = st;
    if (threadIdx.x == 0) (void)xb_add(&bar[XB_XCNT(b.x)], 1u);
    return b;
}
__device__ __forceinline__ void xcd_barrier_complete(unsigned* bar, unsigned x, unsigned& nloc, unsigned& nx) {
    const unsigned G = gridDim.x * gridDim.y * gridDim.z;
    unsigned sum, cnt, mine, sp = 0u;
    for (;;) {
        sum = 0u; cnt = 0u; mine = 0u;
#pragma unroll
        for (unsigned j = 0; j < 16; ++j) { const unsigned c = xb_ld(&bar[XB_XCNT(j)]); sum += c; cnt += (c > 0u) ? 1u : 0u; mine = (j == x) ? c : mine; }
        if (sum == G) break;
        __builtin_amdgcn_s_sleep(1);
        if ((++sp & 255u) == 0u) { if (xb_ld(&bar[XB_TMO])) break; if (sp > XB_SPIN_CAP) { atomicAdd(&bar[XB_TMO], 1u); break; } }
    }
    nloc = mine > 0u ? mine : 1u; nx = cnt > 0u ? cnt : 1u;
}
__device__ __forceinline__ void xcd_barrier(const XcdBarrier& b) {
    asm volatile("s_waitcnt vmcnt(0)" ::: "memory");
    __syncthreads();
    if (threadIdx.x == 0) {
        unsigned* bar = b.bar;
        __builtin_amdgcn_s_waitcnt(0);
        unsigned nloc = b.st[0], nx = b.st[1];
        if (nloc == 0u) { xcd_barrier_complete(bar, b.x, nloc, nx); b.st[0] = nloc; b.st[1] = nx; }
        const unsigned old = xb_add(&bar[XB_XSUB(b.x)], 1u);
        const unsigned gen = old / nloc;
        if (old + 1u == (gen + 1u) * nloc) {
            __builtin_amdgcn_fence(__ATOMIC_RELEASE, "agent");
            asm volatile("s_waitcnt vmcnt(0)" ::: "memory");
            const unsigned og = xb_add(&bar[XB_TOP], 1u);
            const unsigned tg = og / nx;
            if (og + 1u == (tg + 1u) * nx) xb_add(&bar[XB_TOPGEN], 1u);
            else XB_SPIN(xb_ld(&bar[XB_TOPGEN]) == tg, bar);
            __builtin_amdgcn_fence(__ATOMIC_ACQUIRE, "agent");
            xb_add(&bar[XB_XGEN(b.x)], 1u);
            asm volatile("s_waitcnt vmcnt(0)" ::: "memory");
        } else {
            XB_SPIN(xb_ld(&bar[XB_XGEN(b.x)]) == gen, bar);
            __builtin_amdgcn_fence(__ATOMIC_ACQUIRE, "agent");
            asm volatile("s_waitcnt vmcnt(0)" ::: "memory");
        }
    }
    __syncthreads();
}

constexpr int RING_BYTES = 131072;
constexpr int MISC_OFF = RING_BYTES + 320;
constexpr int LDS_BYTES = 147456;

struct Args { const float* in[17]; float* out; unsigned char* ws; int ph_lo, ph_hi; };
static_assert(sizeof(Args) == 17 * 8 + 8 + 8 + 8, "Args has no padding");

struct Ctx {
    LAS unsigned char* lds;
    int tid, lane, wave, G, bid;
    float* out; unsigned char* ws;
};

__device__ __forceinline__ void transpose_item(const float* W, int K, int N, bf16* WT, int k0, int n0, int drow0, LAS float* scr, int lane) {
#pragma unroll 8
    for (int i = 0; i < 32; ++i) { const int kk = 2 * i + (lane >> 5); scr[kk * 33 + (lane & 31)] = W[(size_t)(k0 + kk) * N + n0 + (lane & 31)]; }
    LDS_WAIT(); asm volatile("" ::: "memory");
    const int c = lane & 7;
#pragma unroll
    for (int j = 0; j < 4; ++j) { const int n = (lane >> 3) + 8 * j; const LAS float* s = scr + (8 * c) * 33 + n;
        v4u o; o.x = pk2(s[0 * 33], s[1 * 33]); o.y = pk2(s[2 * 33], s[3 * 33]); o.z = pk2(s[4 * 33], s[5 * 33]); o.w = pk2(s[6 * 33], s[7 * 33]);
        *(GAS v4u*)(WT + (size_t)(drow0 + n) * K + k0 + 8 * c) = o; }
    LDS_WAIT(); asm volatile("" ::: "memory");
}
__device__ __forceinline__ int map_even(int n0) {
    if (n0 < 768) return n0;
    if (n0 < 1280) return NP_E + X_GA + (n0 - 768);
    if (n0 < 3328) return E_QB + (n0 - 1280);
    if (n0 < 3840) return NP_E + X_GB + (n0 - 3328);
    if (n0 < 4352) return E_QM + (n0 - 3840);
    return NP_E + X_GM + (n0 - 4352);
}
__device__ __forceinline__ int map_odd(int n0) {
    if (n0 < 2048) return n0;
    if (n0 < 3072) return NP_O + X_GC + (n0 - 2048);
    if (n0 < 3104) return O_RF + (n0 - 3072);
    if (n0 < 3616) return O_QM + (n0 - 3104);
    return NP_O + X_GM + (n0 - 3616);
}
__device__ __forceinline__ int win_items(int l) { return (l & 1) ? (16 * (NIN_O_SRC / 32) + 224) : (16 * (NIN_E / 32)); }
__device__ __forceinline__ void win_item(const Ctx& C, const float* w_even, const float* w_odd, int l, int it, LAS float* scr) {
    bf16* WT = (bf16*)(C.ws + WS_WIN);
    if (l & 1) {
        const int nconv = 16 * (NIN_O_SRC / 32);
        if (it < nconv) { const int nb = it % (NIN_O_SRC / 32), kb = it / (NIN_O_SRC / 32);
            transpose_item(w_odd + (size_t)(l >> 1) * D * NIN_O_SRC, D, NIN_O_SRC, WT, kb * 64, nb * 32, map_odd(nb * 32), scr, C.lane); }
        else { const int r = 2592 + (it - nconv);
            GAS v4u* p = (GAS v4u*)(WT + (size_t)r * D); v4u z = {0u, 0u, 0u, 0u}; p[C.lane] = z; p[C.lane + 64] = z; }
    } else {
        const int nb = it % (NIN_E / 32), kb = it / (NIN_E / 32);
        transpose_item(w_even + (size_t)(l >> 1) * D * NIN_E, D, NIN_E, WT, kb * 64, nb * 32, map_even(nb * 32), scr, C.lane);
    }
}
__device__ __forceinline__ void rms_row_to_bf16(const float* xrow, const float* g, bf16* orow, int lane) {
    const GAS f32x4* xr = (const GAS f32x4*)xrow + lane; const GAS f32x4* gr = (const GAS f32x4*)g + lane;
    f32x4 v[4]; float s = 0.f;
#pragma unroll
    for (int j = 0; j < 4; ++j) { v[j] = xr[64 * j]; s += (v[j].x * v[j].x + v[j].y * v[j].y) + (v[j].z * v[j].z + v[j].w * v[j].w); }
    const float rstd = 1.f / sqrtf(wave_sum(s) * (1.f / D) + EPS);
    GAS unsigned long long* o8 = (GAS unsigned long long*)orow + lane;
#pragma unroll
    for (int j = 0; j < 4; ++j) { const f32x4 gg = gr[64 * j];
        o8[64 * j] = (unsigned long long)pk2(v[j].x * rstd * gg.x, v[j].y * rstd * gg.y) | ((unsigned long long)pk2(v[j].z * rstd * gg.z, v[j].w * rstd * gg.w) << 32); }
}
__device__ __forceinline__ void rms_row_to_f32(const float* xrow, const float* g, float* orow, int lane) {
    const GAS f32x4* xr = (const GAS f32x4*)xrow + lane; const GAS f32x4* gr = (const GAS f32x4*)g + lane;
    f32x4 v[4]; float s = 0.f;
#pragma unroll
    for (int j = 0; j < 4; ++j) { v[j] = xr[64 * j]; s += (v[j].x * v[j].x + v[j].y * v[j].y) + (v[j].z * v[j].z + v[j].w * v[j].w); }
    const float rstd = 1.f / sqrtf(wave_sum(s) * (1.f / D) + EPS);
    GAS f32x4* o = (GAS f32x4*)orow + lane;
#pragma unroll
    for (int j = 0; j < 4; ++j) { const f32x4 gg = gr[64 * j]; o[64 * j] = v[j] * rstd * gg; }
}

__device__ __forceinline__ void phase_prep(const Ctx& C, const Args& A) {
    LAS float* scr = (LAS float*)(C.lds + C.wave * 16384);
    const int gw = C.bid * NWAVES + C.wave, NGW = C.G * NWAVES;
    constexpr int I_OUT = (1536 / 64) * (1024 / 32), I_KV = (1024 / 64) * (1024 / 32);
    const int I_IN = win_items(0);
    const int total = 4 * I_OUT + 4 * I_KV + I_IN + 1024 + M;
    for (int it = gw; it < total; it += NGW) {
        int r = it;
        if (r < 4 * I_OUT) { const int l = r / I_OUT; r -= l * I_OUT; const int nb = r % 32, kb = r / 32;
            const float* W = (l & 1) ? A.in[13] + (size_t)(l >> 1) * 1536 * 1024 : A.in[7] + (size_t)(l >> 1) * 1536 * 1024;
            transpose_item(W, 1536, 1024, (bf16*)(C.ws + WS_WOUT) + (size_t)l * 1024 * 1536, kb * 64, nb * 32, nb * 32, scr, C.lane); continue; }
        r -= 4 * I_OUT;
        if (r < 4 * I_KV) { const int l = r / I_KV; r -= l * I_KV; const int nb = r % 32, kb = r / 32;
            transpose_item(A.in[15] + (size_t)l * 1024 * 1024, 1024, 1024, (bf16*)(C.ws + WS_WKV) + (size_t)l * 1024 * 1024, kb * 64, nb * 32, nb * 32, scr, C.lane); continue; }
        r -= 4 * I_KV;
        if (r < I_IN) { win_item(C, A.in[3], A.in[9], 0, r, scr); continue; }
        r -= I_IN;
        if (r < 1024) { rms_row_to_bf16(A.in[1] + (size_t)r * D, A.in[14], (bf16*)(C.ws + WS_MEMN) + (size_t)r * D, C.lane); continue; }
        r -= 1024;
        rms_row_to_bf16(A.in[0] + (size_t)r * D, A.in[2], (bf16*)(C.ws + WS_HN) + (size_t)r * D, C.lane);
    }
}

template <class Epi>
__device__ __forceinline__ void gemm_naive(const Ctx& C, const bf16* A, int lda, const bf16* Bt, int ldb, int Mr, int Nr, int K, int tile0, int tstride, const Epi& E) {
    LAS float* As = (LAS float*)C.lds;
    LAS float* Bs = As + 32 * 132;
    const int tid = C.tid, ty = tid >> 4, tx = tid & 15;
    const int nMt = Mr / 128, nNt = Nr / 128, ntiles = nMt * nNt;
    for (int tile = tile0; tile < ntiles; tile += tstride) {
        const int tm = tile % nMt, tn = tile / nMt;
        float acc[4][8];
#pragma unroll
        for (int i = 0; i < 4; ++i)
#pragma unroll
            for (int j = 0; j < 8; ++j) acc[i][j] = 0.f;
        const int lr = tid >> 2, lk = (tid & 3) * 8;
        for (int k0 = 0; k0 < K; k0 += 32) {
            const v4u av = *(const GAS v4u*)(A + (size_t)(tm * 128 + lr) * lda + k0 + lk);
            const v4u bv = *(const GAS v4u*)(Bt + (size_t)(tn * 128 + lr) * ldb + k0 + lk);
            __syncthreads();
#pragma unroll
            for (int j = 0; j < 4; ++j) {
                As[(lk + 2 * j) * 132 + lr] = __uint_as_float(av[j] << 16); As[(lk + 2 * j + 1) * 132 + lr] = __uint_as_float(av[j] & 0xffff0000u);
                Bs[(lk + 2 * j) * 132 + lr] = __uint_as_float(bv[j] << 16); Bs[(lk + 2 * j + 1) * 132 + lr] = __uint_as_float(bv[j] & 0xffff0000u);
            }
            __syncthreads();
#pragma unroll 2
            for (int k = 0; k < 32; ++k) {
                const f32x4 a = *(const LAS f32x4*)(As + k * 132 + ty * 4);
                const f32x4 b0 = *(const LAS f32x4*)(Bs + k * 132 + tx * 8), b1 = *(const LAS f32x4*)(Bs + k * 132 + tx * 8 + 4);
#pragma unroll
                for (int i = 0; i < 4; ++i) {
                    acc[i][0] += a[i] * b0[0]; acc[i][1] += a[i] * b0[1]; acc[i][2] += a[i] * b0[2]; acc[i][3] += a[i] * b0[3];
                    acc[i][4] += a[i] * b1[0]; acc[i][5] += a[i] * b1[1]; acc[i][6] += a[i] * b1[2]; acc[i][7] += a[i] * b1[3];
                }
            }
        }
#pragma unroll
        for (int i = 0; i < 4; ++i) E(tm * 128 + ty * 4 + i, tn * 128 + tx * 8, acc[i]);
    }
    __syncthreads();
}
struct EpiStoreBf16 {
    bf16* O; int ldc;
    __device__ __forceinline__ void operator()(int m, int n0, const float (&v)[8]) const {
        v4u w; w.x = pk2(v[0], v[1]); w.y = pk2(v[2], v[3]); w.z = pk2(v[4], v[5]); w.w = pk2(v[6], v[7]);
        *(GAS v4u*)(O + (size_t)m * ldc + n0) = w; }
};
struct EpiInProj {
    bf16* P; bf16* MIX; int NP;
    __device__ __forceinline__ void operator()(int m, int n0, const float (&v)[8]) const {
        v4u w; w.x = pk2(v[0], v[1]); w.y = pk2(v[2], v[3]); w.z = pk2(v[4], v[5]); w.w = pk2(v[6], v[7]);
        if (n0 < NP) *(GAS v4u*)(P + (size_t)m * NP + n0) = w; else *(GAS v4u*)(MIX + (size_t)m * NMIX + (n0 - NP)) = w; }
};
struct EpiResid {
    const float* xi; float* xo;
    __device__ __forceinline__ void operator()(int m, int n0, const float (&v)[8]) const {
        const f32x4 a = *(const GAS f32x4*)(xi + (size_t)m * D + n0), b = *(const GAS f32x4*)(xi + (size_t)m * D + n0 + 4);
        f32x4 o0 = {a[0] + v[0], a[1] + v[1], a[2] + v[2], a[3] + v[3]}, o1 = {b[0] + v[4], b[1] + v[5], b[2] + v[6], b[3] + v[7]};
        *(GAS f32x4*)(xo + (size_t)m * D + n0) = o0; *(GAS f32x4*)(xo + (size_t)m * D + n0 + 4) = o1; }
};

__device__ __forceinline__ float dot8(const v4u w, const LAS float* q) {
    const f32x4 q0 = *(const LAS f32x4*)q, q1 = *(const LAS f32x4*)(q + 4);
    return (__uint_as_float(w[0] << 16) * q0[0] + __uint_as_float(w[0] & 0xffff0000u) * q0[1]) + (__uint_as_float(w[1] << 16) * q0[2] + __uint_as_float(w[1] & 0xffff0000u) * q0[3])
         + (__uint_as_float(w[2] << 16) * q1[0] + __uint_as_float(w[2] & 0xffff0000u) * q1[1]) + (__uint_as_float(w[3] << 16) * q1[2] + __uint_as_float(w[3] & 0xffff0000u) * q1[3]);
}
__device__ __forceinline__ void naive_winattn_item(const Ctx& C, const float* sink, int item, LAS float* pw) {
    const bf16* P = (const bf16*)(C.ws + WS_P); bf16* MIX = (bf16*)(C.ws + WS_MIX);
    const int lane = C.lane, hq = item & 7, m = item >> 3, t = m & (T - 1), b = m >> 12, n = hq >> 2;
    const float slope = exp2f(-(float)(hq + 1)), sk = sink[hq];
    LAS float* qs = pw + 320;
    qs[lane] = bf2f(P[(size_t)m * NP_E + E_QA + hq * 64 + lane]);
    LDS_WAIT(); asm volatile("" ::: "memory");
    float mx = -3e38f;
#pragma unroll 1
    for (int i = 0; i < 5; ++i) {
        const int j = lane + 64 * i, s = t - 128 + j; const bool valid = (j <= 256) && (s >= 0) && (s < T);
        float acc = -3e38f;
        if (valid) { const GAS v4u* kp = (const GAS v4u*)(P + (size_t)(b * T + s) * NP_E + E_KA + n * 64); acc = 0.f;
#pragma unroll
            for (int jj = 0; jj < 8; ++jj) acc += dot8(kp[jj], qs + 8 * jj);
            acc = acc * 0.125f - slope * fabsf((float)(t - s)); mx = fmaxf(mx, acc); }
        if (j <= 256) pw[j] = acc;
    }
    mx = fmaxf(wave_max(mx), sk);
    LDS_WAIT(); asm volatile("" ::: "memory");
    float sum = 0.f;
#pragma unroll 1
    for (int i = 0; i < 5; ++i) { const int j = lane + 64 * i; if (j <= 256) { const float sc = pw[j]; const float p = (sc > -1e38f) ? __expf(sc - mx) : 0.f; sum += p; pw[j] = p; } }
    sum = wave_sum(sum) + __expf(sk - mx);
    LDS_WAIT(); asm volatile("" ::: "memory");
    float o = 0.f;
    for (int j = 0; j <= 256; ++j) { const int s = t - 128 + j; if (s < 0 || s >= T) continue;
        o += pw[j] * bf2f(P[(size_t)(b * T + s) * NP_E + E_VA + n * 64 + lane]); }
    o /= sum;
    bf16* gp = MIX + (size_t)m * NMIX + X_GA + hq * 64 + lane;
    *gp = (bf16)f2bf(o * siluf_(bf2f(*gp)));
    LDS_WAIT(); asm volatile("" ::: "memory");
}
__device__ __forceinline__ void naive_memattn_item(const Ctx& C, int l, int item, LAS float* pw) {
    const int NP = (l & 1) ? NP_O : NP_E, QOFF = (l & 1) ? O_QM : E_QM;
    const bf16* P = (const bf16*)(C.ws + WS_P); bf16* MIX = (bf16*)(C.ws + WS_MIX);
    const bf16* MK = (const bf16*)(C.ws + WS_MEMK) + (size_t)l * 1024 * 512; const bf16* MVT = (const bf16*)(C.ws + WS_MEMVT) + (size_t)l * 512 * 1024;
    const int lane = C.lane, h = item & 3, m = item >> 2, b = m >> 12;
    LAS float* qs = pw + 320;
    qs[lane] = bf2f(P[(size_t)m * NP + QOFF + h * 128 + lane]); qs[lane + 64] = bf2f(P[(size_t)m * NP + QOFF + h * 128 + lane + 64]);
    LDS_WAIT(); asm volatile("" ::: "memory");
    float mx = -3e38f;
#pragma unroll 1
    for (int i = 0; i < 4; ++i) { const int s = lane + 64 * i;
        const GAS v4u* kp = (const GAS v4u*)(MK + (size_t)(b * NMEM + s) * 512 + h * 128); float acc = 0.f;
#pragma unroll
        for (int jj = 0; jj < 16; ++jj) acc += dot8(kp[jj], qs + 8 * jj);
        acc *= 0.08838834764831845f; mx = fmaxf(mx, acc); pw[s] = acc; }
    mx = wave_max(mx);
    LDS_WAIT(); asm volatile("" ::: "memory");
    float sum = 0.f;
#pragma unroll 1
    for (int i = 0; i < 4; ++i) { const int s = lane + 64 * i; const float p = __expf(pw[s] - mx); sum += p; pw[s] = p; }
    sum = wave_sum(sum);
    LDS_WAIT(); asm volatile("" ::: "memory");
#pragma unroll 1
    for (int dd = 0; dd < 2; ++dd) { const int d = lane + 64 * dd; const bf16* vp = MVT + (size_t)(h * 128 + d) * 1024 + b * NMEM; float o = 0.f;
#pragma unroll 4
        for (int s = 0; s < NMEM; s += 8) o += dot8(*(const GAS v4u*)(vp + s), pw + s);
        o /= sum;
        bf16* gp = MIX + (size_t)m * NMIX + X_GM + h * 128 + d;
        *gp = (bf16)f2bf(o * siluf_(bf2f(*gp))); }
    LDS_WAIT(); asm volatile("" ::: "memory");
}
template <int ODD>
__device__ __forceinline__ void naive_scan_item(const Ctx& C, const float* lbp, const float* wgu, const float* bgp, int l, int item, LAS float* scr) {
    constexpr int DV = ODD ? 256 : 128, NCG = DV / 32, NP = ODD ? NP_O : NP_E, VOFF = ODD ? O_VC : E_IB, TS = 8;
    const int li = l >> 1, lane = C.lane, kh = lane >> 5;
    const int cg = item % NCG, h = (item / NCG) & 3, b = item / (NCG * 4);
    const bf16* P = (const bf16*)(C.ws + WS_P);
    float* O = (float*)(C.ws + (ODD ? WS_OO : WS_OE));
    LAS float* fq = scr; LAS float* fk = scr + TS * 128; LAS float* ff = scr + 2 * TS * 128;
    const int col = h * DV + cg * 32 + (lane & 31);
    for (int dir = 0; dir < 2; ++dir) {
        float lbv[2] = {0.f, 0.f}, bg[2] = {0.f, 0.f};
#pragma unroll
        for (int c = 0; c < 2; ++c) { const int ch = h * 128 + lane + 64 * c;
            if (!ODD) { if (li == 1) { const float p0 = lbp[(0 * 2 + dir) * 512 + ch], p1 = lbp[(1 * 2 + dir) * 512 + ch]; lbv[c] = 1.f / (1.f + __expf(p0 - p1)); } }
            else bg[c] = bgp[(li * 2 + dir) * 512 + ch]; }
        const float* wup = wgu + (size_t)(li * 2 + dir) * 16 * 512 + h * 128 + lane;
        float S[64];
#pragma unroll
        for (int k = 0; k < 64; ++k) S[k] = 0.f;
        for (int tb = 0; tb < T; tb += TS) {
#pragma unroll 1
            for (int s = 0; s < TS; ++s) { const int t = dir ? (T - 1 - (tb + s)) : (tb + s); const size_t m = (size_t)b * T + t; const bf16* row = P + m * NP;
#pragma unroll
                for (int c = 0; c < 2; ++c) { const int k = lane + 64 * c, ch = h * 128 + k; float qv, kv, fv;
                    if (!ODD) { const float z = bf2f(row[(dir ? E_ZB : E_ZF) + ch]); const float sg = sigmoidf_(z);
                        fv = lbv[c] + (1.f - lbv[c]) * sg; kv = (1.f - lbv[c]) * (1.f - sg); qv = siluf_(bf2f(row[E_QB + ch])); }
                    else { float pre = bg[c];
#pragma unroll
                        for (int r = 0; r < 16; ++r) pre += bf2f(row[(dir ? O_RB : O_RF) + r]) * wup[r * 512 + 64 * c];
                        const float ls = fminf(pre, 0.f) - log1pf(__expf(-fabsf(pre)));
                        fv = __expf(ls * (1.f / 16.f)); kv = bf2f(row[O_KC + ch]); qv = bf2f(row[O_QC + ch]) * 0.08838834764831845f; }
                    fq[s * 128 + k] = qv; fk[s * 128 + k] = kv; ff[s * 128 + k] = fv; } }
            LDS_WAIT(); asm volatile("" ::: "memory");
#pragma unroll 1
            for (int s = 0; s < TS; ++s) { const int t = dir ? (T - 1 - (tb + s)) : (tb + s); const size_t m = (size_t)b * T + t;
                const float v = bf2f(P[m * NP + VOFF + col]); float o = 0.f;
                const LAS float* pf = ff + s * 128 + kh * 64; const LAS float* pk = fk + s * 128 + kh * 64; const LAS float* pq = fq + s * 128 + kh * 64;
#pragma unroll
                for (int k4 = 0; k4 < 16; ++k4) { const f32x4 f4 = *(const LAS f32x4*)(pf + 4 * k4), k4v = *(const LAS f32x4*)(pk + 4 * k4), q4 = *(const LAS f32x4*)(pq + 4 * k4);
#pragma unroll
                    for (int e = 0; e < 4; ++e) { S[4 * k4 + e] = f4[e] * S[4 * k4 + e] + k4v[e] * v; o += q4[e] * S[4 * k4 + e]; }
                    if ((k4 & 3) == 3) asm volatile("" ::: "memory"); }
                o += __shfl_xor(o, 32);
                float* op = O + m * (4 * DV) + col;
                if (kh == 0) { if (dir) *op += o; else *op = o; } }
            LDS_WAIT(); asm volatile("" ::: "memory");
        }
    }
}
template <int ODD>
__device__ __forceinline__ void naive_gnorm_item(const Ctx& C, const float* gw_, int l, int item) {
    constexpr int DV = ODD ? 256 : 128, NC = DV / 64, GOFF = ODD ? X_GC : X_GB;
    const int li = l >> 1, lane = C.lane, h = item & 3, m = item >> 2;
    const float* O = (const float*)(C.ws + (ODD ? WS_OO : WS_OE)) + (size_t)m * (4 * DV) + h * DV;
    const float* g = gw_ + li * (4 * DV) + h * DV;
    bf16* MIX = (bf16*)(C.ws + WS_MIX) + (size_t)m * NMIX + GOFF + h * DV;
    float v[NC]; float s = 0.f;
#pragma unroll
    for (int c = 0; c < NC; ++c) { v[c] = O[lane + 64 * c]; s += v[c] * v[c]; }
    const float rstd = 1.f / sqrtf(wave_sum(s) * (1.f / DV) + EPS);
#pragma unroll
    for (int c = 0; c < NC; ++c) { bf16* gp = MIX + lane + 64 * c; *gp = (bf16)f2bf(v[c] * rstd * g[lane + 64 * c] * siluf_(bf2f(*gp))); }
}

constexpr int STEPS_PER_LAYER = 5, NSTEPS = 2 + DEPTH * STEPS_PER_LAYER;

__global__ void __launch_bounds__(NTHR, 2) mk_fwd(Args args) {
    extern __shared__ __attribute__((aligned(16))) unsigned char lds_raw[];
    Ctx C;
    C.lds = (LAS unsigned char*)lds_raw;
    C.tid = threadIdx.x; C.lane = C.tid & 63; C.wave = __builtin_amdgcn_readfirstlane(C.tid >> 6);
    C.G = gridDim.x; C.bid = blockIdx.x;
    C.out = args.out; C.ws = args.ws;
    volatile LAS unsigned* MISC = (volatile LAS unsigned*)(C.lds + MISC_OFF);
    for (int u = C.tid; u < (LDS_BYTES - RING_BYTES) / 4; u += NTHR) ((LAS unsigned*)(C.lds + RING_BYTES))[u] = 0u;
    __syncthreads();
    XcdBarrier bar; bar.bar = (unsigned*)(C.ws + WS_CTL) + CW_BAR; bar.x = 0; bar.st = nullptr;
    const int lo = args.ph_lo, hi = args.ph_hi;
    if (hi - lo > 1) bar = xcd_barrier_post((unsigned*)(C.ws + WS_CTL) + CW_BAR, MISC + 8);
    int step = 0;
#define PHASE_BEGIN if (step >= lo && step < hi) { { unsigned char* _w = args.ws; float* _o = args.out; asm volatile("" : "+s"(_w), "+s"(_o)); C.ws = _w; C.out = _o; \
        P = (bf16*)(C.ws + WS_P); MIX = (bf16*)(C.ws + WS_MIX); HN = (bf16*)(C.ws + WS_HN); }
#define PHASE_END   if (step + 1 < hi) xcd_barrier(bar); } ++step;

    const int gw = C.bid * NWAVES + C.wave, NGW = C.G * NWAVES;
    LAS float* wscr = (LAS float*)(C.lds + C.wave * 16384);
    bf16* P = (bf16*)(C.ws + WS_P); bf16* MIX = (bf16*)(C.ws + WS_MIX); bf16* HN = (bf16*)(C.ws + WS_HN);

    PHASE_BEGIN if (TEST_MASK & 1) phase_prep(C, args); PHASE_END
    PHASE_BEGIN
#pragma unroll 1
        for (int l = 0; l < DEPTH; ++l) {
            const bf16* WKV = (const bf16*)(C.ws + WS_WKV) + (size_t)l * 1024 * 1024; const bf16* MEMN = (const bf16*)(C.ws + WS_MEMN);
            EpiStoreBf16 ek{(bf16*)(C.ws + WS_MEMK) + (size_t)l * 1024 * 512, 512};
            gemm_naive(C, MEMN, 1024, WKV, 1024, 1024, 512, 1024, (C.bid + 32 * l) % C.G, C.G, ek);
            EpiStoreBf16 ev{(bf16*)(C.ws + WS_MEMVT) + (size_t)l * 512 * 1024, 1024};
            gemm_naive(C, WKV + (size_t)512 * 1024, 1024, MEMN, 1024, 512, 1024, 1024, (C.bid + 32 * l + 128) % C.G, C.G, ev);
        }
    PHASE_END

#pragma unroll 1
    for (int l = 0; l < DEPTH; ++l) {
        const int odd = l & 1, li = l >> 1;
        PHASE_BEGIN
            EpiInProj e{P, MIX, odd ? NP_O : NP_E};
            if (TEST_MASK & 2) gemm_naive(C, HN, 1024, (const bf16*)(C.ws + WS_WIN), 1024, M, odd ? NIN_O : NIN_E, 1024, C.bid, C.G, e);
        PHASE_END
        PHASE_BEGIN
            const int nscan = odd ? 128 : 64;
            if (gw < nscan) { if (TEST_MASK & 4) { if (odd) naive_scan_item<1>(C, args.in[5], args.in[10], args.in[11], l, gw, wscr); else naive_scan_item<0>(C, args.in[5], args.in[10], args.in[11], l, gw, wscr); } }
            else {
                const int w2 = gw - nscan, NW2 = NGW - nscan;
                const int nA = odd ? 0 : M * 8, nM = M * 4, nW = (l + 1 < DEPTH) ? win_items(l + 1) : 0;
                for (int it = w2; it < nA + nM + nW; it += NW2) {
                    if (!(TEST_MASK & 8)) {} else if (it < nA) naive_winattn_item(C, args.in[4] + li * 8, it, wscr);
                    else if (it < nA + nM) naive_memattn_item(C, l, it - nA, wscr);
                    else win_item(C, args.in[3], args.in[9], l + 1, it - nA - nM, wscr);
                }
            }
        PHASE_END
        PHASE_BEGIN
            if (TEST_MASK & 16) for (int it = gw; it < M * 4; it += NGW) { if (odd) naive_gnorm_item<1>(C, args.in[12], l, it); else naive_gnorm_item<0>(C, args.in[6], l, it); }
        PHASE_END
        PHASE_BEGIN
            EpiResid e{l == 0 ? args.in[0] : C.out, C.out};
            if (TEST_MASK & 2) gemm_naive(C, MIX, NMIX, (const bf16*)(C.ws + WS_WOUT) + (size_t)l * 1024 * 1536, 1536, M, 1024, 1536, C.bid, C.G, e);
        PHASE_END
        PHASE_BEGIN
            if (!(TEST_MASK & 32)) {} else if (l + 1 < DEPTH) { const float* g = ((l + 1) & 1) ? args.in[8] + ((l + 1) >> 1) * D : args.in[2] + ((l + 1) >> 1) * D;
                for (int r = gw; r < M; r += NGW) rms_row_to_bf16(C.out + (size_t)r * D, g, HN + (size_t)r * D, C.lane); }
            else { for (int r = gw; r < M; r += NGW) rms_row_to_f32(C.out + (size_t)r * D, args.in[16], C.out + (size_t)r * D, C.lane); }
        PHASE_END
    }
#undef PHASE_BEGIN
#undef PHASE_END
}

extern "C" void kernel_launch(void* const* d_in, const int* in_sizes, int n_in, void* d_out, int out_size, void* d_ws, size_t ws_size, hipStream_t stream) {
    static int grid = 0;
    if (grid == 0) {
        if (n_in != 17 || out_size != M * D || ws_size < WS_END) { fprintf(stderr, "kernel_launch: unexpected shapes n_in %d out %d ws %zu\n", n_in, out_size, ws_size); grid = -1; return; }
        int dev = 0, cus = 0, per_cu = 0;
        if (hipGetDevice(&dev) != hipSuccess || hipDeviceGetAttribute(&cus, hipDeviceAttributeMultiprocessorCount, dev) != hipSuccess) { grid = -1; return; }
        if (hipFuncSetAttribute((const void*)mk_fwd, hipFuncAttributeMaxDynamicSharedMemorySize, LDS_BYTES) != hipSuccess) { fprintf(stderr, "kernel_launch: hipFuncSetAttribute failed\n"); grid = -1; return; }
        if (hipOccupancyMaxActiveBlocksPerMultiprocessor(&per_cu, (const void*)mk_fwd, NTHR, LDS_BYTES) != hipSuccess || per_cu < 1)
            fprintf(stderr, "kernel_launch: occupancy query reports %d blocks per CU\n", per_cu);
        (void)hipGetLastError();
        grid = cus;
    }
    if (grid < 0) return;
    if (hipMemsetAsync((char*)d_ws + WS_CTL, 0, CTL_ZERO_BYTES, stream) != hipSuccess) return;
    Args a{};
    for (int i = 0; i < 17; ++i) a.in[i] = (const float*)d_in[i];
    a.out = (float*)d_out; a.ws = (unsigned char*)d_ws;
#if MK_ONE_LAUNCH
    a.ph_lo = 0; a.ph_hi = NSTEPS;
    hipLaunchKernelGGL(mk_fwd, dim3(grid), dim3(NTHR), LDS_BYTES, stream, a);
#else
    for (int s = 0; s < NSTEPS; ++s) { a.ph_lo = s; a.ph_hi = s + 1; hipLaunchKernelGGL(mk_fwd, dim3(grid), dim3(NTHR), LDS_BYTES, stream, a); }
#endif
}
```

```cpp
#include <hip/hip_runtime.h>
#include <cstdio>
#include <cstdint>

#ifndef TEST_MASK
#define TEST_MASK 0xFFFF
#endif
#ifndef USE_MFMA_SCAN
#define USE_MFMA_SCAN 1
#endif
#ifndef USE_PG8
#define USE_PG8 1
#endif
#ifndef MK_ONE_LAUNCH
#define MK_ONE_LAUNCH 1
#endif

#define GAS __attribute__((address_space(1)))
#define LAS __attribute__((address_space(3)))
typedef unsigned short bf16;
typedef unsigned v4u __attribute__((ext_vector_type(4)));
typedef unsigned v2u __attribute__((ext_vector_type(2)));
typedef float f32x4 __attribute__((ext_vector_type(4)));
typedef GAS unsigned gu32;
#define RLX_AGENT __ATOMIC_RELAXED, __HIP_MEMORY_SCOPE_AGENT
#define LDS_WAIT() asm volatile("s_waitcnt lgkmcnt(0)" ::: "memory")
#define VM_WAIT() asm volatile("s_waitcnt vmcnt(0)" ::: "memory")

constexpr int NWAVES = 8, NTHR = 512;
constexpr int BATCH = 4, T = 4096, D = 1024, M = BATCH * T, DEPTH = 4;
constexpr int NMEM = 256;
constexpr int NP_E = 3328, NP_O = 2816, NMIX = 1536, NIN_E = 4864, NIN_O = 4352, NIN_O_SRC = 4128;
constexpr int E_QA = 0, E_KA = 512, E_VA = 640, E_QB = 768, E_ZF = 1280, E_ZB = 1792, E_IB = 2304, E_QM = 2816;
constexpr int O_QC = 0, O_KC = 512, O_VC = 1024, O_QM = 2048, O_RF = 2560, O_RB = 2576;
constexpr int X_GA = 0, X_GB = 512, X_GM = 1024, X_GC = 0;
constexpr float EPS = 1e-6f;

constexpr size_t MiB = 1u << 20;
constexpr size_t WS_CTL = 0, CTL_ZERO_BYTES = 1 * MiB;
constexpr size_t WS_WIN = 2 * MiB;
constexpr size_t WS_WOUT = 12 * MiB;
constexpr size_t WS_WKV = 24 * MiB;
constexpr size_t WS_MEMK = 32 * MiB;
constexpr size_t WS_MEMVT = 36 * MiB;
constexpr size_t WS_MEMN = 40 * MiB;
constexpr size_t WS_MIX = 43 * MiB;
constexpr size_t WS_P = 91 * MiB;
constexpr size_t WS_HN = 195 * MiB;
constexpr size_t WS_OE = 195 * MiB;
constexpr size_t WS_OO = 192 * MiB;
constexpr size_t WS_L_E = 195 * MiB, WS_OG_E = 227 * MiB;
constexpr size_t WS_L_O = 179 * MiB, WS_OG_O = 211 * MiB;
constexpr size_t WS_LOGD = 243 * MiB;
constexpr size_t WS_END = 256 * MiB;

constexpr int CW_BAR = 4096;

__device__ __forceinline__ float bf2f(bf16 v) { return __uint_as_float(((unsigned)v) << 16); }
__device__ __forceinline__ unsigned f2bf(float f) { unsigned u = __float_as_uint(f); return (u + 0x7fffu + ((u >> 16) & 1u)) >> 16; }
__device__ __forceinline__ unsigned pk2(float lo, float hi) { return f2bf(lo) | (f2bf(hi) << 16); }
__device__ __forceinline__ float wave_sum(float v) {
#pragma unroll
    for (int o = 1; o < 64; o <<= 1) v += __shfl_xor(v, o);
    return v;
}
__device__ __forceinline__ float wave_max(float v) {
#pragma unroll
    for (int o = 1; o < 64; o <<= 1) v = fmaxf(v, __shfl_xor(v, o));
    return v;
}
__device__ __forceinline__ float sigmoidf_(float z) { return 1.f / (1.f + __expf(-z)); }
__device__ __forceinline__ float siluf_(float z) { return z / (1.f + __expf(-z)); }

#define XB_TMO      128
#define XB_XCNT(j)  (256  + 64 * (j))
#define XB_XSUB(j)  (1280 + 64 * (j))
#define XB_XGEN(j)  (2304 + 64 * (j))
#define XB_TOP      3328
#define XB_TOPGEN   3392
#define XCD_BAR_WORDS 3456
#define XB_SPIN_CAP (1u << 22)
__device__ __forceinline__ unsigned xb_ld(unsigned* p)              { return __hip_atomic_load(p, __ATOMIC_RELAXED, __HIP_MEMORY_SCOPE_AGENT); }
__device__ __forceinline__ unsigned xb_add(unsigned* p, unsigned v) { return __hip_atomic_fetch_add(p, v, __ATOMIC_RELAXED, __HIP_MEMORY_SCOPE_AGENT); }
__device__ __forceinline__ unsigned xb_xcc_id() { return (unsigned)__builtin_amdgcn_s_getreg((3 << 11) | 20) & 0xFu; }
#define XB_SPIN(cond, bar) do { unsigned _sp = 0; while (cond) { __builtin_amdgcn_s_sleep(1); \
    if ((++_sp & 255u) == 0u) { if (xb_ld(&(bar)[XB_TMO])) break; if (_sp > XB_SPIN_CAP) { atomicAdd(&(bar)[XB_TMO], 1u); break; } } } } while (0)
struct XcdBarrier { unsigned* bar; unsigned x; volatile LAS unsigned* st; };
__device__ __forceinline__ XcdBarrier xcd_barrier_post(unsigned* bar, volatile LAS unsigned* st) {
    XcdBarrier b; b.bar = bar; b.x = xb_xcc_id(); b.st = st;
    if (threadIdx.x == 0) (void)xb_add(&bar[XB_XCNT(b.x)], 1u);
    return b;
}
__device__ __forceinline__ void xcd_barrier_complete(unsigned* bar, unsigned x, unsigned& nloc, unsigned& nx) {
    const unsigned G = gridDim.x * gridDim.y * gridDim.z;
    unsigned sum, cnt, mine, sp = 0u;
    for (;;) {
        sum = 0u; cnt = 0u; mine = 0u;
#pragma unroll
        for (unsigned j = 0; j < 16; ++j) { const unsigned c = xb_ld(&bar[XB_XCNT(j)]); sum += c; cnt += (c > 0u) ? 1u : 0u; mine = (j == x) ? c : mine; }
        if (sum == G) break;
        __builtin_amdgcn_s_sleep(1);
        if ((++sp & 255u) == 0u) { if (xb_ld(&bar[XB_TMO])) break; if (sp > XB_SPIN_CAP) { atomicAdd(&bar[XB_TMO], 1u); break; } }
    }
    nloc = mine > 0u ? mine : 1u; nx = cnt > 0u ? cnt : 1u;
}
__device__ __forceinline__ void xcd_barrier(const XcdBarrier& b) {
    asm volatile("s_waitcnt vmcnt(0)" ::: "memory");
    __syncthreads();
    if (threadIdx.x == 0) {
        unsigned* bar = b.bar; unsigned bx = b.x; asm volatile("" : "+s"(bar), "+s"(bx));
        __builtin_amdgcn_s_waitcnt(0);
        unsigned nloc = b.st[0], nx = b.st[1];
        if (nloc == 0u) { xcd_barrier_complete(bar, bx, nloc, nx); b.st[0] = nloc; b.st[1] = nx; }
        const unsigned old = xb_add(&bar[XB_XSUB(bx)], 1u);
        const unsigned gen = old / nloc;
        if (old + 1u == (gen + 1u) * nloc) {
            __builtin_amdgcn_fence(__ATOMIC_RELEASE, "agent");
            asm volatile("s_waitcnt vmcnt(0)" ::: "memory");
            const unsigned og = xb_add(&bar[XB_TOP], 1u);
            const unsigned tg = og / nx;
            if (og + 1u == (tg + 1u) * nx) xb_add(&bar[XB_TOPGEN], 1u);
            else XB_SPIN(xb_ld(&bar[XB_TOPGEN]) == tg, bar);
            __builtin_amdgcn_fence(__ATOMIC_ACQUIRE, "agent");
            xb_add(&bar[XB_XGEN(bx)], 1u);
            asm volatile("s_waitcnt vmcnt(0)" ::: "memory");
        } else {
            XB_SPIN(xb_ld(&bar[XB_XGEN(bx)]) == gen, bar);
            __builtin_amdgcn_fence(__ATOMIC_ACQUIRE, "agent");
            asm volatile("s_waitcnt vmcnt(0)" ::: "memory");
        }
    }
    __syncthreads();
}

constexpr int RING_BYTES = 131072;
constexpr int MISC_OFF = RING_BYTES + 320;
constexpr int LDS_BYTES = 147456;

struct Args { const float* in[17]; float* out; unsigned char* ws; int ph_lo, ph_hi; };
static_assert(sizeof(Args) == 17 * 8 + 8 + 8 + 8, "Args has no padding");

struct Ctx {
    LAS unsigned char* lds;
    int tid, lane, wave, G, bid;
    float* out; unsigned char* ws;
};

__device__ __forceinline__ void transpose_item(const float* W, int K, int N, bf16* WT, int k0, int n0, int drow0, LAS float* scr, int lane) {
    asm volatile("" : "+v"(lane));
#pragma unroll 8
    for (int i = 0; i < 32; ++i) { const int kk = 2 * i + (lane >> 5); scr[kk * 33 + (lane & 31)] = W[(size_t)(k0 + kk) * N + n0 + (lane & 31)]; }
    LDS_WAIT(); asm volatile("" ::: "memory");
    const int c = lane & 7;
#pragma unroll
    for (int j = 0; j < 4; ++j) { const int n = (lane >> 3) + 8 * j; const LAS float* s = scr + (8 * c) * 33 + n;
        v4u o; o.x = pk2(s[0 * 33], s[1 * 33]); o.y = pk2(s[2 * 33], s[3 * 33]); o.z = pk2(s[4 * 33], s[5 * 33]); o.w = pk2(s[6 * 33], s[7 * 33]);
        *(GAS v4u*)(WT + (size_t)(drow0 + n) * K + k0 + 8 * c) = o; }
    LDS_WAIT(); asm volatile("" ::: "memory");
}
__device__ __forceinline__ int map_even(int n0) {
    if (n0 < 768) return n0;
    if (n0 < 1280) return NP_E + X_GA + (n0 - 768);
    if (n0 < 3328) return E_QB + (n0 - 1280);
    if (n0 < 3840) return NP_E + X_GB + (n0 - 3328);
    if (n0 < 4352) return E_QM + (n0 - 3840);
    return NP_E + X_GM + (n0 - 4352);
}
__device__ __forceinline__ int map_odd(int n0) {
    if (n0 < 2048) return n0;
    if (n0 < 3072) return NP_O + X_GC + (n0 - 2048);
    if (n0 < 3104) return O_RF + (n0 - 3072);
    if (n0 < 3616) return O_QM + (n0 - 3104);
    return NP_O + X_GM + (n0 - 3616);
}
__device__ __forceinline__ int win_items(int l) { return (l & 1) ? (16 * (NIN_O_SRC / 32) + 224) : (16 * (NIN_E / 32)); }
__device__ __forceinline__ void win_item(const Ctx& C, const float* w_even, const float* w_odd, int l, int it, LAS float* scr) {
    bf16* WT = (bf16*)(C.ws + WS_WIN);
    if (l & 1) {
        const int nconv = 16 * (NIN_O_SRC / 32);
        if (it < nconv) { const int nb = it % (NIN_O_SRC / 32), kb = it / (NIN_O_SRC / 32);
            transpose_item(w_odd + (size_t)(l >> 1) * D * NIN_O_SRC, D, NIN_O_SRC, WT, kb * 64, nb * 32, map_odd(nb * 32), scr, C.lane); }
        else { const int r = 2592 + (it - nconv);
            GAS v4u* p = (GAS v4u*)(WT + (size_t)r * D); v4u z = {0u, 0u, 0u, 0u}; p[C.lane] = z; p[C.lane + 64] = z; }
    } else {
        const int nb = it % (NIN_E / 32), kb = it / (NIN_E / 32);
        transpose_item(w_even + (size_t)(l >> 1) * D * NIN_E, D, NIN_E, WT, kb * 64, nb * 32, map_even(nb * 32), scr, C.lane);
    }
}
__device__ __forceinline__ void rms_row_to_bf16(const float* xrow, const float* g, bf16* orow, int lane) {
    asm volatile("" : "+v"(lane));
    const GAS f32x4* xr = (const GAS f32x4*)xrow + lane; const GAS f32x4* gr = (const GAS f32x4*)g + lane;
    f32x4 v[4]; float s = 0.f;
#pragma unroll
    for (int j = 0; j < 4; ++j) { v[j] = xr[64 * j]; s += (v[j].x * v[j].x + v[j].y * v[j].y) + (v[j].z * v[j].z + v[j].w * v[j].w); }
    const float rstd = 1.f / sqrtf(wave_sum(s) * (1.f / D) + EPS);
    GAS unsigned long long* o8 = (GAS unsigned long long*)orow + lane;
#pragma unroll
    for (int j = 0; j < 4; ++j) { const f32x4 gg = gr[64 * j];
        o8[64 * j] = (unsigned long long)pk2(v[j].x * rstd * gg.x, v[j].y * rstd * gg.y) | ((unsigned long long)pk2(v[j].z * rstd * gg.z, v[j].w * rstd * gg.w) << 32); }
}
__device__ __forceinline__ void rms_row_to_f32(const float* xrow, const float* g, float* orow, int lane) {
    asm volatile("" : "+v"(lane));
    const GAS f32x4* xr = (const GAS f32x4*)xrow + lane; const GAS f32x4* gr = (const GAS f32x4*)g + lane;
    f32x4 v[4]; float s = 0.f;
#pragma unroll
    for (int j = 0; j < 4; ++j) { v[j] = xr[64 * j]; s += (v[j].x * v[j].x + v[j].y * v[j].y) + (v[j].z * v[j].z + v[j].w * v[j].w); }
    const float rstd = 1.f / sqrtf(wave_sum(s) * (1.f / D) + EPS);
    GAS f32x4* o = (GAS f32x4*)orow + lane;
#pragma unroll
    for (int j = 0; j < 4; ++j) { const f32x4 gg = gr[64 * j]; o[64 * j] = v[j] * rstd * gg; }
}

__device__ __forceinline__ void phase_prep(const Ctx& C, const Args& A) {
    LAS float* scr = (LAS float*)(C.lds + C.wave * 16384);
    const int gw = C.bid * NWAVES + C.wave, NGW = C.G * NWAVES;
    constexpr int I_OUT = (1536 / 64) * (1024 / 32), I_KV = (1024 / 64) * (1024 / 32);
    const int I_IN = win_items(0);
    const int total = 4 * I_OUT + 4 * I_KV + I_IN + 1024 + M;
    for (int it = gw; it < total; it += NGW) {
        int r = it;
        if (r < 4 * I_OUT) { const int l = r / I_OUT; r -= l * I_OUT; const int nb = r % 32, kb = r / 32;
            const float* W = (l & 1) ? A.in[13] + (size_t)(l >> 1) * 1536 * 1024 : A.in[7] + (size_t)(l >> 1) * 1536 * 1024;
            transpose_item(W, 1536, 1024, (bf16*)(C.ws + WS_WOUT) + (size_t)l * 1024 * 1536, kb * 64, nb * 32, nb * 32, scr, C.lane); continue; }
        r -= 4 * I_OUT;
        if (r < 4 * I_KV) { const int l = r / I_KV; r -= l * I_KV; const int nb = r % 32, kb = r / 32;
            transpose_item(A.in[15] + (size_t)l * 1024 * 1024, 1024, 1024, (bf16*)(C.ws + WS_WKV) + (size_t)l * 1024 * 1024, kb * 64, nb * 32, nb * 32, scr, C.lane); continue; }
        r -= 4 * I_KV;
        if (r < I_IN) { win_item(C, A.in[3], A.in[9], 0, r, scr); continue; }
        r -= I_IN;
        if (r < 1024) { rms_row_to_bf16(A.in[1] + (size_t)r * D, A.in[14], (bf16*)(C.ws + WS_MEMN) + (size_t)r * D, C.lane); continue; }
        r -= 1024;
        rms_row_to_bf16(A.in[0] + (size_t)r * D, A.in[2], (bf16*)(C.ws + WS_HN) + (size_t)r * D, C.lane);
    }
}

namespace pg8 {
#define PG8_LAS __attribute__((address_space(3)))
typedef unsigned short bf16_t;
typedef short bf16x8 __attribute__((ext_vector_type(8)));
typedef float f32x4 __attribute__((ext_vector_type(4)));
typedef unsigned u32x4 __attribute__((ext_vector_type(4)));
constexpr int BM = 256, BK = 64, HALF = 128, HTB = HALF * BK * 2  , STAGE_BYTES = 8 * HTB, NXCD = 8, WGM = 8;

__host__ __device__ __forceinline__ int lds_byte(int r, int c) { const int st = (r >> 4) * 2 + (c >> 5), rr = r & 15, cc = c & 31, ob = rr * 64 + cc * 2; return st * 1024 + (ob ^ (((ob >> 9) & 1) << 5)); }
__host__ __device__ __forceinline__ void stage_rc(int b, int& R, int& C) { const int st = b / 1024, sb = b % 1024, swz = sb ^ (((sb >> 9) & 1) << 5); R = (st >> 1) * 16 + swz / 64; C = (st & 1) * 32 + (swz % 64) / 2; }
__host__ __device__ __forceinline__ int perm32(int rho) { const int n = rho >> 4, i = rho & 15; return 8 * (i >> 2) + 4 * n + (i & 3); }

struct Unit { int pm, pn; };
struct Gemm { const bf16_t* A; const bf16_t* Bt; int M, N, K; };

struct StaticOrder {
    int nM, nN, nwg, G, c;
    __host__ __device__ void init(int M, int N, int G_, int c_) { nM = M / BM; nN = N / BM; nwg = nM * nN; G = G_; c = c_; }
    __host__ __device__ bool next(int i, Unit& u) const {
        const long L = (long)i * G + c; if (L >= nwg) return false;
        int wgid = (int)L; { const int q = nwg / NXCD, r = nwg % NXCD, xcd = wgid % NXCD, off = wgid / NXCD; wgid = (xcd < r ? xcd * (q + 1) : r * (q + 1) + (xcd - r) * q) + off; }
        const int nig = WGM * nN, gid = wgid / nig, fm = gid * WGM, gsz = (nM - fm) < WGM ? (nM - fm) : WGM;
        u.pm = fm + ((wgid % nig) % gsz); u.pn = (wgid % nig) / gsz; return true;
    }
    __device__ __forceinline__ void a_ready(const Unit&) const {}
    __device__ __forceinline__ void done(const Unit&) const {}
};

__device__ __forceinline__ unsigned cvt_pk_bf16(float lo, float hi) { unsigned r; asm volatile("v_cvt_pk_bf16_f32 %0, %1, %2" : "=v"(r) : "v"(lo), "v"(hi)); return r; }

template <class Epi, class Sched, bool ALIGN_EPI = false, bool SP2 = false>
__device__ __forceinline__ void gemm_phase(PG8_LAS unsigned char* lds, const Gemm g, const Sched& S, const Epi& E) {
    int tid = threadIdx.x; asm volatile("" : "+v"(tid));
    const int wid = __builtin_amdgcn_readfirstlane(tid >> 6), lane = tid & 63, wr = wid >> 2, wc = wid & 3, fr = lane & 15, fq = lane >> 4;
    const int K = g.K, nt = K / BK;
    unsigned voffA[2], voffB[2];
#pragma unroll
    for (int i = 0; i < 2; ++i) { int R, C; stage_rc(tid * 16 + i * 8192, R, C); const int Rb = Epi::PERM ? ((R & ~31) + perm32(R & 31)) : R;
        voffA[i] = (unsigned)(R * K + C) * 2u; voffB[i] = (unsigned)(Rb * K + C) * 2u; }
    const size_t kstep = (size_t)(BK * 2);
    const size_t hstep = (size_t)HALF * K * 2;
    const size_t tstep = 2 * hstep;
    const unsigned ldsw = (unsigned)wid * 1024u;
    const int aoff = lds_byte(wr * 64 + fr, fq * 8), boff = lds_byte(wc * 32 + fr, fq * 8);
#define PG8_SA(b, h) (((b) * 2 + (h)) * HTB)
#define PG8_SB(b, h) ((4 + (b) * 2 + (h)) * HTB)
#define PG8_STAGE(bufoff, gbase, voff) do { _Pragma("unroll") for (int _i = 0; _i < 2; ++_i) \
        __builtin_amdgcn_global_load_lds((const unsigned*)((const char*)(gbase) + (voff)[_i]), (PG8_LAS unsigned*)(lds + (bufoff) + ldsw + _i * 8192), 16, 0, 0); } while (0)
#define PG8_LDA(dst, b, h) do { _Pragma("unroll") for (int m = 0; m < 4; ++m) _Pragma("unroll") for (int k = 0; k < 2; ++k) dst[m][k] = *(const PG8_LAS bf16x8*)(lds + PG8_SA(b, h) + aoff + m * 2048 + k * 1024); } while (0)
#define PG8_LDB(dst, b, h) do { _Pragma("unroll") for (int n = 0; n < 2; ++n) _Pragma("unroll") for (int k = 0; k < 2; ++k) dst[n][k] = *(const PG8_LAS bf16x8*)(lds + PG8_SB(b, h) + boff + n * 2048 + k * 1024); } while (0)
#define PG8_MMA(ai, bj, At, Bt) do { __builtin_amdgcn_s_setprio(1); _Pragma("unroll") for (int m = 0; m < 4; ++m) _Pragma("unroll") for (int n = 0; n < 2; ++n) _Pragma("unroll") for (int k = 0; k < 2; ++k) \
        acc[ai][bj][m][n] = __builtin_amdgcn_mfma_f32_16x16x32_bf16(Bt[n][k], At[m][k], acc[ai][bj][m][n], 0, 0, 0); __builtin_amdgcn_s_setprio(0); } while (0)
#define PG8_WAIT_V(n) asm volatile("s_waitcnt vmcnt(" #n ")" ::: "memory")
#define PG8_WAIT_L(n) asm volatile("s_waitcnt lgkmcnt(" #n ")" ::: "memory")
#define PG8_BAR __builtin_amdgcn_s_barrier()
#define PG8_SCHED __builtin_amdgcn_sched_barrier(0)
    Unit cur, nxt; int ui = 0;
    if (!S.next(0, cur)) return;
    f32x4 acc[2][2][4][2];
#pragma unroll
    for (int a = 0; a < 2; ++a)
#pragma unroll
        for (int b = 0; b < 2; ++b)
#pragma unroll
            for (int m = 0; m < 4; ++m)
#pragma unroll
                for (int n = 0; n < 2; ++n) acc[a][b][m][n] = (f32x4){0.f, 0.f, 0.f, 0.f};
    bf16x8 At[4][2], B0[2][2], B1[2][2];
    const char* cA = (const char*)g.A + (size_t)cur.pm * tstep; const char* cB = (const char*)g.Bt + (size_t)cur.pn * tstep;
    S.a_ready(cur);
    if constexpr (SP2) {
        PG8_STAGE(PG8_SB(0, 0), cB, voffB); PG8_STAGE(PG8_SB(0, 1), cB + hstep, voffB); PG8_STAGE(PG8_SA(0, 0), cA, voffA); PG8_STAGE(PG8_SA(0, 1), cA + hstep, voffA);
        if (wr == 1) PG8_BAR;
        PG8_WAIT_V(2); PG8_BAR;
        PG8_STAGE(PG8_SB(1, 0), cB + kstep, voffB); PG8_STAGE(PG8_SA(1, 0), cA + kstep, voffA); PG8_STAGE(PG8_SB(1, 1), cB + hstep + kstep, voffB);
        PG8_WAIT_V(6); PG8_BAR;
    } else {
        PG8_STAGE(PG8_SB(0, 0), cB, voffB); PG8_STAGE(PG8_SA(0, 0), cA, voffA); PG8_STAGE(PG8_SB(0, 1), cB + hstep, voffB); PG8_STAGE(PG8_SA(0, 1), cA + hstep, voffA);
        if (wr == 1) PG8_BAR;
        PG8_WAIT_V(4); PG8_BAR;
        PG8_STAGE(PG8_SB(1, 0), cB + kstep, voffB); PG8_STAGE(PG8_SA(1, 0), cA + kstep, voffA); PG8_STAGE(PG8_SB(1, 1), cB + hstep + kstep, voffB);
        PG8_WAIT_V(6); PG8_BAR;
    }
    for (;;) {
        const bool has_next = S.next(ui + 1, nxt);
        const char* nA = has_next ? (const char*)g.A + (size_t)nxt.pm * tstep : cA; const char* nB = has_next ? (const char*)g.Bt + (size_t)nxt.pn * tstep : cB;
        for (int t = 0; t < nt; t += 2) {
            const bool last = (t == nt - 2);
            const char* a1 = cA + (size_t)(t + 1) * kstep;
            const char* a2 = last ? nA : cA + (size_t)(t + 2) * kstep; const char* b2 = last ? nB : cB + (size_t)(t + 2) * kstep;
            const char* a3 = a2 + kstep; const char* b3 = b2 + kstep;
            if (last && has_next) S.a_ready(nxt);
            if constexpr (SP2) {
            PG8_LDB(B0, 0, 0); PG8_LDB(B1, 0, 1); PG8_SCHED; PG8_LDA(At, 0, 0); PG8_STAGE(PG8_SA(1, 1), a1 + hstep, voffA);
            PG8_WAIT_V(8); PG8_WAIT_L(0); PG8_BAR; PG8_MMA(0, 0, At, B0); PG8_MMA(0, 1, At, B1); PG8_BAR; PG8_SCHED;
            PG8_LDA(At, 0, 1); PG8_STAGE(PG8_SB(0, 0), b2, voffB); PG8_STAGE(PG8_SB(0, 1), b2 + hstep, voffB); PG8_STAGE(PG8_SA(0, 0), a2, voffA);
            PG8_WAIT_V(8); PG8_WAIT_L(0); PG8_BAR; PG8_MMA(1, 0, At, B0); PG8_MMA(1, 1, At, B1); PG8_BAR; PG8_SCHED;
            PG8_LDB(B0, 1, 0); PG8_LDB(B1, 1, 1); PG8_SCHED; PG8_LDA(At, 1, 0); PG8_STAGE(PG8_SA(0, 1), a2 + hstep, voffA);
            PG8_WAIT_V(8); PG8_WAIT_L(0); PG8_BAR; PG8_MMA(0, 0, At, B0); PG8_MMA(0, 1, At, B1); PG8_BAR; PG8_SCHED;
            PG8_LDA(At, 1, 1); PG8_STAGE(PG8_SB(1, 0), b3, voffB); PG8_STAGE(PG8_SB(1, 1), b3 + hstep, voffB); PG8_STAGE(PG8_SA(1, 0), a3, voffA);
            PG8_WAIT_V(8); PG8_WAIT_L(0); PG8_BAR; PG8_MMA(1, 0, At, B0); PG8_MMA(1, 1, At, B1); PG8_BAR; PG8_SCHED;
            } else {
            PG8_LDB(B0, 0, 0); PG8_SCHED; PG8_LDA(At, 0, 0); PG8_STAGE(PG8_SA(1, 1), a1 + hstep, voffA);
            PG8_WAIT_L(8); PG8_BAR; PG8_WAIT_L(0); PG8_MMA(0, 0, At, B0); PG8_BAR; PG8_SCHED;
            PG8_LDB(B1, 0, 1); PG8_STAGE(PG8_SB(0, 0), b2, voffB);
            PG8_BAR; PG8_WAIT_L(0); PG8_MMA(0, 1, At, B1); PG8_BAR;
            PG8_LDA(At, 0, 1); PG8_STAGE(PG8_SA(0, 0), a2, voffA);
            PG8_BAR; PG8_WAIT_L(0); PG8_MMA(1, 0, At, B0); PG8_BAR; PG8_SCHED;
            PG8_STAGE(PG8_SB(0, 1), b2 + hstep, voffB);
            PG8_WAIT_V(6); PG8_BAR; PG8_MMA(1, 1, At, B1); PG8_BAR;
            PG8_LDB(B0, 1, 0); PG8_SCHED; PG8_LDA(At, 1, 0); PG8_STAGE(PG8_SA(0, 1), a2 + hstep, voffA);
            PG8_WAIT_L(8); PG8_BAR; PG8_WAIT_L(0); PG8_MMA(0, 0, At, B0); PG8_BAR; PG8_SCHED;
            PG8_LDB(B1, 1, 1); PG8_STAGE(PG8_SB(1, 0), b3, voffB);
            PG8_BAR; PG8_WAIT_L(0); PG8_MMA(0, 1, At, B1); PG8_BAR;
            PG8_LDA(At, 1, 1); PG8_STAGE(PG8_SA(1, 0), a3, voffA);
            PG8_BAR; PG8_WAIT_L(0); PG8_MMA(1, 0, At, B0); PG8_BAR; PG8_SCHED;
            PG8_STAGE(PG8_SB(1, 1), b3 + hstep, voffB);
            PG8_WAIT_V(6); PG8_BAR; PG8_MMA(1, 1, At, B1); PG8_BAR;
            }
        }
        if constexpr (ALIGN_EPI) { if (wr == 0) PG8_BAR; }
        if constexpr (!Epi::AFTER_DRAIN) { E(acc, cur, wr, wc, fr, fq); S.done(cur); }
        if (!has_next) break;
#pragma unroll
        for (int a = 0; a < 2; ++a)
#pragma unroll
            for (int b = 0; b < 2; ++b)
#pragma unroll
                for (int m = 0; m < 4; ++m)
#pragma unroll
                    for (int n = 0; n < 2; ++n) acc[a][b][m][n] = (f32x4){0.f, 0.f, 0.f, 0.f};
        cur = nxt; cA = nA; cB = nB; ++ui;
        if constexpr (ALIGN_EPI) { if (wr == 1) PG8_BAR; }
    }
    PG8_WAIT_V(0);
    if constexpr (!ALIGN_EPI) { if (wr == 0) PG8_BAR; }
    PG8_BAR;
    if constexpr (Epi::AFTER_DRAIN) { E.fused(acc, cur, wr, wc, fr, fq, lds, wid, lane); S.done(cur); }
#undef PG8_SA
#undef PG8_SB
#undef PG8_STAGE
#undef PG8_LDA
#undef PG8_LDB
#undef PG8_MMA
#undef PG8_WAIT_V
#undef PG8_WAIT_L
#undef PG8_BAR
#undef PG8_SCHED
}

struct EpiProj {
    static constexpr bool PERM = true, AFTER_DRAIN = false;
    bf16_t* P; bf16_t* MIXp; int np_cols; int npt;
    __device__ __forceinline__ void operator()(const f32x4 (&acc)[2][2][4][2], const Unit& u, int wr, int wc, int fr, int fq) const {
        const int row0 = u.pm * BM + wr * 64 + fr;
        bf16_t* base; int ldc, colt;
        if (u.pn < npt) { base = P; ldc = np_cols; colt = u.pn * BM; } else { base = MIXp; ldc = 1536; colt = (u.pn - npt) * BM; }
        const int col0 = colt + wc * 32 + 8 * fq;
#pragma unroll
        for (int ai = 0; ai < 2; ++ai)
#pragma unroll
            for (int m = 0; m < 4; ++m) { bf16_t* rowp = base + (size_t)(row0 + ai * HALF + m * 16) * ldc + col0;
#pragma unroll
                for (int bj = 0; bj < 2; ++bj) { const f32x4 v0 = acc[ai][bj][m][0], v1 = acc[ai][bj][m][1];
                    u32x4 w; w.x = cvt_pk_bf16(v0[0], v0[1]); w.y = cvt_pk_bf16(v0[2], v0[3]); w.z = cvt_pk_bf16(v1[0], v1[1]); w.w = cvt_pk_bf16(v1[2], v1[3]);
                    *(u32x4*)(rowp + bj * HALF) = w; } }
    }
};
struct EpiResidF32 {
    static constexpr bool PERM = false, AFTER_DRAIN = false;
    const float* xi; float* xo;
    __device__ __forceinline__ void operator()(const f32x4 (&acc)[2][2][4][2], const Unit& u, int wr, int wc, int fr, int fq) const {
        const int col0 = u.pn * BM + wc * 32 + 4 * fq;
#pragma unroll
        for (int ai = 0; ai < 2; ++ai)
#pragma unroll
            for (int m = 0; m < 4; ++m) { const size_t off = (size_t)(u.pm * BM + ai * HALF + wr * 64 + m * 16 + fr) * 1024 + col0;
#pragma unroll
                for (int bj = 0; bj < 2; ++bj)
#pragma unroll
                    for (int n = 0; n < 2; ++n) { const f32x4 b = *(const f32x4*)(xi + off + bj * HALF + n * 16); *(f32x4*)(xo + off + bj * HALF + n * 16) = b + acc[ai][bj][m][n]; } }
    }
};
}

template <class Epi>
__device__ __forceinline__ void gemm_naive(const Ctx& C, const bf16* A, int lda, const bf16* Bt, int ldb, int Mr, int Nr, int K, int tile0, int tstride, const Epi& E) {
    LAS float* As = (LAS float*)C.lds;
    LAS float* Bs = As + 32 * 132;
    const int tid = C.tid, ty = tid >> 4, tx = tid & 15;
    const int nMt = Mr / 128, nNt = Nr / 128, ntiles = nMt * nNt;
    for (int tile = tile0; tile < ntiles; tile += tstride) {
        const int tm = tile % nMt, tn = tile / nMt;
        float acc[4][8];
#pragma unroll
        for (int i = 0; i < 4; ++i)
#pragma unroll
            for (int j = 0; j < 8; ++j) acc[i][j] = 0.f;
        const int lr = tid >> 2, lk = (tid & 3) * 8;
        for (int k0 = 0; k0 < K; k0 += 32) {
            const v4u av = *(const GAS v4u*)(A + (size_t)(tm * 128 + lr) * lda + k0 + lk);
            const v4u bv = *(const GAS v4u*)(Bt + (size_t)(tn * 128 + lr) * ldb + k0 + lk);
            __syncthreads();
#pragma unroll
            for (int j = 0; j < 4; ++j) {
                As[(lk + 2 * j) * 132 + lr] = __uint_as_float(av[j] << 16); As[(lk + 2 * j + 1) * 132 + lr] = __uint_as_float(av[j] & 0xffff0000u);
                Bs[(lk + 2 * j) * 132 + lr] = __uint_as_float(bv[j] << 16); Bs[(lk + 2 * j + 1) * 132 + lr] = __uint_as_float(bv[j] & 0xffff0000u);
            }
            __syncthreads();
#pragma unroll 2
            for (int k = 0; k < 32; ++k) {
                const f32x4 a = *(const LAS f32x4*)(As + k * 132 + ty * 4);
                const f32x4 b0 = *(const LAS f32x4*)(Bs + k * 132 + tx * 8), b1 = *(const LAS f32x4*)(Bs + k * 132 + tx * 8 + 4);
#pragma unroll
                for (int i = 0; i < 4; ++i) {
                    acc[i][0] += a[i] * b0[0]; acc[i][1] += a[i] * b0[1]; acc[i][2] += a[i] * b0[2]; acc[i][3] += a[i] * b0[3];
                    acc[i][4] += a[i] * b1[0]; acc[i][5] += a[i] * b1[1]; acc[i][6] += a[i] * b1[2]; acc[i][7] += a[i] * b1[3];
                }
            }
        }
#pragma unroll
        for (int i = 0; i < 4; ++i) E(tm * 128 + ty * 4 + i, tn * 128 + tx * 8, acc[i]);
    }
    __syncthreads();
}
struct EpiStoreBf16 {
    bf16* O; int ldc;
    __device__ __forceinline__ void operator()(int m, int n0, const float (&v)[8]) const {
        v4u w; w.x = pk2(v[0], v[1]); w.y = pk2(v[2], v[3]); w.z = pk2(v[4], v[5]); w.w = pk2(v[6], v[7]);
        *(GAS v4u*)(O + (size_t)m * ldc + n0) = w; }
};
struct EpiInProj {
    bf16* P; bf16* MIX; int NP;
    __device__ __forceinline__ void operator()(int m, int n0, const float (&v)[8]) const {
        v4u w; w.x = pk2(v[0], v[1]); w.y = pk2(v[2], v[3]); w.z = pk2(v[4], v[5]); w.w = pk2(v[6], v[7]);
        if (n0 < NP) *(GAS v4u*)(P + (size_t)m * NP + n0) = w; else *(GAS v4u*)(MIX + (size_t)m * NMIX + (n0 - NP)) = w; }
};
struct EpiResid {
    const float* xi; float* xo;
    __device__ __forceinline__ void operator()(int m, int n0, const float (&v)[8]) const {
        const f32x4 a = *(const GAS f32x4*)(xi + (size_t)m * D + n0), b = *(const GAS f32x4*)(xi + (size_t)m * D + n0 + 4);
        f32x4 o0 = {a[0] + v[0], a[1] + v[1], a[2] + v[2], a[3] + v[3]}, o1 = {b[0] + v[4], b[1] + v[5], b[2] + v[6], b[3] + v[7]};
        *(GAS f32x4*)(xo + (size_t)m * D + n0) = o0; *(GAS f32x4*)(xo + (size_t)m * D + n0 + 4) = o1; }
};

__device__ __forceinline__ float dot8(const v4u w, const LAS float* q) {
    const f32x4 q0 = *(const LAS f32x4*)q, q1 = *(const LAS f32x4*)(q + 4);
    return (__uint_as_float(w[0] << 16) * q0[0] + __uint_as_float(w[0] & 0xffff0000u) * q0[1]) + (__uint_as_float(w[1] << 16) * q0[2] + __uint_as_float(w[1] & 0xffff0000u) * q0[3])
         + (__uint_as_float(w[2] << 16) * q1[0] + __uint_as_float(w[2] & 0xffff0000u) * q1[1]) + (__uint_as_float(w[3] << 16) * q1[2] + __uint_as_float(w[3] & 0xffff0000u) * q1[3]);
}
__device__ __forceinline__ void naive_winattn_item(const Ctx& C, const float* sink, int item, LAS float* pw) {
    const bf16* P = (const bf16*)(C.ws + WS_P); bf16* MIX = (bf16*)(C.ws + WS_MIX);
    int lane = C.lane; asm volatile("" : "+v"(lane));
    const int hq = item & 7, m = item >> 3, t = m & (T - 1), b = m >> 12, n = hq >> 2;
    const float slope = exp2f(-(float)(hq + 1)), sk = sink[hq];
    LAS float* qs = pw + 320;
    qs[lane] = bf2f(P[(size_t)m * NP_E + E_QA + hq * 64 + lane]);
    LDS_WAIT(); asm volatile("" ::: "memory");
    float mx = -3e38f;
#pragma unroll 1
    for (int i = 0; i < 5; ++i) {
        const int j = lane + 64 * i, s = t - 128 + j; const bool valid = (j <= 256) && (s >= 0) && (s < T);
        float acc = -3e38f;
        if (valid) { const GAS v4u* kp = (const GAS v4u*)(P + (size_t)(b * T + s) * NP_E + E_KA + n * 64); acc = 0.f;
#pragma unroll
            for (int jj = 0; jj < 8; ++jj) acc += dot8(kp[jj], qs + 8 * jj);
            acc = acc * 0.125f - slope * fabsf((float)(t - s)); mx = fmaxf(mx, acc); }
        if (j <= 256) pw[j] = acc;
    }
    mx = fmaxf(wave_max(mx), sk);
    LDS_WAIT(); asm volatile("" ::: "memory");
    float sum = 0.f;
#pragma unroll 1
    for (int i = 0; i < 5; ++i) { const int j = lane + 64 * i; if (j <= 256) { const float sc = pw[j]; const float p = (sc > -1e38f) ? __expf(sc - mx) : 0.f; sum += p; pw[j] = p; } }
    sum = wave_sum(sum) + __expf(sk - mx);
    LDS_WAIT(); asm volatile("" ::: "memory");
    float o = 0.f;
    for (int j = 0; j <= 256; ++j) { const int s = t - 128 + j; if (s < 0 || s >= T) continue;
        o += pw[j] * bf2f(P[(size_t)(b * T + s) * NP_E + E_VA + n * 64 + lane]); }
    o /= sum;
    bf16* gp = MIX + (size_t)m * NMIX + X_GA + hq * 64 + lane;
    *gp = (bf16)f2bf(o * siluf_(bf2f(*gp)));
    LDS_WAIT(); asm volatile("" ::: "memory");
}
__device__ __forceinline__ void naive_memattn_item(const Ctx& C, int l, int item, LAS float* pw) {
    const int NP = (l & 1) ? NP_O : NP_E, QOFF = (l & 1) ? O_QM : E_QM;
    const bf16* P = (const bf16*)(C.ws + WS_P); bf16* MIX = (bf16*)(C.ws + WS_MIX);
    const bf16* MK = (const bf16*)(C.ws + WS_MEMK) + (size_t)l * 1024 * 512; const bf16* MVT = (const bf16*)(C.ws + WS_MEMVT) + (size_t)l * 512 * 1024;
    int lane = C.lane; asm volatile("" : "+v"(lane));
    const int h = item & 3, m = item >> 2, b = m >> 12;
    LAS float* qs = pw + 320;
    qs[lane] = bf2f(P[(size_t)m * NP + QOFF + h * 128 + lane]); qs[lane + 64] = bf2f(P[(size_t)m * NP + QOFF + h * 128 + lane + 64]);
    LDS_WAIT(); asm volatile("" ::: "memory");
    float mx = -3e38f;
#pragma unroll 1
    for (int i = 0; i < 4; ++i) { const int s = lane + 64 * i;
        const GAS v4u* kp = (const GAS v4u*)(MK + (size_t)(b * NMEM + s) * 512 + h * 128); float acc = 0.f;
#pragma unroll
        for (int jj = 0; jj < 16; ++jj) acc += dot8(kp[jj], qs + 8 * jj);
        acc *= 0.08838834764831845f; mx = fmaxf(mx, acc); pw[s] = acc; }
    mx = wave_max(mx);
    LDS_WAIT(); asm volatile("" ::: "memory");
    float sum = 0.f;
#pragma unroll 1
    for (int i = 0; i < 4; ++i) { const int s = lane + 64 * i; const float p = __expf(pw[s] - mx); sum += p; pw[s] = p; }
    sum = wave_sum(sum);
    LDS_WAIT(); asm volatile("" ::: "memory");
#pragma unroll 1
    for (int dd = 0; dd < 2; ++dd) { const int d = lane + 64 * dd; const bf16* vp = MVT + (size_t)(h * 128 + d) * 1024 + b * NMEM; float o = 0.f;
#pragma unroll 4
        for (int s = 0; s < NMEM; s += 8) o += dot8(*(const GAS v4u*)(vp + s), pw + s);
        o /= sum;
        bf16* gp = MIX + (size_t)m * NMIX + X_GM + h * 128 + d;
        *gp = (bf16)f2bf(o * siluf_(bf2f(*gp))); }
    LDS_WAIT(); asm volatile("" ::: "memory");
}
template <int ODD>
__device__ __forceinline__ void naive_scan_item(const Ctx& C, const float* lbp, const float* wgu, const float* bgp, int l, int item, LAS float* scr) {
    constexpr int DV = ODD ? 256 : 128, NCG = DV / 32, NP = ODD ? NP_O : NP_E, VOFF = ODD ? O_VC : E_IB, TS = 8;
    int lane = C.lane; asm volatile("" : "+v"(lane));
    const int li = l >> 1, kh = lane >> 5;
    const int cg = item % NCG, h = (item / NCG) & 3, b = item / (NCG * 4);
    const bf16* P = (const bf16*)(C.ws + WS_P);
    float* O = (float*)(C.ws + (ODD ? WS_OO : WS_OE));
    LAS float* fq = scr; LAS float* fk = scr + TS * 128; LAS float* ff = scr + 2 * TS * 128;
    const int col = h * DV + cg * 32 + (lane & 31);
    for (int dir = 0; dir < 2; ++dir) {
        float lbv[2] = {0.f, 0.f}, bg[2] = {0.f, 0.f};
#pragma unroll
        for (int c = 0; c < 2; ++c) { const int ch = h * 128 + lane + 64 * c;
            if (!ODD) { if (li == 1) { const float p0 = lbp[(0 * 2 + dir) * 512 + ch], p1 = lbp[(1 * 2 + dir) * 512 + ch]; lbv[c] = 1.f / (1.f + __expf(p0 - p1)); } }
            else bg[c] = bgp[(li * 2 + dir) * 512 + ch]; }
        const float* wup = wgu + (size_t)(li * 2 + dir) * 16 * 512 + h * 128 + lane;
        float S[64];
#pragma unroll
        for (int k = 0; k < 64; ++k) S[k] = 0.f;
        for (int tb = 0; tb < T; tb += TS) {
#pragma unroll 1
            for (int s = 0; s < TS; ++s) { const int t = dir ? (T - 1 - (tb + s)) : (tb + s); const size_t m = (size_t)b * T + t; const bf16* row = P + m * NP;
#pragma unroll
                for (int c = 0; c < 2; ++c) { const int k = lane + 64 * c, ch = h * 128 + k; float qv, kv, fv;
                    if (!ODD) { const float z = bf2f(row[(dir ? E_ZB : E_ZF) + ch]); const float sg = sigmoidf_(z);
                        fv = lbv[c] + (1.f - lbv[c]) * sg; kv = (1.f - lbv[c]) * (1.f - sg); qv = siluf_(bf2f(row[E_QB + ch])); }
                    else { float pre = bg[c];
#pragma unroll
                        for (int r = 0; r < 16; ++r) pre += bf2f(row[(dir ? O_RB : O_RF) + r]) * wup[r * 512 + 64 * c];
                        const float ls = fminf(pre, 0.f) - log1pf(__expf(-fabsf(pre)));
                        fv = __expf(ls * (1.f / 16.f)); kv = bf2f(row[O_KC + ch]); qv = bf2f(row[O_QC + ch]) * 0.08838834764831845f; }
                    fq[s * 128 + k] = qv; fk[s * 128 + k] = kv; ff[s * 128 + k] = fv; } }
            LDS_WAIT(); asm volatile("" ::: "memory");
#pragma unroll 1
            for (int s = 0; s < TS; ++s) { const int t = dir ? (T - 1 - (tb + s)) : (tb + s); const size_t m = (size_t)b * T + t;
                const float v = bf2f(P[m * NP + VOFF + col]); float o = 0.f;
                const LAS float* pf = ff + s * 128 + kh * 64; const LAS float* pk = fk + s * 128 + kh * 64; const LAS float* pq = fq + s * 128 + kh * 64;
#pragma unroll
                for (int k4 = 0; k4 < 16; ++k4) { const f32x4 f4 = *(const LAS f32x4*)(pf + 4 * k4), k4v = *(const LAS f32x4*)(pk + 4 * k4), q4 = *(const LAS f32x4*)(pq + 4 * k4);
#pragma unroll
                    for (int e = 0; e < 4; ++e) { S[4 * k4 + e] = f4[e] * S[4 * k4 + e] + k4v[e] * v; o += q4[e] * S[4 * k4 + e]; }
                    if ((k4 & 3) == 3) asm volatile("" ::: "memory"); }
                o += __shfl_xor(o, 32);
                float* op = O + m * (4 * DV) + col;
                if (kh == 0) { if (dir) *op += o; else *op = o; } }
            LDS_WAIT(); asm volatile("" ::: "memory");
        }
    }
}
template <int ODD>
__device__ __forceinline__ void naive_gnorm_item(const Ctx& C, const float* gw_, int l, int item) {
    constexpr int DV = ODD ? 256 : 128, NC = DV / 64, GOFF = ODD ? X_GC : X_GB;
    int lane = C.lane; asm volatile("" : "+v"(lane));
    const int li = l >> 1, h = item & 3, m = item >> 2;
    const float* O = (const float*)(C.ws + (ODD ? WS_OO : WS_OE)) + (size_t)m * (4 * DV) + h * DV;
    const float* g = gw_ + li * (4 * DV) + h * DV;
    bf16* MIX = (bf16*)(C.ws + WS_MIX) + (size_t)m * NMIX + GOFF + h * DV;
    float v[NC]; float s = 0.f;
#pragma unroll
    for (int c = 0; c < NC; ++c) { v[c] = O[lane + 64 * c]; s += v[c] * v[c]; }
    const float rstd = 1.f / sqrtf(wave_sum(s) * (1.f / DV) + EPS);
#pragma unroll
    for (int c = 0; c < NC; ++c) { bf16* gp = MIX + lane + 64 * c; *gp = (bf16)f2bf(v[c] * rstd * g[lane + 64 * c] * siluf_(bf2f(*gp))); }
}

namespace scan {
typedef short bf16x8 __attribute__((ext_vector_type(8)));
typedef short s16x4 __attribute__((ext_vector_type(4)));
typedef float f32x16 __attribute__((ext_vector_type(16)));
typedef float f32x2_t __attribute__((ext_vector_type(2)));
typedef __bf16 bf16x2_t __attribute__((ext_vector_type(2)));
typedef short v4i16_t __attribute__((ext_vector_type(4)));
__device__ __forceinline__ unsigned cvtpk(float lo, float hi) { f32x2_t v = {lo, hi}; bf16x2_t b = __builtin_convertvector(v, bf16x2_t); return __builtin_bit_cast(unsigned, b); }
__device__ __forceinline__ s16x4 trd(const LAS unsigned char* p) { return __builtin_bit_cast(s16x4, __builtin_amdgcn_ds_read_tr16_b64_v4i16((LAS v4i16_t*)p)); }
#define SC_MFMA(a, b, c) __builtin_amdgcn_mfma_f32_32x32x16_bf16((a), (b), (c), 0, 0, 0)
__device__ __forceinline__ bf16x8 pack8(const f32x16& x, int s) {
    v4u p; p.x = cvtpk(x[8 * s + 0], x[8 * s + 1]); p.y = cvtpk(x[8 * s + 2], x[8 * s + 3]); p.z = cvtpk(x[8 * s + 4], x[8 * s + 5]); p.w = cvtpk(x[8 * s + 6], x[8 * s + 7]);
    return __builtin_bit_cast(bf16x8, p);
}
__device__ __forceinline__ float expc(float x) { return __expf(fminf(x, 80.f)); }

template <int ODD> struct Geo {
    static constexpr int NH = ODD ? 1 : 2, DVH = ODD ? 256 : 128, KH = 128 * NH, NHG = 4 / NH, SCLEN = ODD ? 256 : 128, NSC = T / SCLEN, NCH = SCLEN / 32;
    static constexpr int NP = ODD ? NP_O : NP_E, QOFF = ODD ? O_QC : E_QB, VOFF = ODD ? O_VC : E_IB, GOFF = ODD ? X_GC : X_GB;
    static constexpr int RSB = KH * 4;
    static constexpr int RSK = KH * 2 + 16;
    static constexpr int RST = KH * 2 + 64;
    static constexpr int RSV = 512 + 64;
    static constexpr int RSO = 260 * 4;
    static constexpr int OFF_B = 0, OFF_Q1 = 34816, OFF_Q2 = OFF_Q1 + 32 * RSK, OFF_K2 = OFF_Q2 + 32 * RSK, OFF_W = OFF_K2 + 32 * RSK, OFF_V = OFF_W + 32 * RST, OFF_D = OFF_V + 32 * RSV, OFF_END = OFF_D + 1024;
    static_assert(OFF_END <= RING_BYTES, "scan LDS map");
    static constexpr size_t L_ITEM = (size_t)DVH * 128;
};
struct ScanPtrs { const bf16* P; bf16* MIX; bf16* L; float* LOGD; bf16* OG; const float* lbp; const float* wgu; const float* bgp; const float* gnw; };

template <int ODD, int MODE>
__device__ __forceinline__ void scan_item(const Ctx& C, const ScanPtrs& sp, int li, int b, int hg, int sc, int dir0) {
    typedef Geo<ODD> G;
    const int tid = C.tid, wave = C.wave; int lane = C.lane; asm volatile("" : "+v"(lane));
    const int r = lane & 31, h = lane >> 5, i16 = lane & 15, q4 = i16 >> 2, p4 = i16 & 3, g1 = (lane >> 4) & 1;
    const int hh = wave / (8 / G::NH), h0 = hg * G::NH;
    const int kc0 = hh * 128, vcol0 = wave * 32;
    LAS unsigned char* lds = C.lds;
    const int sc0 = sc * G::SCLEN;
    const bf16* Pb = sp.P + (size_t)b * T * G::NP;
    f32x16 S[4];
    for (int dd = 0; dd < (MODE ? 2 : 1); ++dd) {
        const int dir = MODE ? dd : dir0;
        float lbv = 0.f, bgv = 0.f, wupv[16]; float logd_acc = 0.f;
        if (tid < G::KH) {
            const int ch = h0 * 128 + tid;
            if (!ODD) { if (li == 1) { const float p0 = sp.lbp[(0 * 2 + dir) * 512 + ch], p1 = sp.lbp[(1 * 2 + dir) * 512 + ch]; lbv = 1.f / (1.f + __expf(p0 - p1)); } }
            else { bgv = sp.bgp[(li * 2 + dir) * 512 + ch];
#pragma unroll
                for (int rr = 0; rr < 16; ++rr) wupv[rr] = sp.wgu[((size_t)(li * 2 + dir) * 16 + rr) * 512 + ch]; }
        }
        if (MODE) { const bf16* Lp = sp.L + ((((size_t)(b * 4 + h0 + hh) * G::NSC + sc) * 2 + dir) * G::L_ITEM) + (size_t)((vcol0 - hh * G::DVH) + r) * 128;
#pragma unroll
            for (int kt = 0; kt < 4; ++kt)
#pragma unroll
                for (int g4 = 0; g4 < 4; ++g4) { const v2u w = *(const GAS v2u*)(Lp + 32 * kt + 8 * g4 + 4 * h);
                    S[kt][4 * g4 + 0] = __uint_as_float(w.x << 16); S[kt][4 * g4 + 1] = __uint_as_float(w.x & 0xffff0000u); S[kt][4 * g4 + 2] = __uint_as_float(w.y << 16); S[kt][4 * g4 + 3] = __uint_as_float(w.y & 0xffff0000u); } }
        else {
#pragma unroll
            for (int kt = 0; kt < 4; ++kt)
#pragma unroll
                for (int e = 0; e < 16; ++e) S[kt][e] = 0.f; }
#pragma unroll 1
        for (int ci = 0; ci < G::NCH; ++ci) {
            const int tbase = dir ? (sc0 + G::SCLEN - 1 - 32 * ci) : (sc0 + 32 * ci); const int tstep = dir ? -1 : 1;
            if (tid < G::KH) {
                float bacc = 0.f;
#pragma unroll 4
                for (int i = 0; i < 32; ++i) { const bf16* row = Pb + (size_t)(tbase + tstep * i) * G::NP; float gl;
                    if (!ODD) { const float z = bf2f(row[(dir ? E_ZB : E_ZF) + h0 * 128 + tid]); const float f = lbv + (1.f - lbv) * sigmoidf_(z); gl = __logf(fmaxf(f, 1e-30f)); }
                    else { const v4u r0 = *(const GAS v4u*)(row + (dir ? O_RB : O_RF)), r1 = *(const GAS v4u*)(row + (dir ? O_RB : O_RF) + 8); float pre = bgv;
#pragma unroll
                        for (int e = 0; e < 4; ++e) { pre += __uint_as_float(r0[e] << 16) * wupv[2 * e] + __uint_as_float(r0[e] & 0xffff0000u) * wupv[2 * e + 1];
                                                      pre += __uint_as_float(r1[e] << 16) * wupv[8 + 2 * e] + __uint_as_float(r1[e] & 0xffff0000u) * wupv[8 + 2 * e + 1]; }
                        gl = (fminf(pre, 0.f) - __logf(1.f + __expf(-fabsf(pre)))) * (1.f / 16.f); }
                    bacc += gl; *(LAS float*)(lds + G::OFF_B + i * G::RSB + tid * 4) = bacc; }
                *(LAS float*)(lds + G::OFF_D + tid * 4) = __expf(bacc); logd_acc += bacc;
            }
            __syncthreads();
            for (int u = tid; u < 32 * G::KH / 8; u += NTHR) {
                const int i = u / (G::KH / 8), c8 = (u % (G::KH / 8)) * 8; const bf16* row = Pb + (size_t)(tbase + tstep * i) * G::NP;
                const f32x4 b0 = *(const LAS f32x4*)(lds + G::OFF_B + i * G::RSB + c8 * 4), b1 = *(const LAS f32x4*)(lds + G::OFF_B + i * G::RSB + c8 * 4 + 16);
                const f32x4 r0 = *(const LAS f32x4*)(lds + G::OFF_B + 15 * G::RSB + c8 * 4), r1 = *(const LAS f32x4*)(lds + G::OFF_B + 15 * G::RSB + c8 * 4 + 16);
                const f32x4 e0 = *(const LAS f32x4*)(lds + G::OFF_B + 31 * G::RSB + c8 * 4), e1 = *(const LAS f32x4*)(lds + G::OFF_B + 31 * G::RSB + c8 * 4 + 16);
                float bb[8] = {b0[0], b0[1], b0[2], b0[3], b1[0], b1[1], b1[2], b1[3]}, rr[8] = {r0[0], r0[1], r0[2], r0[3], r1[0], r1[1], r1[2], r1[3]}, ee[8] = {e0[0], e0[1], e0[2], e0[3], e1[0], e1[1], e1[2], e1[3]};
                float kk[8], qq[8];
                if (!ODD) { const v4u zv = *(const GAS v4u*)(row + (dir ? E_ZB : E_ZF) + h0 * 128 + c8);
                    float lb8[8];
#pragma unroll
                    for (int e = 0; e < 8; ++e) { lb8[e] = 0.f; if (li == 1) { const int ch = h0 * 128 + c8 + e; lb8[e] = 1.f / (1.f + __expf(sp.lbp[(0 * 2 + dir) * 512 + ch] - sp.lbp[(1 * 2 + dir) * 512 + ch])); } }
#pragma unroll
                    for (int e = 0; e < 4; ++e) { kk[2 * e] = (1.f - lb8[2 * e]) * (1.f - sigmoidf_(__uint_as_float(zv[e] << 16))); kk[2 * e + 1] = (1.f - lb8[2 * e + 1]) * (1.f - sigmoidf_(__uint_as_float(zv[e] & 0xffff0000u))); }
                    if (MODE) { const v4u qv = *(const GAS v4u*)(row + E_QB + h0 * 128 + c8);
#pragma unroll
                        for (int e = 0; e < 4; ++e) { qq[2 * e] = siluf_(__uint_as_float(qv[e] << 16)); qq[2 * e + 1] = siluf_(__uint_as_float(qv[e] & 0xffff0000u)); } } }
                else { const v4u kv = *(const GAS v4u*)(row + O_KC + h0 * 128 + c8);
#pragma unroll
                    for (int e = 0; e < 4; ++e) { kk[2 * e] = __uint_as_float(kv[e] << 16); kk[2 * e + 1] = __uint_as_float(kv[e] & 0xffff0000u); }
                    if (MODE) { const v4u qv = *(const GAS v4u*)(row + O_QC + h0 * 128 + c8);
#pragma unroll
                        for (int e = 0; e < 4; ++e) { qq[2 * e] = __uint_as_float(qv[e] << 16) * 0.08838834764831845f; qq[2 * e + 1] = __uint_as_float(qv[e] & 0xffff0000u) * 0.08838834764831845f; } } }
                v4u w;
                w.x = cvtpk(kk[0] * __expf(ee[0] - bb[0]), kk[1] * __expf(ee[1] - bb[1])); w.y = cvtpk(kk[2] * __expf(ee[2] - bb[2]), kk[3] * __expf(ee[3] - bb[3]));
                w.z = cvtpk(kk[4] * __expf(ee[4] - bb[4]), kk[5] * __expf(ee[5] - bb[5])); w.w = cvtpk(kk[6] * __expf(ee[6] - bb[6]), kk[7] * __expf(ee[7] - bb[7]));
                *(LAS v4u*)(lds + G::OFF_W + i * G::RST + c8 * 2) = w;
                if (MODE) {
                    float dl[8];
#pragma unroll
                    for (int e = 0; e < 8; ++e) dl[e] = bb[e] - rr[e];
                    w.x = cvtpk(qq[0] * __expf(bb[0]), qq[1] * __expf(bb[1])); w.y = cvtpk(qq[2] * __expf(bb[2]), qq[3] * __expf(bb[3]));
                    w.z = cvtpk(qq[4] * __expf(bb[4]), qq[5] * __expf(bb[5])); w.w = cvtpk(qq[6] * __expf(bb[6]), qq[7] * __expf(bb[7]));
                    *(LAS v4u*)(lds + G::OFF_Q1 + i * G::RSK + c8 * 2) = w;
                    w.x = cvtpk(qq[0] * expc(dl[0]), qq[1] * expc(dl[1])); w.y = cvtpk(qq[2] * expc(dl[2]), qq[3] * expc(dl[3]));
                    w.z = cvtpk(qq[4] * expc(dl[4]), qq[5] * expc(dl[5])); w.w = cvtpk(qq[6] * expc(dl[6]), qq[7] * expc(dl[7]));
                    *(LAS v4u*)(lds + G::OFF_Q2 + i * G::RSK + c8 * 2) = w;
                    w.x = cvtpk(kk[0] * expc(-dl[0]), kk[1] * expc(-dl[1])); w.y = cvtpk(kk[2] * expc(-dl[2]), kk[3] * expc(-dl[3]));
                    w.z = cvtpk(kk[4] * expc(-dl[4]), kk[5] * expc(-dl[5])); w.w = cvtpk(kk[6] * expc(-dl[6]), kk[7] * expc(-dl[7]));
                    *(LAS v4u*)(lds + G::OFF_K2 + i * G::RSK + c8 * 2) = w;
                }
            }
            for (int u = tid; u < 32 * 32; u += NTHR) { const int i = u >> 5, c8 = (u & 31) * 8;
                *(LAS v4u*)(lds + G::OFF_V + i * G::RSV + c8 * 2) = *(const GAS v4u*)(Pb + (size_t)(tbase + tstep * i) * G::NP + G::VOFF + h0 * G::DVH + c8); }
            __syncthreads();
            f32x16 o;
            if (MODE) {
#pragma unroll
                for (int e = 0; e < 16; ++e) o[e] = 0.f;
#pragma unroll
                for (int kt = 0; kt < 4; ++kt)
#pragma unroll
                    for (int st = 0; st < 2; ++st) { const LAS unsigned char* qp = lds + G::OFF_Q1 + r * G::RSK + (kc0 + 32 * kt + 16 * st + 4 * h) * 2;
                        const s16x4 lo = *(const LAS s16x4*)qp, hi = *(const LAS s16x4*)(qp + 16);
                        const bf16x8 a = __builtin_shufflevector(lo, hi, 0, 1, 2, 3, 4, 5, 6, 7);
                        o = SC_MFMA(a, pack8(S[kt], st), o); }
                f32x16 at;
#pragma unroll
                for (int e = 0; e < 16; ++e) at[e] = 0.f;
#pragma unroll
                for (int ks = 0; ks < 8; ++ks) { const bf16x8 a = *(const LAS bf16x8*)(lds + G::OFF_K2 + r * G::RSK + (kc0 + 16 * ks + 8 * h) * 2), bq = *(const LAS bf16x8*)(lds + G::OFF_Q2 + r * G::RSK + (kc0 + 16 * ks + 8 * h) * 2);
                    at = SC_MFMA(a, bq, at); }
#pragma unroll
                for (int e = 0; e < 16; ++e) { const int srow = (e & 3) + 8 * (e >> 2) + 4 * h; at[e] = (srow <= r) ? at[e] : 0.f; }
#pragma unroll
                for (int st = 0; st < 2; ++st) { const LAS unsigned char* vp = lds + G::OFF_V + (16 * st + 4 * h + q4) * G::RSV + (vcol0 + 16 * g1 + 4 * p4) * 2;
                    const s16x4 lo = trd(vp), hi = trd(vp + 8 * G::RSV);
                    const bf16x8 bv = __builtin_shufflevector(lo, hi, 0, 1, 2, 3, 4, 5, 6, 7);
                    o = SC_MFMA(pack8(at, st), bv, o); }
            }
#pragma unroll
            for (int kt = 0; kt < 4; ++kt)
#pragma unroll
                for (int g4 = 0; g4 < 4; ++g4) { const f32x4 dv = *(const LAS f32x4*)(lds + G::OFF_D + (kc0 + 32 * kt + 8 * g4 + 4 * h) * 4);
#pragma unroll
                    for (int e = 0; e < 4; ++e) S[kt][4 * g4 + e] *= dv[e]; }
#pragma unroll
            for (int st = 0; st < 2; ++st) { const LAS unsigned char* vp = lds + G::OFF_V + (16 * st + 8 * h + q4) * G::RSV + (vcol0 + 16 * g1 + 4 * p4) * 2;
                const s16x4 vlo = trd(vp), vhi = trd(vp + 4 * G::RSV);
                const bf16x8 bv = __builtin_shufflevector(vlo, vhi, 0, 1, 2, 3, 4, 5, 6, 7);
#pragma unroll
                for (int kt = 0; kt < 4; ++kt) { const LAS unsigned char* wp = lds + G::OFF_W + (16 * st + 8 * h + q4) * G::RST + (kc0 + 32 * kt + 16 * g1 + 4 * p4) * 2;
                    const s16x4 wlo = trd(wp), whi = trd(wp + 4 * G::RST);
                    const bf16x8 aw = __builtin_shufflevector(wlo, whi, 0, 1, 2, 3, 4, 5, 6, 7);
                    S[kt] = SC_MFMA(aw, bv, S[kt]); } }
            if (MODE) {
#pragma unroll
                for (int e = 0; e < 16; ++e) *(LAS float*)(lds + G::OFF_B + ((e & 3) + 8 * (e >> 2) + 4 * h) * G::RSO + (vcol0 + r) * 4) = o[e];
                __syncthreads();
                { const int i = tid >> 4, seg = tid & 15, vc = seg * 16; const size_t m = (size_t)b * T + (tbase + tstep * i);
                  float v[16];
#pragma unroll
                  for (int e4 = 0; e4 < 4; ++e4) { const f32x4 x = *(const LAS f32x4*)(lds + G::OFF_B + i * G::RSO + (vc + 4 * e4) * 4); v[4 * e4] = x[0]; v[4 * e4 + 1] = x[1]; v[4 * e4 + 2] = x[2]; v[4 * e4 + 3] = x[3]; }
                  bf16* og = sp.OG + m * (G::NHG * 256) + hg * 256 + vc;
                  if (dd == 0) { v4u w0, w1; w0.x = cvtpk(v[0], v[1]); w0.y = cvtpk(v[2], v[3]); w0.z = cvtpk(v[4], v[5]); w0.w = cvtpk(v[6], v[7]); w1.x = cvtpk(v[8], v[9]); w1.y = cvtpk(v[10], v[11]); w1.z = cvtpk(v[12], v[13]); w1.w = cvtpk(v[14], v[15]);
                      *(GAS v4u*)og = w0; *(GAS v4u*)(og + 8) = w1; }
                  else { const v4u w0 = *(const GAS v4u*)og, w1 = *(const GAS v4u*)(og + 8); float ss = 0.f;
#pragma unroll
                      for (int e = 0; e < 4; ++e) { v[2 * e] += __uint_as_float(w0[e] << 16); v[2 * e + 1] += __uint_as_float(w0[e] & 0xffff0000u); v[8 + 2 * e] += __uint_as_float(w1[e] << 16); v[8 + 2 * e + 1] += __uint_as_float(w1[e] & 0xffff0000u); }
#pragma unroll
                      for (int e = 0; e < 16; ++e) ss += v[e] * v[e];
#pragma unroll
                      for (int o_ = 1; o_ < G::DVH / 16; o_ <<= 1) ss += __shfl_xor(ss, o_);
                      const float rstd = 1.f / sqrtf(ss * (1.f / G::DVH) + EPS);
                      bf16* mp = sp.MIX + m * NMIX + G::GOFF + h0 * G::DVH + vc; const float* gwp = sp.gnw + li * (4 * G::DVH) + h0 * G::DVH + vc;
                      const v4u g0 = *(const GAS v4u*)mp, g1v = *(const GAS v4u*)(mp + 8); float gt[16];
#pragma unroll
                      for (int e = 0; e < 4; ++e) { gt[2 * e] = __uint_as_float(g0[e] << 16); gt[2 * e + 1] = __uint_as_float(g0[e] & 0xffff0000u); gt[8 + 2 * e] = __uint_as_float(g1v[e] << 16); gt[8 + 2 * e + 1] = __uint_as_float(g1v[e] & 0xffff0000u); }
#pragma unroll
                      for (int e = 0; e < 16; ++e) v[e] = v[e] * rstd * gwp[e] * siluf_(gt[e]);
                      v4u w0o, w1o; w0o.x = cvtpk(v[0], v[1]); w0o.y = cvtpk(v[2], v[3]); w0o.z = cvtpk(v[4], v[5]); w0o.w = cvtpk(v[6], v[7]); w1o.x = cvtpk(v[8], v[9]); w1o.y = cvtpk(v[10], v[11]); w1o.z = cvtpk(v[12], v[13]); w1o.w = cvtpk(v[14], v[15]);
                      *(GAS v4u*)mp = w0o; *(GAS v4u*)(mp + 8) = w1o; }
                }
            }
            __syncthreads();
        }
        if (!MODE) {
            bf16* Lp = sp.L + ((((size_t)(b * 4 + h0 + hh) * G::NSC + sc) * 2 + dir) * G::L_ITEM) + (size_t)((vcol0 - hh * G::DVH) + r) * 128;
#pragma unroll
            for (int kt = 0; kt < 4; ++kt)
#pragma unroll
                for (int g4 = 0; g4 < 4; ++g4) { v2u w; w.x = cvtpk(S[kt][4 * g4], S[kt][4 * g4 + 1]); w.y = cvtpk(S[kt][4 * g4 + 2], S[kt][4 * g4 + 3]); *(GAS v2u*)(Lp + 32 * kt + 8 * g4 + 4 * h) = w; }
            if (tid < G::KH) sp.LOGD[(((size_t)(b * 4 + h0 + (tid >> 7)) * G::NSC + sc) * 2 + dir) * 128 + (tid & 127)] = logd_acc;
        }
        if (MODE) { asm volatile("s_waitcnt vmcnt(0)" ::: "memory"); __syncthreads(); }
    }
}

template <int ODD>
__device__ __forceinline__ void scan_combine(const Ctx& C, const ScanPtrs& sp) {
    typedef Geo<ODD> G;
    const int nunits = 16 * 2 * G::DVH * 16;
    for (int u = C.bid * NTHR + C.tid; u < nunits; u += C.G * NTHR) {
        const int k8 = (u & 15) * 8, j = (u >> 4) % G::DVH, dir = ((u >> 4) / G::DVH) & 1, bh = (u >> 4) / (G::DVH * 2);
        float S[8];
#pragma unroll
        for (int e = 0; e < 8; ++e) S[e] = 0.f;
#pragma unroll 4
        for (int s = 0; s < G::NSC; ++s) { const int sc = dir ? (G::NSC - 1 - s) : s;
            bf16* p = sp.L + (((size_t)bh * G::NSC + sc) * 2 + dir) * G::L_ITEM + (size_t)j * 128 + k8;
            const float* ld = sp.LOGD + (((size_t)bh * G::NSC + sc) * 2 + dir) * 128 + k8;
            const v4u w = *(const GAS v4u*)p; const f32x4 d0 = *(const GAS f32x4*)ld, d1 = *(const GAS f32x4*)(ld + 4);
            v4u o; o.x = cvtpk(S[0], S[1]); o.y = cvtpk(S[2], S[3]); o.z = cvtpk(S[4], S[5]); o.w = cvtpk(S[6], S[7]);
            *(GAS v4u*)p = o;
            const float dd[8] = {d0[0], d0[1], d0[2], d0[3], d1[0], d1[1], d1[2], d1[3]};
#pragma unroll
            for (int e = 0; e < 4; ++e) { S[2 * e] = __expf(dd[2 * e]) * S[2 * e] + __uint_as_float(w[e] << 16); S[2 * e + 1] = __expf(dd[2 * e + 1]) * S[2 * e + 1] + __uint_as_float(w[e] & 0xffff0000u); }
        }
    }
}
}

constexpr int STEPS_PER_LAYER = 6, NSTEPS = 2 + DEPTH * STEPS_PER_LAYER;

__global__ void __launch_bounds__(NTHR, 2) mk_fwd(Args args) {
    extern __shared__ __attribute__((aligned(16))) unsigned char lds_raw[];
    Ctx C;
    C.lds = (LAS unsigned char*)lds_raw;
    C.tid = threadIdx.x; C.lane = C.tid & 63; C.wave = __builtin_amdgcn_readfirstlane(C.tid >> 6);
    C.G = gridDim.x; C.bid = blockIdx.x;
    C.out = args.out; C.ws = args.ws;
    volatile LAS unsigned* MISC = (volatile LAS unsigned*)(C.lds + MISC_OFF);
    for (int u = C.tid; u < (LDS_BYTES - RING_BYTES) / 4; u += NTHR) ((LAS unsigned*)(C.lds + RING_BYTES))[u] = 0u;
    __syncthreads();
    XcdBarrier bar; bar.bar = (unsigned*)(C.ws + WS_CTL) + CW_BAR; bar.x = 0; bar.st = nullptr;
    const int lo = args.ph_lo, hi = args.ph_hi;
    if (hi - lo > 1) bar = xcd_barrier_post((unsigned*)(C.ws + WS_CTL) + CW_BAR, MISC + 8);
    int step = 0; bool run_ = false;
#define PHASE_BEGIN { int _st = step; asm volatile("" : "+s"(_st)); run_ = (_st >= lo && _st < hi); } if (run_) { { unsigned char* _w = args.ws; float* _o = args.out; asm volatile("" : "+s"(_w), "+s"(_o)); C.ws = _w; C.out = _o; \
        int _t = threadIdx.x; asm volatile("" : "+v"(_t)); C.tid = _t; C.lane = _t & 63; C.wave = __builtin_amdgcn_readfirstlane(_t >> 6); \
        gw = C.bid * NWAVES + C.wave; wscr = (LAS float*)(C.lds + C.wave * 16384); \
        P = (bf16*)(C.ws + WS_P); MIX = (bf16*)(C.ws + WS_MIX); HN = (bf16*)(C.ws + WS_HN); }
#define PHASE_END   if (step + 1 < hi) xcd_barrier(bar); } ++step;

    int gw = C.bid * NWAVES + C.wave; const int NGW = C.G * NWAVES;
    LAS float* wscr = (LAS float*)(C.lds + C.wave * 16384);
    bf16* P = (bf16*)(C.ws + WS_P); bf16* MIX = (bf16*)(C.ws + WS_MIX); bf16* HN = (bf16*)(C.ws + WS_HN);

    PHASE_BEGIN if (TEST_MASK & 1) phase_prep(C, args); PHASE_END
    PHASE_BEGIN
#pragma unroll 1
        for (int l = 0; l < DEPTH; ++l) {
            const bf16* WKV = (const bf16*)(C.ws + WS_WKV) + (size_t)l * 1024 * 1024; const bf16* MEMN = (const bf16*)(C.ws + WS_MEMN);
#if USE_PG8
            { pg8::Gemm g{MEMN, WKV, 1024, 512, 1024}; pg8::StaticOrder S; S.init(1024, 512, C.G, (C.bid + C.G - 16 * l) % C.G);
              pg8::EpiProj e{(bf16*)(C.ws + WS_MEMK) + (size_t)l * 1024 * 512, nullptr, 512, 1 << 20};
              pg8::gemm_phase<pg8::EpiProj, pg8::StaticOrder, false, true>(C.lds, g, S, e); }
            { pg8::Gemm g{WKV + (size_t)512 * 1024, MEMN, 512, 1024, 1024}; pg8::StaticOrder S; S.init(512, 1024, C.G, (C.bid + C.G - 16 * l - 8) % C.G);
              pg8::EpiProj e{(bf16*)(C.ws + WS_MEMVT) + (size_t)l * 512 * 1024, nullptr, 1024, 1 << 20};
              pg8::gemm_phase<pg8::EpiProj, pg8::StaticOrder, false, true>(C.lds, g, S, e); }
#else
            EpiStoreBf16 ek{(bf16*)(C.ws + WS_MEMK) + (size_t)l * 1024 * 512, 512};
            gemm_naive(C, MEMN, 1024, WKV, 1024, 1024, 512, 1024, (C.bid + 32 * l) % C.G, C.G, ek);
            EpiStoreBf16 ev{(bf16*)(C.ws + WS_MEMVT) + (size_t)l * 512 * 1024, 1024};
            gemm_naive(C, WKV + (size_t)512 * 1024, 1024, MEMN, 1024, 512, 1024, 1024, (C.bid + 32 * l + 128) % C.G, C.G, ev);
#endif
        }
    PHASE_END

#pragma unroll 1
    for (int l = 0; l < DEPTH; ++l) {
        const int odd = l & 1, li = l >> 1;
        PHASE_BEGIN
#if USE_PG8
            pg8::Gemm g{HN, (const bf16*)(C.ws + WS_WIN), M, odd ? NIN_O : NIN_E, 1024}; pg8::StaticOrder S; S.init(M, odd ? NIN_O : NIN_E, C.G, C.bid);
            pg8::EpiProj e{P, MIX, odd ? NP_O : NP_E, (odd ? NP_O : NP_E) / 256};
            pg8::gemm_phase<pg8::EpiProj, pg8::StaticOrder, true, true>(C.lds, g, S, e);
#else
            EpiInProj e{P, MIX, odd ? NP_O : NP_E};
            gemm_naive(C, HN, 1024, (const bf16*)(C.ws + WS_WIN), 1024, M, odd ? NIN_O : NIN_E, 1024, C.bid, C.G, e);
#endif
        PHASE_END
        PHASE_BEGIN
#if USE_MFMA_SCAN
            { scan::ScanPtrs sp{P, MIX, (bf16*)(C.ws + (odd ? WS_L_O : WS_L_E)), (float*)(C.ws + WS_LOGD), (bf16*)(C.ws + (odd ? WS_OG_O : WS_OG_E)), args.in[5], args.in[10], args.in[11], odd ? args.in[12] : args.in[6]};
              const int NHG = odd ? 4 : 2, NSC = odd ? 16 : 32;
              for (int it = C.bid; it < BATCH * NHG * NSC * 2; it += C.G) { const int dir = it & 1, sc = (it >> 1) % NSC, hg = ((it >> 1) / NSC) % NHG, b = (it >> 1) / (NSC * NHG);
                  if (odd) scan::scan_item<1, 0>(C, sp, li, b, hg, sc, dir); else scan::scan_item<0, 0>(C, sp, li, b, hg, sc, dir); } }
            const int nscan = 0;
#else
            const int nscan = odd ? 128 : 64;
#endif
            if (gw < nscan) { if (TEST_MASK & 4) { if (odd) naive_scan_item<1>(C, args.in[5], args.in[10], args.in[11], l, gw, wscr); else naive_scan_item<0>(C, args.in[5], args.in[10], args.in[11], l, gw, wscr); } }
            else {
                const int w2 = gw - nscan, NW2 = NGW - nscan;
                const int nA = odd ? 0 : M * 8, nM = M * 4, nW = (l + 1 < DEPTH) ? win_items(l + 1) : 0;
                for (int it = w2; it < nA + nM + nW; it += NW2) {
                    if (it < nA) naive_winattn_item(C, args.in[4] + li * 8, it, wscr);
                    else if (it < nA + nM) naive_memattn_item(C, l, it - nA, wscr);
                    else win_item(C, args.in[3], args.in[9], l + 1, it - nA - nM, wscr);
                }
            }
        PHASE_END
        PHASE_BEGIN
#if USE_MFMA_SCAN
            { scan::ScanPtrs sp{P, MIX, (bf16*)(C.ws + (odd ? WS_L_O : WS_L_E)), (float*)(C.ws + WS_LOGD), (bf16*)(C.ws + (odd ? WS_OG_O : WS_OG_E)), args.in[5], args.in[10], args.in[11], odd ? args.in[12] : args.in[6]};
              if (odd) scan::scan_combine<1>(C, sp); else scan::scan_combine<0>(C, sp); }
#else
            for (int it = gw; it < M * 4; it += NGW) { if (odd) naive_gnorm_item<1>(C, args.in[12], l, it); else naive_gnorm_item<0>(C, args.in[6], l, it); }
#endif
        PHASE_END
        PHASE_BEGIN
#if USE_MFMA_SCAN
            { scan::ScanPtrs sp{P, MIX, (bf16*)(C.ws + (odd ? WS_L_O : WS_L_E)), (float*)(C.ws + WS_LOGD), (bf16*)(C.ws + (odd ? WS_OG_O : WS_OG_E)), args.in[5], args.in[10], args.in[11], odd ? args.in[12] : args.in[6]};
              const int NHG = odd ? 4 : 2, NSC = odd ? 16 : 32;
              for (int it = C.bid; it < BATCH * NHG * NSC; it += C.G) { const int sc = it % NSC, hg = (it / NSC) % NHG, b = it / (NSC * NHG);
                  if (odd) scan::scan_item<1, 1>(C, sp, li, b, hg, sc, 0); else scan::scan_item<0, 1>(C, sp, li, b, hg, sc, 0); } }
#endif
        PHASE_END
        PHASE_BEGIN
#if USE_PG8
            pg8::Gemm g{MIX, (const bf16*)(C.ws + WS_WOUT) + (size_t)l * 1024 * 1536, M, 1024, 1536}; pg8::StaticOrder S; S.init(M, 1024, C.G, C.bid);
            pg8::EpiResidF32 e{l == 0 ? args.in[0] : C.out, C.out};
            pg8::gemm_phase<pg8::EpiResidF32, pg8::StaticOrder, false, true>(C.lds, g, S, e);
#else
            EpiResid e{l == 0 ? args.in[0] : C.out, C.out};
            gemm_naive(C, MIX, NMIX, (const bf16*)(C.ws + WS_WOUT) + (size_t)l * 1024 * 1536, 1536, M, 1024, 1536, C.bid, C.G, e);
#endif
        PHASE_END
        PHASE_BEGIN
            if (!(TEST_MASK & 32)) {} else if (l + 1 < DEPTH) { const float* g = ((l + 1) & 1) ? args.in[8] + ((l + 1) >> 1) * D : args.in[2] + ((l + 1) >> 1) * D;
                for (int r = gw; r < M; r += NGW) rms_row_to_bf16(C.out + (size_t)r * D, g, HN + (size_t)r * D, C.lane); }
            else { for (int r = gw; r < M; r += NGW) rms_row_to_f32(C.out + (size_t)r * D, args.in[16], C.out + (size_t)r * D, C.lane); }
        PHASE_END
    }
#undef PHASE_BEGIN
#undef PHASE_END
}

extern "C" void kernel_launch(void* const* d_in, const int* in_sizes, int n_in, void* d_out, int out_size, void* d_ws, size_t ws_size, hipStream_t stream) {
    static int grid = 0;
    if (grid == 0) {
        if (n_in != 17 || out_size != M * D || ws_size < WS_END) { fprintf(stderr, "kernel_launch: unexpected shapes n_in %d out %d ws %zu\n", n_in, out_size, ws_size); grid = -1; return; }
        int dev = 0, cus = 0, per_cu = 0;
        if (hipGetDevice(&dev) != hipSuccess || hipDeviceGetAttribute(&cus, hipDeviceAttributeMultiprocessorCount, dev) != hipSuccess) { grid = -1; return; }
        if (hipFuncSetAttribute((const void*)mk_fwd, hipFuncAttributeMaxDynamicSharedMemorySize, LDS_BYTES) != hipSuccess) { fprintf(stderr, "kernel_launch: hipFuncSetAttribute failed\n"); grid = -1; return; }
        if (hipOccupancyMaxActiveBlocksPerMultiprocessor(&per_cu, (const void*)mk_fwd, NTHR, LDS_BYTES) != hipSuccess || per_cu < 1)
            fprintf(stderr, "kernel_launch: occupancy query reports %d blocks per CU\n", per_cu);
        (void)hipGetLastError();
        grid = cus;
    }
    if (grid < 0) return;
    if (hipMemsetAsync((char*)d_ws + WS_CTL, 0, CTL_ZERO_BYTES, stream) != hipSuccess) return;
    Args a{};
    for (int i = 0; i < 17; ++i) a.in[i] = (const float*)d_in[i];
    a.out = (float*)d_out; a.ws = (unsigned char*)d_ws;
#if MK_ONE_LAUNCH
    a.ph_lo = 0; a.ph_hi = NSTEPS;
    hipLaunchKernelGGL(mk_fwd, dim3(grid), dim3(NTHR), LDS_BYTES, stream, a);
#else
    for (int s = 0; s < NSTEPS; ++s) { a.ph_lo = s; a.ph_hi = s + 1; hipLaunchKernelGGL(mk_fwd, dim3(grid), dim3(NTHR), LDS_BYTES, stream, a); }
#endif
}
```

```cpp
#include <hip/hip_runtime.h>
#include <cstdio>
#include <cstdint>

#ifndef TEST_MASK
#define TEST_MASK 0xFFFF
#endif
#ifndef USE_MFMA_ATTN
#define USE_MFMA_ATTN 1
#endif
#ifndef USE_MFMA_SCAN
#define USE_MFMA_SCAN 1
#endif
#ifndef USE_PG8
#define USE_PG8 1
#endif
#ifndef MK_ONE_LAUNCH
#define MK_ONE_LAUNCH 1
#endif

#define GAS __attribute__((address_space(1)))
#define LAS __attribute__((address_space(3)))
typedef unsigned short bf16;
typedef unsigned v4u __attribute__((ext_vector_type(4)));
typedef unsigned v2u __attribute__((ext_vector_type(2)));
typedef float f32x4 __attribute__((ext_vector_type(4)));
typedef GAS unsigned gu32;
#define RLX_AGENT __ATOMIC_RELAXED, __HIP_MEMORY_SCOPE_AGENT
#define LDS_WAIT() asm volatile("s_waitcnt lgkmcnt(0)" ::: "memory")
#define VM_WAIT() asm volatile("s_waitcnt vmcnt(0)" ::: "memory")

constexpr int NWAVES = 8, NTHR = 512;
constexpr int BATCH = 4, T = 4096, D = 1024, M = BATCH * T, DEPTH = 4;
constexpr int NMEM = 256;
constexpr int NP_E = 3328, NP_O = 2816, NMIX = 1536, NIN_E = 4864, NIN_O = 4352, NIN_O_SRC = 4128;
constexpr int E_QA = 0, E_KA = 512, E_VA = 640, E_QB = 768, E_ZF = 1280, E_ZB = 1792, E_IB = 2304, E_QM = 2816;
constexpr int O_QC = 0, O_KC = 512, O_VC = 1024, O_QM = 2048, O_RF = 2560, O_RB = 2576;
constexpr int X_GA = 0, X_GB = 512, X_GM = 1024, X_GC = 0;
constexpr float EPS = 1e-6f;

constexpr size_t MiB = 1u << 20;
constexpr size_t WS_CTL = 0, CTL_ZERO_BYTES = 1 * MiB;
constexpr size_t WS_WIN = 2 * MiB;
constexpr size_t WS_WOUT = 12 * MiB;
constexpr size_t WS_WKV = 24 * MiB;
constexpr size_t WS_MEMK = 32 * MiB;
constexpr size_t WS_MEMVT = 36 * MiB;
constexpr size_t WS_MEMN = 40 * MiB;
constexpr size_t WS_MIX = 43 * MiB;
constexpr size_t WS_P = 91 * MiB;
constexpr size_t WS_HN = 195 * MiB;
constexpr size_t WS_OE = 195 * MiB;
constexpr size_t WS_OO = 192 * MiB;
constexpr size_t WS_L_E = 195 * MiB, WS_OG_E = 227 * MiB;
constexpr size_t WS_L_O = 179 * MiB, WS_OG_O = 211 * MiB;
constexpr size_t WS_LOGD = 243 * MiB;
constexpr size_t WS_END = 256 * MiB;

constexpr int CW_BAR = 4096;

__device__ __forceinline__ float bf2f(bf16 v) { return __uint_as_float(((unsigned)v) << 16); }
__device__ __forceinline__ unsigned f2bf(float f) { unsigned u = __float_as_uint(f); return (u + 0x7fffu + ((u >> 16) & 1u)) >> 16; }
__device__ __forceinline__ unsigned pk2(float lo, float hi) { return f2bf(lo) | (f2bf(hi) << 16); }
__device__ __forceinline__ float wave_sum(float v) {
#pragma unroll
    for (int o = 1; o < 64; o <<= 1) v += __shfl_xor(v, o);
    return v;
}
__device__ __forceinline__ float wave_max(float v) {
#pragma unroll
    for (int o = 1; o < 64; o <<= 1) v = fmaxf(v, __shfl_xor(v, o));
    return v;
}
__device__ __forceinline__ float sigmoidf_(float z) { return 1.f / (1.f + __expf(-z)); }
__device__ __forceinline__ float siluf_(float z) { return z / (1.f + __expf(-z)); }

#define XB_TMO      128
#define XB_XCNT(j)  (256  + 64 * (j))
#define XB_XSUB(j)  (1280 + 64 * (j))
#define XB_XGEN(j)  (2304 + 64 * (j))
#define XB_TOP      3328
#define XB_TOPGEN   3392
#define XCD_BAR_WORDS 3456
#define XB_SPIN_CAP (1u << 22)
__device__ __forceinline__ unsigned xb_ld(unsigned* p)              { return __hip_atomic_load(p, __ATOMIC_RELAXED, __HIP_MEMORY_SCOPE_AGENT); }
__device__ __forceinline__ unsigned xb_add(unsigned* p, unsigned v) { return __hip_atomic_fetch_add(p, v, __ATOMIC_RELAXED, __HIP_MEMORY_SCOPE_AGENT); }
__device__ __forceinline__ unsigned xb_xcc_id() { return (unsigned)__builtin_amdgcn_s_getreg((3 << 11) | 20) & 0xFu; }
#define XB_SPIN(cond, bar) do { unsigned _sp = 0; while (cond) { __builtin_amdgcn_s_sleep(1); \
    if ((++_sp & 255u) == 0u) { if (xb_ld(&(bar)[XB_TMO])) break; if (_sp > XB_SPIN_CAP) { atomicAdd(&(bar)[XB_TMO], 1u); break; } } } } while (0)
struct XcdBarrier { unsigned* bar; unsigned x; volatile LAS unsigned* st; };
__device__ __forceinline__ XcdBarrier xcd_barrier_post(unsigned* bar, volatile LAS unsigned* st) {
    XcdBarrier b; b.bar = bar; b.x = xb_xcc_id(); b.st = st;
    if (threadIdx.x == 0) (void)xb_add(&bar[XB_XCNT(b.x)], 1u);
    return b;
}
__device__ __forceinline__ void xcd_barrier_complete(unsigned* bar, unsigned x, unsigned& nloc, unsigned& nx) {
    const unsigned G = gridDim.x * gridDim.y * gridDim.z;
    unsigned sum, cnt, mine, sp = 0u;
    for (;;) {
        sum = 0u; cnt = 0u; mine = 0u;
#pragma unroll
        for (unsigned j = 0; j < 16; ++j) { const unsigned c = xb_ld(&bar[XB_XCNT(j)]); sum += c; cnt += (c > 0u) ? 1u : 0u; mine = (j == x) ? c : mine; }
        if (sum == G) break;
        __builtin_amdgcn_s_sleep(1);
        if ((++sp & 255u) == 0u) { if (xb_ld(&bar[XB_TMO])) break; if (sp > XB_SPIN_CAP) { atomicAdd(&bar[XB_TMO], 1u); break; } }
    }
    nloc = mine > 0u ? mine : 1u; nx = cnt > 0u ? cnt : 1u;
}
__device__ __forceinline__ void xcd_barrier(const XcdBarrier& b) {
    asm volatile("s_waitcnt vmcnt(0)" ::: "memory");
    __syncthreads();
    if (threadIdx.x == 0) {
        unsigned* bar = b.bar; unsigned bx = b.x; asm volatile("" : "+s"(bar), "+s"(bx));
        __builtin_amdgcn_s_waitcnt(0);
        unsigned nloc = b.st[0], nx = b.st[1];
        if (nloc == 0u) { xcd_barrier_complete(bar, bx, nloc, nx); b.st[0] = nloc; b.st[1] = nx; }
        const unsigned old = xb_add(&bar[XB_XSUB(bx)], 1u);
        const unsigned gen = old / nloc;
        if (old + 1u == (gen + 1u) * nloc) {
            __builtin_amdgcn_fence(__ATOMIC_RELEASE, "agent");
            asm volatile("s_waitcnt vmcnt(0)" ::: "memory");
            const unsigned og = xb_add(&bar[XB_TOP], 1u);
            const unsigned tg = og / nx;
            if (og + 1u == (tg + 1u) * nx) xb_add(&bar[XB_TOPGEN], 1u);
            else XB_SPIN(xb_ld(&bar[XB_TOPGEN]) == tg, bar);
            __builtin_amdgcn_fence(__ATOMIC_ACQUIRE, "agent");
            xb_add(&bar[XB_XGEN(bx)], 1u);
            asm volatile("s_waitcnt vmcnt(0)" ::: "memory");
        } else {
            XB_SPIN(xb_ld(&bar[XB_XGEN(bx)]) == gen, bar);
            __builtin_amdgcn_fence(__ATOMIC_ACQUIRE, "agent");
            asm volatile("s_waitcnt vmcnt(0)" ::: "memory");
        }
    }
    __syncthreads();
}

constexpr int RING_BYTES = 139264;
constexpr int MISC_OFF = RING_BYTES + 320;
constexpr int LDS_BYTES = 147456;

struct Args { const float* in[17]; float* out; unsigned char* ws; int ph_lo, ph_hi; };
static_assert(sizeof(Args) == 17 * 8 + 8 + 8 + 8, "Args has no padding");

struct Ctx {
    LAS unsigned char* lds;
    int tid, lane, wave, G, bid;
    float* out; unsigned char* ws;
};

__device__ __forceinline__ void transpose_item(const float* W, int K, int N, bf16* WT, int k0, int n0, int drow0, LAS float* scr, int lane) {
    asm volatile("" : "+v"(lane));
#pragma unroll 8
    for (int i = 0; i < 32; ++i) { const int kk = 2 * i + (lane >> 5); scr[kk * 33 + (lane & 31)] = W[(size_t)(k0 + kk) * N + n0 + (lane & 31)]; }
    LDS_WAIT(); asm volatile("" ::: "memory");
    const int c = lane & 7;
#pragma unroll
    for (int j = 0; j < 4; ++j) { const int n = (lane >> 3) + 8 * j; const LAS float* s = scr + (8 * c) * 33 + n;
        v4u o; o.x = pk2(s[0 * 33], s[1 * 33]); o.y = pk2(s[2 * 33], s[3 * 33]); o.z = pk2(s[4 * 33], s[5 * 33]); o.w = pk2(s[6 * 33], s[7 * 33]);
        *(GAS v4u*)(WT + (size_t)(drow0 + n) * K + k0 + 8 * c) = o; }
    LDS_WAIT(); asm volatile("" ::: "memory");
}
__device__ __forceinline__ int map_even(int n0) {
    if (n0 < 768) return n0;
    if (n0 < 1280) return NP_E + X_GA + (n0 - 768);
    if (n0 < 3328) return E_QB + (n0 - 1280);
    if (n0 < 3840) return NP_E + X_GB + (n0 - 3328);
    if (n0 < 4352) return E_QM + (n0 - 3840);
    return NP_E + X_GM + (n0 - 4352);
}
__device__ __forceinline__ int map_odd(int n0) {
    if (n0 < 2048) return n0;
    if (n0 < 3072) return NP_O + X_GC + (n0 - 2048);
    if (n0 < 3104) return O_RF + (n0 - 3072);
    if (n0 < 3616) return O_QM + (n0 - 3104);
    return NP_O + X_GM + (n0 - 3616);
}
__device__ __forceinline__ int win_items(int l) { return (l & 1) ? (16 * (NIN_O_SRC / 32) + 224) : (16 * (NIN_E / 32)); }
__device__ __forceinline__ void win_item(const Ctx& C, const float* w_even, const float* w_odd, int l, int it, LAS float* scr) {
    bf16* WT = (bf16*)(C.ws + WS_WIN);
    if (l & 1) {
        const int nconv = 16 * (NIN_O_SRC / 32);
        if (it < nconv) { const int nb = it % (NIN_O_SRC / 32), kb = it / (NIN_O_SRC / 32);
            transpose_item(w_odd + (size_t)(l >> 1) * D * NIN_O_SRC, D, NIN_O_SRC, WT, kb * 64, nb * 32, map_odd(nb * 32), scr, C.lane); }
        else { const int r = 2592 + (it - nconv);
            GAS v4u* p = (GAS v4u*)(WT + (size_t)r * D); v4u z = {0u, 0u, 0u, 0u}; p[C.lane] = z; p[C.lane + 64] = z; }
    } else {
        const int nb = it % (NIN_E / 32), kb = it / (NIN_E / 32);
        transpose_item(w_even + (size_t)(l >> 1) * D * NIN_E, D, NIN_E, WT, kb * 64, nb * 32, map_even(nb * 32), scr, C.lane);
    }
}
__device__ __forceinline__ void rms_row_to_bf16(const float* xrow, const float* g, bf16* orow, int lane) {
    asm volatile("" : "+v"(lane));
    const GAS f32x4* xr = (const GAS f32x4*)xrow + lane; const GAS f32x4* gr = (const GAS f32x4*)g + lane;
    f32x4 v[4]; float s = 0.f;
#pragma unroll
    for (int j = 0; j < 4; ++j) { v[j] = xr[64 * j]; s += (v[j].x * v[j].x + v[j].y * v[j].y) + (v[j].z * v[j].z + v[j].w * v[j].w); }
    const float rstd = 1.f / sqrtf(wave_sum(s) * (1.f / D) + EPS);
    GAS unsigned long long* o8 = (GAS unsigned long long*)orow + lane;
#pragma unroll
    for (int j = 0; j < 4; ++j) { const f32x4 gg = gr[64 * j];
        o8[64 * j] = (unsigned long long)pk2(v[j].x * rstd * gg.x, v[j].y * rstd * gg.y) | ((unsigned long long)pk2(v[j].z * rstd * gg.z, v[j].w * rstd * gg.w) << 32); }
}
__device__ __forceinline__ void rms_row_to_f32(const float* xrow, const float* g, float* orow, int lane) {
    asm volatile("" : "+v"(lane));
    const GAS f32x4* xr = (const GAS f32x4*)xrow + lane; const GAS f32x4* gr = (const GAS f32x4*)g + lane;
    f32x4 v[4]; float s = 0.f;
#pragma unroll
    for (int j = 0; j < 4; ++j) { v[j] = xr[64 * j]; s += (v[j].x * v[j].x + v[j].y * v[j].y) + (v[j].z * v[j].z + v[j].w * v[j].w); }
    const float rstd = 1.f / sqrtf(wave_sum(s) * (1.f / D) + EPS);
    GAS f32x4* o = (GAS f32x4*)orow + lane;
#pragma unroll
    for (int j = 0; j < 4; ++j) { const f32x4 gg = gr[64 * j]; o[64 * j] = v[j] * rstd * gg; }
}

__device__ __forceinline__ void phase_prep(const Ctx& C, const Args& A) {
    LAS float* scr = (LAS float*)(C.lds + C.wave * 16384);
    const int gw = C.bid * NWAVES + C.wave, NGW = C.G * NWAVES;
    constexpr int I_OUT = (1536 / 64) * (1024 / 32), I_KV = (1024 / 64) * (1024 / 32);
    const int I_IN = win_items(0);
    const int total = 4 * I_OUT + 4 * I_KV + I_IN + 1024 + M;
    for (int it = gw; it < total; it += NGW) {
        int r = it;
        if (r < 4 * I_OUT) { const int l = r / I_OUT; r -= l * I_OUT; const int nb = r % 32, kb = r / 32;
            const float* W = (l & 1) ? A.in[13] + (size_t)(l >> 1) * 1536 * 1024 : A.in[7] + (size_t)(l >> 1) * 1536 * 1024;
            transpose_item(W, 1536, 1024, (bf16*)(C.ws + WS_WOUT) + (size_t)l * 1024 * 1536, kb * 64, nb * 32, nb * 32, scr, C.lane); continue; }
        r -= 4 * I_OUT;
        if (r < 4 * I_KV) { const int l = r / I_KV; r -= l * I_KV; const int nb = r % 32, kb = r / 32;
            transpose_item(A.in[15] + (size_t)l * 1024 * 1024, 1024, 1024, (bf16*)(C.ws + WS_WKV) + (size_t)l * 1024 * 1024, kb * 64, nb * 32, nb * 32, scr, C.lane); continue; }
        r -= 4 * I_KV;
        if (r < I_IN) { win_item(C, A.in[3], A.in[9], 0, r, scr); continue; }
        r -= I_IN;
        if (r < 1024) { rms_row_to_bf16(A.in[1] + (size_t)r * D, A.in[14], (bf16*)(C.ws + WS_MEMN) + (size_t)r * D, C.lane); continue; }
        r -= 1024;
        rms_row_to_bf16(A.in[0] + (size_t)r * D, A.in[2], (bf16*)(C.ws + WS_HN) + (size_t)r * D, C.lane);
    }
}

namespace pg8 {
#define PG8_LAS __attribute__((address_space(3)))
typedef unsigned short bf16_t;
typedef short bf16x8 __attribute__((ext_vector_type(8)));
typedef float f32x4 __attribute__((ext_vector_type(4)));
typedef unsigned u32x4 __attribute__((ext_vector_type(4)));
constexpr int BM = 256, BK = 64, HALF = 128, HTB = HALF * BK * 2  , STAGE_BYTES = 8 * HTB, NXCD = 8, WGM = 8;

__host__ __device__ __forceinline__ int lds_byte(int r, int c) { const int st = (r >> 4) * 2 + (c >> 5), rr = r & 15, cc = c & 31, ob = rr * 64 + cc * 2; return st * 1024 + (ob ^ (((ob >> 9) & 1) << 5)); }
__host__ __device__ __forceinline__ void stage_rc(int b, int& R, int& C) { const int st = b / 1024, sb = b % 1024, swz = sb ^ (((sb >> 9) & 1) << 5); R = (st >> 1) * 16 + swz / 64; C = (st & 1) * 32 + (swz % 64) / 2; }
__host__ __device__ __forceinline__ int perm32(int rho) { const int n = rho >> 4, i = rho & 15; return 8 * (i >> 2) + 4 * n + (i & 3); }

struct Unit { int pm, pn; };
struct Gemm { const bf16_t* A; const bf16_t* Bt; int M, N, K; };

struct StaticOrder {
    int nM, nN, nwg, G, c;
    __host__ __device__ void init(int M, int N, int G_, int c_) { nM = M / BM; nN = N / BM; nwg = nM * nN; G = G_; c = c_; }
    __host__ __device__ bool next(int i, Unit& u) const {
        const long L = (long)i * G + c; if (L >= nwg) return false;
        int wgid = (int)L; { const int q = nwg / NXCD, r = nwg % NXCD, xcd = wgid % NXCD, off = wgid / NXCD; wgid = (xcd < r ? xcd * (q + 1) : r * (q + 1) + (xcd - r) * q) + off; }
        const int nig = WGM * nN, gid = wgid / nig, fm = gid * WGM, gsz = (nM - fm) < WGM ? (nM - fm) : WGM;
        u.pm = fm + ((wgid % nig) % gsz); u.pn = (wgid % nig) / gsz; return true;
    }
    __device__ __forceinline__ void a_ready(const Unit&) const {}
    __device__ __forceinline__ void done(const Unit&) const {}
};

__device__ __forceinline__ unsigned cvt_pk_bf16(float lo, float hi) { unsigned r; asm volatile("v_cvt_pk_bf16_f32 %0, %1, %2" : "=v"(r) : "v"(lo), "v"(hi)); return r; }

template <class Epi, class Sched, bool ALIGN_EPI = false, bool SP2 = false>
__device__ __forceinline__ void gemm_phase(PG8_LAS unsigned char* lds, const Gemm g, const Sched& S, const Epi& E) {
    int tid = threadIdx.x; asm volatile("" : "+v"(tid));
    const int wid = __builtin_amdgcn_readfirstlane(tid >> 6), lane = tid & 63, wr = wid >> 2, wc = wid & 3, fr = lane & 15, fq = lane >> 4;
    const int K = g.K, nt = K / BK;
    unsigned voffA[2], voffB[2];
#pragma unroll
    for (int i = 0; i < 2; ++i) { int R, C; stage_rc(tid * 16 + i * 8192, R, C); const int Rb = Epi::PERM ? ((R & ~31) + perm32(R & 31)) : R;
        voffA[i] = (unsigned)(R * K + C) * 2u; voffB[i] = (unsigned)(Rb * K + C) * 2u; }
    const size_t kstep = (size_t)(BK * 2);
    const size_t hstep = (size_t)HALF * K * 2;
    const size_t tstep = 2 * hstep;
    const unsigned ldsw = (unsigned)wid * 1024u;
    const int aoff = lds_byte(wr * 64 + fr, fq * 8), boff = lds_byte(wc * 32 + fr, fq * 8);
#define PG8_SA(b, h) (((b) * 2 + (h)) * HTB)
#define PG8_SB(b, h) ((4 + (b) * 2 + (h)) * HTB)
#define PG8_STAGE(bufoff, gbase, voff) do { _Pragma("unroll") for (int _i = 0; _i < 2; ++_i) \
        __builtin_amdgcn_global_load_lds((const unsigned*)((const char*)(gbase) + (voff)[_i]), (PG8_LAS unsigned*)(lds + (bufoff) + ldsw + _i * 8192), 16, 0, 0); } while (0)
#define PG8_LDA(dst, b, h) do { _Pragma("unroll") for (int m = 0; m < 4; ++m) _Pragma("unroll") for (int k = 0; k < 2; ++k) dst[m][k] = *(const PG8_LAS bf16x8*)(lds + PG8_SA(b, h) + aoff + m * 2048 + k * 1024); } while (0)
#define PG8_LDB(dst, b, h) do { _Pragma("unroll") for (int n = 0; n < 2; ++n) _Pragma("unroll") for (int k = 0; k < 2; ++k) dst[n][k] = *(const PG8_LAS bf16x8*)(lds + PG8_SB(b, h) + boff + n * 2048 + k * 1024); } while (0)
#define PG8_MMA(ai, bj, At, Bt) do { __builtin_amdgcn_s_setprio(1); _Pragma("unroll") for (int m = 0; m < 4; ++m) _Pragma("unroll") for (int n = 0; n < 2; ++n) _Pragma("unroll") for (int k = 0; k < 2; ++k) \
        acc[ai][bj][m][n] = __builtin_amdgcn_mfma_f32_16x16x32_bf16(Bt[n][k], At[m][k], acc[ai][bj][m][n], 0, 0, 0); __builtin_amdgcn_s_setprio(0); } while (0)
#define PG8_WAIT_V(n) asm volatile("s_waitcnt vmcnt(" #n ")" ::: "memory")
#define PG8_WAIT_L(n) asm volatile("s_waitcnt lgkmcnt(" #n ")" ::: "memory")
#define PG8_BAR __builtin_amdgcn_s_barrier()
#define PG8_SCHED __builtin_amdgcn_sched_barrier(0)
    Unit cur, nxt; int ui = 0;
    if (!S.next(0, cur)) return;
    f32x4 acc[2][2][4][2];
#pragma unroll
    for (int a = 0; a < 2; ++a)
#pragma unroll
        for (int b = 0; b < 2; ++b)
#pragma unroll
            for (int m = 0; m < 4; ++m)
#pragma unroll
                for (int n = 0; n < 2; ++n) acc[a][b][m][n] = (f32x4){0.f, 0.f, 0.f, 0.f};
    bf16x8 At[4][2], B0[2][2], B1[2][2];
    const char* cA = (const char*)g.A + (size_t)cur.pm * tstep; const char* cB = (const char*)g.Bt + (size_t)cur.pn * tstep;
    S.a_ready(cur);
    if constexpr (SP2) {
        PG8_STAGE(PG8_SB(0, 0), cB, voffB); PG8_STAGE(PG8_SB(0, 1), cB + hstep, voffB); PG8_STAGE(PG8_SA(0, 0), cA, voffA); PG8_STAGE(PG8_SA(0, 1), cA + hstep, voffA);
        if (wr == 1) PG8_BAR;
        PG8_WAIT_V(2); PG8_BAR;
        PG8_STAGE(PG8_SB(1, 0), cB + kstep, voffB); PG8_STAGE(PG8_SA(1, 0), cA + kstep, voffA); PG8_STAGE(PG8_SB(1, 1), cB + hstep + kstep, voffB);
        PG8_WAIT_V(6); PG8_BAR;
    } else {
        PG8_STAGE(PG8_SB(0, 0), cB, voffB); PG8_STAGE(PG8_SA(0, 0), cA, voffA); PG8_STAGE(PG8_SB(0, 1), cB + hstep, voffB); PG8_STAGE(PG8_SA(0, 1), cA + hstep, voffA);
        if (wr == 1) PG8_BAR;
        PG8_WAIT_V(4); PG8_BAR;
        PG8_STAGE(PG8_SB(1, 0), cB + kstep, voffB); PG8_STAGE(PG8_SA(1, 0), cA + kstep, voffA); PG8_STAGE(PG8_SB(1, 1), cB + hstep + kstep, voffB);
        PG8_WAIT_V(6); PG8_BAR;
    }
    for (;;) {
        const bool has_next = S.next(ui + 1, nxt);
        const char* nA = has_next ? (const char*)g.A + (size_t)nxt.pm * tstep : cA; const char* nB = has_next ? (const char*)g.Bt + (size_t)nxt.pn * tstep : cB;
        for (int t = 0; t < nt; t += 2) {
            const bool last = (t == nt - 2);
            const char* a1 = cA + (size_t)(t + 1) * kstep;
            const char* a2 = last ? nA : cA + (size_t)(t + 2) * kstep; const char* b2 = last ? nB : cB + (size_t)(t + 2) * kstep;
            const char* a3 = a2 + kstep; const char* b3 = b2 + kstep;
            if (last && has_next) S.a_ready(nxt);
            if constexpr (SP2) {
            PG8_LDB(B0, 0, 0); PG8_LDB(B1, 0, 1); PG8_SCHED; PG8_LDA(At, 0, 0); PG8_STAGE(PG8_SA(1, 1), a1 + hstep, voffA);
            PG8_WAIT_V(8); PG8_WAIT_L(0); PG8_BAR; PG8_MMA(0, 0, At, B0); PG8_MMA(0, 1, At, B1); PG8_BAR; PG8_SCHED;
            PG8_LDA(At, 0, 1); PG8_STAGE(PG8_SB(0, 0), b2, voffB); PG8_STAGE(PG8_SB(0, 1), b2 + hstep, voffB); PG8_STAGE(PG8_SA(0, 0), a2, voffA);
            PG8_WAIT_V(8); PG8_WAIT_L(0); PG8_BAR; PG8_MMA(1, 0, At, B0); PG8_MMA(1, 1, At, B1); PG8_BAR; PG8_SCHED;
            PG8_LDB(B0, 1, 0); PG8_LDB(B1, 1, 1); PG8_SCHED; PG8_LDA(At, 1, 0); PG8_STAGE(PG8_SA(0, 1), a2 + hstep, voffA);
            PG8_WAIT_V(8); PG8_WAIT_L(0); PG8_BAR; PG8_MMA(0, 0, At, B0); PG8_MMA(0, 1, At, B1); PG8_BAR; PG8_SCHED;
            PG8_LDA(At, 1, 1); PG8_STAGE(PG8_SB(1, 0), b3, voffB); PG8_STAGE(PG8_SB(1, 1), b3 + hstep, voffB); PG8_STAGE(PG8_SA(1, 0), a3, voffA);
            PG8_WAIT_V(8); PG8_WAIT_L(0); PG8_BAR; PG8_MMA(1, 0, At, B0); PG8_MMA(1, 1, At, B1); PG8_BAR; PG8_SCHED;
            } else {
            PG8_LDB(B0, 0, 0); PG8_SCHED; PG8_LDA(At, 0, 0); PG8_STAGE(PG8_SA(1, 1), a1 + hstep, voffA);
            PG8_WAIT_L(8); PG8_BAR; PG8_WAIT_L(0); PG8_MMA(0, 0, At, B0); PG8_BAR; PG8_SCHED;
            PG8_LDB(B1, 0, 1); PG8_STAGE(PG8_SB(0, 0), b2, voffB);
            PG8_BAR; PG8_WAIT_L(0); PG8_MMA(0, 1, At, B1); PG8_BAR;
            PG8_LDA(At, 0, 1); PG8_STAGE(PG8_SA(0, 0), a2, voffA);
            PG8_BAR; PG8_WAIT_L(0); PG8_MMA(1, 0, At, B0); PG8_BAR; PG8_SCHED;
            PG8_STAGE(PG8_SB(0, 1), b2 + hstep, voffB);
            PG8_WAIT_V(6); PG8_BAR; PG8_MMA(1, 1, At, B1); PG8_BAR;
            PG8_LDB(B0, 1, 0); PG8_SCHED; PG8_LDA(At, 1, 0); PG8_STAGE(PG8_SA(0, 1), a2 + hstep, voffA);
            PG8_WAIT_L(8); PG8_BAR; PG8_WAIT_L(0); PG8_MMA(0, 0, At, B0); PG8_BAR; PG8_SCHED;
            PG8_LDB(B1, 1, 1); PG8_STAGE(PG8_SB(1, 0), b3, voffB);
            PG8_BAR; PG8_WAIT_L(0); PG8_MMA(0, 1, At, B1); PG8_BAR;
            PG8_LDA(At, 1, 1); PG8_STAGE(PG8_SA(1, 0), a3, voffA);
            PG8_BAR; PG8_WAIT_L(0); PG8_MMA(1, 0, At, B0); PG8_BAR; PG8_SCHED;
            PG8_STAGE(PG8_SB(1, 1), b3 + hstep, voffB);
            PG8_WAIT_V(6); PG8_BAR; PG8_MMA(1, 1, At, B1); PG8_BAR;
            }
        }
        if constexpr (ALIGN_EPI) { if (wr == 0) PG8_BAR; }
        if constexpr (!Epi::AFTER_DRAIN) { E(acc, cur, wr, wc, fr, fq); S.done(cur); }
        if (!has_next) break;
#pragma unroll
        for (int a = 0; a < 2; ++a)
#pragma unroll
            for (int b = 0; b < 2; ++b)
#pragma unroll
                for (int m = 0; m < 4; ++m)
#pragma unroll
                    for (int n = 0; n < 2; ++n) acc[a][b][m][n] = (f32x4){0.f, 0.f, 0.f, 0.f};
        cur = nxt; cA = nA; cB = nB; ++ui;
        if constexpr (ALIGN_EPI) { if (wr == 1) PG8_BAR; }
    }
    PG8_WAIT_V(0);
    if constexpr (!ALIGN_EPI) { if (wr == 0) PG8_BAR; }
    PG8_BAR;
    if constexpr (Epi::AFTER_DRAIN) { E.fused(acc, cur, wr, wc, fr, fq, lds, wid, lane); S.done(cur); }
#undef PG8_SA
#undef PG8_SB
#undef PG8_STAGE
#undef PG8_LDA
#undef PG8_LDB
#undef PG8_MMA
#undef PG8_WAIT_V
#undef PG8_WAIT_L
#undef PG8_BAR
#undef PG8_SCHED
}

struct EpiProj {
    static constexpr bool PERM = true, AFTER_DRAIN = false;
    bf16_t* P; bf16_t* MIXp; int np_cols; int npt;
    __device__ __forceinline__ void operator()(const f32x4 (&acc)[2][2][4][2], const Unit& u, int wr, int wc, int fr, int fq) const {
        const int row0 = u.pm * BM + wr * 64 + fr;
        bf16_t* base; int ldc, colt;
        if (u.pn < npt) { base = P; ldc = np_cols; colt = u.pn * BM; } else { base = MIXp; ldc = 1536; colt = (u.pn - npt) * BM; }
        const int col0 = colt + wc * 32 + 8 * fq;
#pragma unroll
        for (int ai = 0; ai < 2; ++ai)
#pragma unroll
            for (int m = 0; m < 4; ++m) { bf16_t* rowp = base + (size_t)(row0 + ai * HALF + m * 16) * ldc + col0;
#pragma unroll
                for (int bj = 0; bj < 2; ++bj) { const f32x4 v0 = acc[ai][bj][m][0], v1 = acc[ai][bj][m][1];
                    u32x4 w; w.x = cvt_pk_bf16(v0[0], v0[1]); w.y = cvt_pk_bf16(v0[2], v0[3]); w.z = cvt_pk_bf16(v1[0], v1[1]); w.w = cvt_pk_bf16(v1[2], v1[3]);
                    *(u32x4*)(rowp + bj * HALF) = w; } }
    }
};
struct EpiResidF32 {
    static constexpr bool PERM = false, AFTER_DRAIN = false;
    const float* xi; float* xo;
    __device__ __forceinline__ void operator()(const f32x4 (&acc)[2][2][4][2], const Unit& u, int wr, int wc, int fr, int fq) const {
        const int col0 = u.pn * BM + wc * 32 + 4 * fq;
#pragma unroll
        for (int ai = 0; ai < 2; ++ai)
#pragma unroll
            for (int m = 0; m < 4; ++m) { const size_t off = (size_t)(u.pm * BM + ai * HALF + wr * 64 + m * 16 + fr) * 1024 + col0;
#pragma unroll
                for (int bj = 0; bj < 2; ++bj)
#pragma unroll
                    for (int n = 0; n < 2; ++n) { const f32x4 b = *(const f32x4*)(xi + off + bj * HALF + n * 16); *(f32x4*)(xo + off + bj * HALF + n * 16) = b + acc[ai][bj][m][n]; } }
    }
};
}

template <class Epi>
__device__ __forceinline__ void gemm_naive(const Ctx& C, const bf16* A, int lda, const bf16* Bt, int ldb, int Mr, int Nr, int K, int tile0, int tstride, const Epi& E) {
    LAS float* As = (LAS float*)C.lds;
    LAS float* Bs = As + 32 * 132;
    const int tid = C.tid, ty = tid >> 4, tx = tid & 15;
    const int nMt = Mr / 128, nNt = Nr / 128, ntiles = nMt * nNt;
    for (int tile = tile0; tile < ntiles; tile += tstride) {
        const int tm = tile % nMt, tn = tile / nMt;
        float acc[4][8];
#pragma unroll
        for (int i = 0; i < 4; ++i)
#pragma unroll
            for (int j = 0; j < 8; ++j) acc[i][j] = 0.f;
        const int lr = tid >> 2, lk = (tid & 3) * 8;
        for (int k0 = 0; k0 < K; k0 += 32) {
            const v4u av = *(const GAS v4u*)(A + (size_t)(tm * 128 + lr) * lda + k0 + lk);
            const v4u bv = *(const GAS v4u*)(Bt + (size_t)(tn * 128 + lr) * ldb + k0 + lk);
            __syncthreads();
#pragma unroll
            for (int j = 0; j < 4; ++j) {
                As[(lk + 2 * j) * 132 + lr] = __uint_as_float(av[j] << 16); As[(lk + 2 * j + 1) * 132 + lr] = __uint_as_float(av[j] & 0xffff0000u);
                Bs[(lk + 2 * j) * 132 + lr] = __uint_as_float(bv[j] << 16); Bs[(lk + 2 * j + 1) * 132 + lr] = __uint_as_float(bv[j] & 0xffff0000u);
            }
            __syncthreads();
#pragma unroll 2
            for (int k = 0; k < 32; ++k) {
                const f32x4 a = *(const LAS f32x4*)(As + k * 132 + ty * 4);
                const f32x4 b0 = *(const LAS f32x4*)(Bs + k * 132 + tx * 8), b1 = *(const LAS f32x4*)(Bs + k * 132 + tx * 8 + 4);
#pragma unroll
                for (int i = 0; i < 4; ++i) {
                    acc[i][0] += a[i] * b0[0]; acc[i][1] += a[i] * b0[1]; acc[i][2] += a[i] * b0[2]; acc[i][3] += a[i] * b0[3];
                    acc[i][4] += a[i] * b1[0]; acc[i][5] += a[i] * b1[1]; acc[i][6] += a[i] * b1[2]; acc[i][7] += a[i] * b1[3];
                }
            }
        }
#pragma unroll
        for (int i = 0; i < 4; ++i) E(tm * 128 + ty * 4 + i, tn * 128 + tx * 8, acc[i]);
    }
    __syncthreads();
}
struct EpiStoreBf16 {
    bf16* O; int ldc;
    __device__ __forceinline__ void operator()(int m, int n0, const float (&v)[8]) const {
        v4u w; w.x = pk2(v[0], v[1]); w.y = pk2(v[2], v[3]); w.z = pk2(v[4], v[5]); w.w = pk2(v[6], v[7]);
        *(GAS v4u*)(O + (size_t)m * ldc + n0) = w; }
};
struct EpiInProj {
    bf16* P; bf16* MIX; int NP;
    __device__ __forceinline__ void operator()(int m, int n0, const float (&v)[8]) const {
        v4u w; w.x = pk2(v[0], v[1]); w.y = pk2(v[2], v[3]); w.z = pk2(v[4], v[5]); w.w = pk2(v[6], v[7]);
        if (n0 < NP) *(GAS v4u*)(P + (size_t)m * NP + n0) = w; else *(GAS v4u*)(MIX + (size_t)m * NMIX + (n0 - NP)) = w; }
};
struct EpiResid {
    const float* xi; float* xo;
    __device__ __forceinline__ void operator()(int m, int n0, const float (&v)[8]) const {
        const f32x4 a = *(const GAS f32x4*)(xi + (size_t)m * D + n0), b = *(const GAS f32x4*)(xi + (size_t)m * D + n0 + 4);
        f32x4 o0 = {a[0] + v[0], a[1] + v[1], a[2] + v[2], a[3] + v[3]}, o1 = {b[0] + v[4], b[1] + v[5], b[2] + v[6], b[3] + v[7]};
        *(GAS f32x4*)(xo + (size_t)m * D + n0) = o0; *(GAS f32x4*)(xo + (size_t)m * D + n0 + 4) = o1; }
};

__device__ __forceinline__ float dot8(const v4u w, const LAS float* q) {
    const f32x4 q0 = *(const LAS f32x4*)q, q1 = *(const LAS f32x4*)(q + 4);
    return (__uint_as_float(w[0] << 16) * q0[0] + __uint_as_float(w[0] & 0xffff0000u) * q0[1]) + (__uint_as_float(w[1] << 16) * q0[2] + __uint_as_float(w[1] & 0xffff0000u) * q0[3])
         + (__uint_as_float(w[2] << 16) * q1[0] + __uint_as_float(w[2] & 0xffff0000u) * q1[1]) + (__uint_as_float(w[3] << 16) * q1[2] + __uint_as_float(w[3] & 0xffff0000u) * q1[3]);
}
__device__ __forceinline__ void naive_winattn_item(const Ctx& C, const float* sink, int item, LAS float* pw) {
    const bf16* P = (const bf16*)(C.ws + WS_P); bf16* MIX = (bf16*)(C.ws + WS_MIX);
    int lane = C.lane; asm volatile("" : "+v"(lane));
    const int hq = item & 7, m = item >> 3, t = m & (T - 1), b = m >> 12, n = hq >> 2;
    const float slope = exp2f(-(float)(hq + 1)), sk = sink[hq];
    LAS float* qs = pw + 320;
    qs[lane] = bf2f(P[(size_t)m * NP_E + E_QA + hq * 64 + lane]);
    LDS_WAIT(); asm volatile("" ::: "memory");
    float mx = -3e38f;
#pragma unroll 1
    for (int i = 0; i < 5; ++i) {
        const int j = lane + 64 * i, s = t - 128 + j; const bool valid = (j <= 256) && (s >= 0) && (s < T);
        float acc = -3e38f;
        if (valid) { const GAS v4u* kp = (const GAS v4u*)(P + (size_t)(b * T + s) * NP_E + E_KA + n * 64); acc = 0.f;
#pragma unroll
            for (int jj = 0; jj < 8; ++jj) acc += dot8(kp[jj], qs + 8 * jj);
            acc = acc * 0.125f - slope * fabsf((float)(t - s)); mx = fmaxf(mx, acc); }
        if (j <= 256) pw[j] = acc;
    }
    mx = fmaxf(wave_max(mx), sk);
    LDS_WAIT(); asm volatile("" ::: "memory");
    float sum = 0.f;
#pragma unroll 1
    for (int i = 0; i < 5; ++i) { const int j = lane + 64 * i; if (j <= 256) { const float sc = pw[j]; const float p = (sc > -1e38f) ? __expf(sc - mx) : 0.f; sum += p; pw[j] = p; } }
    sum = wave_sum(sum) + __expf(sk - mx);
    LDS_WAIT(); asm volatile("" ::: "memory");
    float o = 0.f;
    for (int j = 0; j <= 256; ++j) { const int s = t - 128 + j; if (s < 0 || s >= T) continue;
        o += pw[j] * bf2f(P[(size_t)(b * T + s) * NP_E + E_VA + n * 64 + lane]); }
    o /= sum;
    bf16* gp = MIX + (size_t)m * NMIX + X_GA + hq * 64 + lane;
    *gp = (bf16)f2bf(o * siluf_(bf2f(*gp)));
    LDS_WAIT(); asm volatile("" ::: "memory");
}
__device__ __forceinline__ void naive_memattn_item(const Ctx& C, int l, int item, LAS float* pw) {
    const int NP = (l & 1) ? NP_O : NP_E, QOFF = (l & 1) ? O_QM : E_QM;
    const bf16* P = (const bf16*)(C.ws + WS_P); bf16* MIX = (bf16*)(C.ws + WS_MIX);
    const bf16* MK = (const bf16*)(C.ws + WS_MEMK) + (size_t)l * 1024 * 512; const bf16* MVT = (const bf16*)(C.ws + WS_MEMVT) + (size_t)l * 512 * 1024;
    int lane = C.lane; asm volatile("" : "+v"(lane));
    const int h = item & 3, m = item >> 2, b = m >> 12;
    LAS float* qs = pw + 320;
    qs[lane] = bf2f(P[(size_t)m * NP + QOFF + h * 128 + lane]); qs[lane + 64] = bf2f(P[(size_t)m * NP + QOFF + h * 128 + lane + 64]);
    LDS_WAIT(); asm volatile("" ::: "memory");
    float mx = -3e38f;
#pragma unroll 1
    for (int i = 0; i < 4; ++i) { const int s = lane + 64 * i;
        const GAS v4u* kp = (const GAS v4u*)(MK + (size_t)(b * NMEM + s) * 512 + h * 128); float acc = 0.f;
#pragma unroll
        for (int jj = 0; jj < 16; ++jj) acc += dot8(kp[jj], qs + 8 * jj);
        acc *= 0.08838834764831845f; mx = fmaxf(mx, acc); pw[s] = acc; }
    mx = wave_max(mx);
    LDS_WAIT(); asm volatile("" ::: "memory");
    float sum = 0.f;
#pragma unroll 1
    for (int i = 0; i < 4; ++i) { const int s = lane + 64 * i; const float p = __expf(pw[s] - mx); sum += p; pw[s] = p; }
    sum = wave_sum(sum);
    LDS_WAIT(); asm volatile("" ::: "memory");
#pragma unroll 1
    for (int dd = 0; dd < 2; ++dd) { const int d = lane + 64 * dd; const bf16* vp = MVT + (size_t)(h * 128 + d) * 1024 + b * NMEM; float o = 0.f;
#pragma unroll 4
        for (int s = 0; s < NMEM; s += 8) o += dot8(*(const GAS v4u*)(vp + s), pw + s);
        o /= sum;
        bf16* gp = MIX + (size_t)m * NMIX + X_GM + h * 128 + d;
        *gp = (bf16)f2bf(o * siluf_(bf2f(*gp))); }
    LDS_WAIT(); asm volatile("" ::: "memory");
}
template <int ODD>
__device__ __forceinline__ void naive_scan_item(const Ctx& C, const float* lbp, const float* wgu, const float* bgp, int l, int item, LAS float* scr) {
    constexpr int DV = ODD ? 256 : 128, NCG = DV / 32, NP = ODD ? NP_O : NP_E, VOFF = ODD ? O_VC : E_IB, TS = 8;
    int lane = C.lane; asm volatile("" : "+v"(lane));
    const int li = l >> 1, kh = lane >> 5;
    const int cg = item % NCG, h = (item / NCG) & 3, b = item / (NCG * 4);
    const bf16* P = (const bf16*)(C.ws + WS_P);
    float* O = (float*)(C.ws + (ODD ? WS_OO : WS_OE));
    LAS float* fq = scr; LAS float* fk = scr + TS * 128; LAS float* ff = scr + 2 * TS * 128;
    const int col = h * DV + cg * 32 + (lane & 31);
    for (int dir = 0; dir < 2; ++dir) {
        float lbv[2] = {0.f, 0.f}, bg[2] = {0.f, 0.f};
#pragma unroll
        for (int c = 0; c < 2; ++c) { const int ch = h * 128 + lane + 64 * c;
            if (!ODD) { if (li == 1) { const float p0 = lbp[(0 * 2 + dir) * 512 + ch], p1 = lbp[(1 * 2 + dir) * 512 + ch]; lbv[c] = 1.f / (1.f + __expf(p0 - p1)); } }
            else bg[c] = bgp[(li * 2 + dir) * 512 + ch]; }
        const float* wup = wgu + (size_t)(li * 2 + dir) * 16 * 512 + h * 128 + lane;
        float S[64];
#pragma unroll
        for (int k = 0; k < 64; ++k) S[k] = 0.f;
        for (int tb = 0; tb < T; tb += TS) {
#pragma unroll 1
            for (int s = 0; s < TS; ++s) { const int t = dir ? (T - 1 - (tb + s)) : (tb + s); const size_t m = (size_t)b * T + t; const bf16* row = P + m * NP;
#pragma unroll
                for (int c = 0; c < 2; ++c) { const int k = lane + 64 * c, ch = h * 128 + k; float qv, kv, fv;
                    if (!ODD) { const float z = bf2f(row[(dir ? E_ZB : E_ZF) + ch]); const float sg = sigmoidf_(z);
                        fv = lbv[c] + (1.f - lbv[c]) * sg; kv = (1.f - lbv[c]) * (1.f - sg); qv = siluf_(bf2f(row[E_QB + ch])); }
                    else { float pre = bg[c];
#pragma unroll
                        for (int r = 0; r < 16; ++r) pre += bf2f(row[(dir ? O_RB : O_RF) + r]) * wup[r * 512 + 64 * c];
                        const float ls = fminf(pre, 0.f) - log1pf(__expf(-fabsf(pre)));
                        fv = __expf(ls * (1.f / 16.f)); kv = bf2f(row[O_KC + ch]); qv = bf2f(row[O_QC + ch]) * 0.08838834764831845f; }
                    fq[s * 128 + k] = qv; fk[s * 128 + k] = kv; ff[s * 128 + k] = fv; } }
            LDS_WAIT(); asm volatile("" ::: "memory");
#pragma unroll 1
            for (int s = 0; s < TS; ++s) { const int t = dir ? (T - 1 - (tb + s)) : (tb + s); const size_t m = (size_t)b * T + t;
                const float v = bf2f(P[m * NP + VOFF + col]); float o = 0.f;
                const LAS float* pf = ff + s * 128 + kh * 64; const LAS float* pk = fk + s * 128 + kh * 64; const LAS float* pq = fq + s * 128 + kh * 64;
#pragma unroll
                for (int k4 = 0; k4 < 16; ++k4) { const f32x4 f4 = *(const LAS f32x4*)(pf + 4 * k4), k4v = *(const LAS f32x4*)(pk + 4 * k4), q4 = *(const LAS f32x4*)(pq + 4 * k4);
#pragma unroll
                    for (int e = 0; e < 4; ++e) { S[4 * k4 + e] = f4[e] * S[4 * k4 + e] + k4v[e] * v; o += q4[e] * S[4 * k4 + e]; }
                    if ((k4 & 3) == 3) asm volatile("" ::: "memory"); }
                o += __shfl_xor(o, 32);
                float* op = O + m * (4 * DV) + col;
                if (kh == 0) { if (dir) *op += o; else *op = o; } }
            LDS_WAIT(); asm volatile("" ::: "memory");
        }
    }
}
template <int ODD>
__device__ __forceinline__ void naive_gnorm_item(const Ctx& C, const float* gw_, int l, int item) {
    constexpr int DV = ODD ? 256 : 128, NC = DV / 64, GOFF = ODD ? X_GC : X_GB;
    int lane = C.lane; asm volatile("" : "+v"(lane));
    const int li = l >> 1, h = item & 3, m = item >> 2;
    const float* O = (const float*)(C.ws + (ODD ? WS_OO : WS_OE)) + (size_t)m * (4 * DV) + h * DV;
    const float* g = gw_ + li * (4 * DV) + h * DV;
    bf16* MIX = (bf16*)(C.ws + WS_MIX) + (size_t)m * NMIX + GOFF + h * DV;
    float v[NC]; float s = 0.f;
#pragma unroll
    for (int c = 0; c < NC; ++c) { v[c] = O[lane + 64 * c]; s += v[c] * v[c]; }
    const float rstd = 1.f / sqrtf(wave_sum(s) * (1.f / DV) + EPS);
#pragma unroll
    for (int c = 0; c < NC; ++c) { bf16* gp = MIX + lane + 64 * c; *gp = (bf16)f2bf(v[c] * rstd * g[lane + 64 * c] * siluf_(bf2f(*gp))); }
}

namespace scan {
typedef short bf16x8 __attribute__((ext_vector_type(8)));
typedef short s16x4 __attribute__((ext_vector_type(4)));
typedef float f32x16 __attribute__((ext_vector_type(16)));
typedef float f32x2_t __attribute__((ext_vector_type(2)));
typedef __bf16 bf16x2_t __attribute__((ext_vector_type(2)));
typedef short v4i16_t __attribute__((ext_vector_type(4)));
__device__ __forceinline__ unsigned cvtpk(float lo, float hi) { f32x2_t v = {lo, hi}; bf16x2_t b = __builtin_convertvector(v, bf16x2_t); return __builtin_bit_cast(unsigned, b); }
__device__ __forceinline__ s16x4 trd(const LAS unsigned char* p) { return __builtin_bit_cast(s16x4, __builtin_amdgcn_ds_read_tr16_b64_v4i16((LAS v4i16_t*)p)); }
#define SC_MFMA(a, b, c) __builtin_amdgcn_mfma_f32_32x32x16_bf16((a), (b), (c), 0, 0, 0)
__device__ __forceinline__ bf16x8 pack8(const f32x16& x, int s) {
    v4u p; p.x = cvtpk(x[8 * s + 0], x[8 * s + 1]); p.y = cvtpk(x[8 * s + 2], x[8 * s + 3]); p.z = cvtpk(x[8 * s + 4], x[8 * s + 5]); p.w = cvtpk(x[8 * s + 6], x[8 * s + 7]);
    return __builtin_bit_cast(bf16x8, p);
}
__device__ __forceinline__ float expc(float x) { return __expf(fminf(x, 80.f)); }

template <int ODD> struct Geo {
    static constexpr int NH = ODD ? 1 : 2, DVH = ODD ? 256 : 128, KH = 128 * NH, NHG = 4 / NH, SCLEN = ODD ? 256 : 128, NSC = T / SCLEN, NCH = SCLEN / 32;
    static constexpr int NP = ODD ? NP_O : NP_E, QOFF = ODD ? O_QC : E_QB, VOFF = ODD ? O_VC : E_IB, GOFF = ODD ? X_GC : X_GB;
    static constexpr int RSB = KH * 4;
    static constexpr int RSK = KH * 2 + 16;
    static constexpr int RST = KH * 2 + 64;
    static constexpr int RSV = 512 + 64;
    static constexpr int RSO = 260 * 4;
    static constexpr int OFF_B = 0, OFF_Q1 = 34816, OFF_Q2 = OFF_Q1 + 32 * RSK, OFF_K2 = OFF_Q2 + 32 * RSK, OFF_W = OFF_K2 + 32 * RSK, OFF_V = OFF_W + 32 * RST, OFF_D = OFF_V + 32 * RSV, OFF_END = OFF_D + 1024;
    static_assert(OFF_END <= RING_BYTES, "scan LDS map");
    static constexpr size_t L_ITEM = (size_t)DVH * 128;
};
struct ScanPtrs { const bf16* P; bf16* MIX; bf16* L; float* LOGD; bf16* OG; const float* lbp; const float* wgu; const float* bgp; const float* gnw; };

template <int ODD, int MODE>
__device__ __forceinline__ void scan_item(const Ctx& C, const ScanPtrs& sp, int li, int b, int hg, int sc, int dir0) {
    typedef Geo<ODD> G;
    const int tid = C.tid, wave = C.wave; int lane = C.lane; asm volatile("" : "+v"(lane));
    const int r = lane & 31, h = lane >> 5, i16 = lane & 15, q4 = i16 >> 2, p4 = i16 & 3, g1 = (lane >> 4) & 1;
    const int hh = wave / (8 / G::NH), h0 = hg * G::NH;
    const int kc0 = hh * 128, vcol0 = wave * 32;
    LAS unsigned char* lds = C.lds;
    const int sc0 = sc * G::SCLEN;
    const bf16* Pb = sp.P + (size_t)b * T * G::NP;
    f32x16 S[4];
    for (int dd = 0; dd < (MODE ? 2 : 1); ++dd) {
        const int dir = MODE ? dd : dir0;
        float lbv = 0.f, bgv = 0.f, wupv[16]; float logd_acc = 0.f;
        if (tid < G::KH) {
            const int ch = h0 * 128 + tid;
            if (!ODD) { if (li == 1) { const float p0 = sp.lbp[(0 * 2 + dir) * 512 + ch], p1 = sp.lbp[(1 * 2 + dir) * 512 + ch]; lbv = 1.f / (1.f + __expf(p0 - p1)); } }
            else { bgv = sp.bgp[(li * 2 + dir) * 512 + ch];
#pragma unroll
                for (int rr = 0; rr < 16; ++rr) wupv[rr] = sp.wgu[((size_t)(li * 2 + dir) * 16 + rr) * 512 + ch]; }
        }
        if (MODE) { const bf16* Lp = sp.L + ((((size_t)(b * 4 + h0 + hh) * G::NSC + sc) * 2 + dir) * G::L_ITEM) + (size_t)((vcol0 - hh * G::DVH) + r) * 128;
#pragma unroll
            for (int kt = 0; kt < 4; ++kt)
#pragma unroll
                for (int g4 = 0; g4 < 4; ++g4) { const v2u w = *(const GAS v2u*)(Lp + 32 * kt + 8 * g4 + 4 * h);
                    S[kt][4 * g4 + 0] = __uint_as_float(w.x << 16); S[kt][4 * g4 + 1] = __uint_as_float(w.x & 0xffff0000u); S[kt][4 * g4 + 2] = __uint_as_float(w.y << 16); S[kt][4 * g4 + 3] = __uint_as_float(w.y & 0xffff0000u); } }
        else {
#pragma unroll
            for (int kt = 0; kt < 4; ++kt)
#pragma unroll
                for (int e = 0; e < 16; ++e) S[kt][e] = 0.f; }
#pragma unroll 1
        for (int ci = 0; ci < G::NCH; ++ci) {
            const int tbase = dir ? (sc0 + G::SCLEN - 1 - 32 * ci) : (sc0 + 32 * ci); const int tstep = dir ? -1 : 1;
            if (tid < G::KH) {
                float bacc = 0.f;
#pragma unroll 4
                for (int i = 0; i < 32; ++i) { const bf16* row = Pb + (size_t)(tbase + tstep * i) * G::NP; float gl;
                    if (!ODD) { const float z = bf2f(row[(dir ? E_ZB : E_ZF) + h0 * 128 + tid]); const float f = lbv + (1.f - lbv) * sigmoidf_(z); gl = __logf(fmaxf(f, 1e-30f)); }
                    else { const v4u r0 = *(const GAS v4u*)(row + (dir ? O_RB : O_RF)), r1 = *(const GAS v4u*)(row + (dir ? O_RB : O_RF) + 8); float pre = bgv;
#pragma unroll
                        for (int e = 0; e < 4; ++e) { pre += __uint_as_float(r0[e] << 16) * wupv[2 * e] + __uint_as_float(r0[e] & 0xffff0000u) * wupv[2 * e + 1];
                                                      pre += __uint_as_float(r1[e] << 16) * wupv[8 + 2 * e] + __uint_as_float(r1[e] & 0xffff0000u) * wupv[8 + 2 * e + 1]; }
                        gl = (fminf(pre, 0.f) - __logf(1.f + __expf(-fabsf(pre)))) * (1.f / 16.f); }
                    bacc += gl; *(LAS float*)(lds + G::OFF_B + i * G::RSB + tid * 4) = bacc; }
                *(LAS float*)(lds + G::OFF_D + tid * 4) = __expf(bacc); logd_acc += bacc;
            }
            __syncthreads();
            for (int u = tid; u < 32 * G::KH / 8; u += NTHR) {
                const int i = u / (G::KH / 8), c8 = (u % (G::KH / 8)) * 8; const bf16* row = Pb + (size_t)(tbase + tstep * i) * G::NP;
                const f32x4 b0 = *(const LAS f32x4*)(lds + G::OFF_B + i * G::RSB + c8 * 4), b1 = *(const LAS f32x4*)(lds + G::OFF_B + i * G::RSB + c8 * 4 + 16);
                const f32x4 r0 = *(const LAS f32x4*)(lds + G::OFF_B + 15 * G::RSB + c8 * 4), r1 = *(const LAS f32x4*)(lds + G::OFF_B + 15 * G::RSB + c8 * 4 + 16);
                const f32x4 e0 = *(const LAS f32x4*)(lds + G::OFF_B + 31 * G::RSB + c8 * 4), e1 = *(const LAS f32x4*)(lds + G::OFF_B + 31 * G::RSB + c8 * 4 + 16);
                float bb[8] = {b0[0], b0[1], b0[2], b0[3], b1[0], b1[1], b1[2], b1[3]}, rr[8] = {r0[0], r0[1], r0[2], r0[3], r1[0], r1[1], r1[2], r1[3]}, ee[8] = {e0[0], e0[1], e0[2], e0[3], e1[0], e1[1], e1[2], e1[3]};
                float kk[8], qq[8];
                if (!ODD) { const v4u zv = *(const GAS v4u*)(row + (dir ? E_ZB : E_ZF) + h0 * 128 + c8);
                    float lb8[8];
#pragma unroll
                    for (int e = 0; e < 8; ++e) { lb8[e] = 0.f; if (li == 1) { const int ch = h0 * 128 + c8 + e; lb8[e] = 1.f / (1.f + __expf(sp.lbp[(0 * 2 + dir) * 512 + ch] - sp.lbp[(1 * 2 + dir) * 512 + ch])); } }
#pragma unroll
                    for (int e = 0; e < 4; ++e) { kk[2 * e] = (1.f - lb8[2 * e]) * (1.f - sigmoidf_(__uint_as_float(zv[e] << 16))); kk[2 * e + 1] = (1.f - lb8[2 * e + 1]) * (1.f - sigmoidf_(__uint_as_float(zv[e] & 0xffff0000u))); }
                    if (MODE) { const v4u qv = *(const GAS v4u*)(row + E_QB + h0 * 128 + c8);
#pragma unroll
                        for (int e = 0; e < 4; ++e) { qq[2 * e] = siluf_(__uint_as_float(qv[e] << 16)); qq[2 * e + 1] = siluf_(__uint_as_float(qv[e] & 0xffff0000u)); } } }
                else { const v4u kv = *(const GAS v4u*)(row + O_KC + h0 * 128 + c8);
#pragma unroll
                    for (int e = 0; e < 4; ++e) { kk[2 * e] = __uint_as_float(kv[e] << 16); kk[2 * e + 1] = __uint_as_float(kv[e] & 0xffff0000u); }
                    if (MODE) { const v4u qv = *(const GAS v4u*)(row + O_QC + h0 * 128 + c8);
#pragma unroll
                        for (int e = 0; e < 4; ++e) { qq[2 * e] = __uint_as_float(qv[e] << 16) * 0.08838834764831845f; qq[2 * e + 1] = __uint_as_float(qv[e] & 0xffff0000u) * 0.08838834764831845f; } } }
                v4u w;
                w.x = cvtpk(kk[0] * __expf(ee[0] - bb[0]), kk[1] * __expf(ee[1] - bb[1])); w.y = cvtpk(kk[2] * __expf(ee[2] - bb[2]), kk[3] * __expf(ee[3] - bb[3]));
                w.z = cvtpk(kk[4] * __expf(ee[4] - bb[4]), kk[5] * __expf(ee[5] - bb[5])); w.w = cvtpk(kk[6] * __expf(ee[6] - bb[6]), kk[7] * __expf(ee[7] - bb[7]));
                *(LAS v4u*)(lds + G::OFF_W + i * G::RST + c8 * 2) = w;
                if (MODE) {
                    float dl[8];
#pragma unroll
                    for (int e = 0; e < 8; ++e) dl[e] = bb[e] - rr[e];
                    w.x = cvtpk(qq[0] * __expf(bb[0]), qq[1] * __expf(bb[1])); w.y = cvtpk(qq[2] * __expf(bb[2]), qq[3] * __expf(bb[3]));
                    w.z = cvtpk(qq[4] * __expf(bb[4]), qq[5] * __expf(bb[5])); w.w = cvtpk(qq[6] * __expf(bb[6]), qq[7] * __expf(bb[7]));
                    *(LAS v4u*)(lds + G::OFF_Q1 + i * G::RSK + c8 * 2) = w;
                    w.x = cvtpk(qq[0] * expc(dl[0]), qq[1] * expc(dl[1])); w.y = cvtpk(qq[2] * expc(dl[2]), qq[3] * expc(dl[3]));
                    w.z = cvtpk(qq[4] * expc(dl[4]), qq[5] * expc(dl[5])); w.w = cvtpk(qq[6] * expc(dl[6]), qq[7] * expc(dl[7]));
                    *(LAS v4u*)(lds + G::OFF_Q2 + i * G::RSK + c8 * 2) = w;
                    w.x = cvtpk(kk[0] * expc(-dl[0]), kk[1] * expc(-dl[1])); w.y = cvtpk(kk[2] * expc(-dl[2]), kk[3] * expc(-dl[3]));
                    w.z = cvtpk(kk[4] * expc(-dl[4]), kk[5] * expc(-dl[5])); w.w = cvtpk(kk[6] * expc(-dl[6]), kk[7] * expc(-dl[7]));
                    *(LAS v4u*)(lds + G::OFF_K2 + i * G::RSK + c8 * 2) = w;
                }
            }
            for (int u = tid; u < 32 * 32; u += NTHR) { const int i = u >> 5, c8 = (u & 31) * 8;
                *(LAS v4u*)(lds + G::OFF_V + i * G::RSV + c8 * 2) = *(const GAS v4u*)(Pb + (size_t)(tbase + tstep * i) * G::NP + G::VOFF + h0 * G::DVH + c8); }
            __syncthreads();
            f32x16 o;
            if (MODE) {
#pragma unroll
                for (int e = 0; e < 16; ++e) o[e] = 0.f;
#pragma unroll
                for (int kt = 0; kt < 4; ++kt)
#pragma unroll
                    for (int st = 0; st < 2; ++st) { const LAS unsigned char* qp = lds + G::OFF_Q1 + r * G::RSK + (kc0 + 32 * kt + 16 * st + 4 * h) * 2;
                        const s16x4 lo = *(const LAS s16x4*)qp, hi = *(const LAS s16x4*)(qp + 16);
                        const bf16x8 a = __builtin_shufflevector(lo, hi, 0, 1, 2, 3, 4, 5, 6, 7);
                        o = SC_MFMA(a, pack8(S[kt], st), o); }
                f32x16 at;
#pragma unroll
                for (int e = 0; e < 16; ++e) at[e] = 0.f;
#pragma unroll
                for (int ks = 0; ks < 8; ++ks) { const bf16x8 a = *(const LAS bf16x8*)(lds + G::OFF_K2 + r * G::RSK + (kc0 + 16 * ks + 8 * h) * 2), bq = *(const LAS bf16x8*)(lds + G::OFF_Q2 + r * G::RSK + (kc0 + 16 * ks + 8 * h) * 2);
                    at = SC_MFMA(a, bq, at); }
#pragma unroll
                for (int e = 0; e < 16; ++e) { const int srow = (e & 3) + 8 * (e >> 2) + 4 * h; at[e] = (srow <= r) ? at[e] : 0.f; }
#pragma unroll
                for (int st = 0; st < 2; ++st) { const LAS unsigned char* vp = lds + G::OFF_V + (16 * st + 4 * h + q4) * G::RSV + (vcol0 + 16 * g1 + 4 * p4) * 2;
                    const s16x4 lo = trd(vp), hi = trd(vp + 8 * G::RSV);
                    const bf16x8 bv = __builtin_shufflevector(lo, hi, 0, 1, 2, 3, 4, 5, 6, 7);
                    o = SC_MFMA(pack8(at, st), bv, o); }
            }
#pragma unroll
            for (int kt = 0; kt < 4; ++kt)
#pragma unroll
                for (int g4 = 0; g4 < 4; ++g4) { const f32x4 dv = *(const LAS f32x4*)(lds + G::OFF_D + (kc0 + 32 * kt + 8 * g4 + 4 * h) * 4);
#pragma unroll
                    for (int e = 0; e < 4; ++e) S[kt][4 * g4 + e] *= dv[e]; }
#pragma unroll
            for (int st = 0; st < 2; ++st) { const LAS unsigned char* vp = lds + G::OFF_V + (16 * st + 8 * h + q4) * G::RSV + (vcol0 + 16 * g1 + 4 * p4) * 2;
                const s16x4 vlo = trd(vp), vhi = trd(vp + 4 * G::RSV);
                const bf16x8 bv = __builtin_shufflevector(vlo, vhi, 0, 1, 2, 3, 4, 5, 6, 7);
#pragma unroll
                for (int kt = 0; kt < 4; ++kt) { const LAS unsigned char* wp = lds + G::OFF_W + (16 * st + 8 * h + q4) * G::RST + (kc0 + 32 * kt + 16 * g1 + 4 * p4) * 2;
                    const s16x4 wlo = trd(wp), whi = trd(wp + 4 * G::RST);
                    const bf16x8 aw = __builtin_shufflevector(wlo, whi, 0, 1, 2, 3, 4, 5, 6, 7);
                    S[kt] = SC_MFMA(aw, bv, S[kt]); } }
            if (MODE) {
#pragma unroll
                for (int e = 0; e < 16; ++e) *(LAS float*)(lds + G::OFF_B + ((e & 3) + 8 * (e >> 2) + 4 * h) * G::RSO + (vcol0 + r) * 4) = o[e];
                __syncthreads();
                { const int i = tid >> 4, seg = tid & 15, vc = seg * 16; const size_t m = (size_t)b * T + (tbase + tstep * i);
                  float v[16];
#pragma unroll
                  for (int e4 = 0; e4 < 4; ++e4) { const f32x4 x = *(const LAS f32x4*)(lds + G::OFF_B + i * G::RSO + (vc + 4 * e4) * 4); v[4 * e4] = x[0]; v[4 * e4 + 1] = x[1]; v[4 * e4 + 2] = x[2]; v[4 * e4 + 3] = x[3]; }
                  bf16* og = sp.OG + m * (G::NHG * 256) + hg * 256 + vc;
                  if (dd == 0) { v4u w0, w1; w0.x = cvtpk(v[0], v[1]); w0.y = cvtpk(v[2], v[3]); w0.z = cvtpk(v[4], v[5]); w0.w = cvtpk(v[6], v[7]); w1.x = cvtpk(v[8], v[9]); w1.y = cvtpk(v[10], v[11]); w1.z = cvtpk(v[12], v[13]); w1.w = cvtpk(v[14], v[15]);
                      *(GAS v4u*)og = w0; *(GAS v4u*)(og + 8) = w1; }
                  else { const v4u w0 = *(const GAS v4u*)og, w1 = *(const GAS v4u*)(og + 8); float ss = 0.f;
#pragma unroll
                      for (int e = 0; e < 4; ++e) { v[2 * e] += __uint_as_float(w0[e] << 16); v[2 * e + 1] += __uint_as_float(w0[e] & 0xffff0000u); v[8 + 2 * e] += __uint_as_float(w1[e] << 16); v[8 + 2 * e + 1] += __uint_as_float(w1[e] & 0xffff0000u); }
#pragma unroll
                      for (int e = 0; e < 16; ++e) ss += v[e] * v[e];
#pragma unroll
                      for (int o_ = 1; o_ < G::DVH / 16; o_ <<= 1) ss += __shfl_xor(ss, o_);
                      const float rstd = 1.f / sqrtf(ss * (1.f / G::DVH) + EPS);
                      bf16* mp = sp.MIX + m * NMIX + G::GOFF + h0 * G::DVH + vc; const float* gwp = sp.gnw + li * (4 * G::DVH) + h0 * G::DVH + vc;
                      const v4u g0 = *(const GAS v4u*)mp, g1v = *(const GAS v4u*)(mp + 8); float gt[16];
#pragma unroll
                      for (int e = 0; e < 4; ++e) { gt[2 * e] = __uint_as_float(g0[e] << 16); gt[2 * e + 1] = __uint_as_float(g0[e] & 0xffff0000u); gt[8 + 2 * e] = __uint_as_float(g1v[e] << 16); gt[8 + 2 * e + 1] = __uint_as_float(g1v[e] & 0xffff0000u); }
#pragma unroll
                      for (int e = 0; e < 16; ++e) v[e] = v[e] * rstd * gwp[e] * siluf_(gt[e]);
                      v4u w0o, w1o; w0o.x = cvtpk(v[0], v[1]); w0o.y = cvtpk(v[2], v[3]); w0o.z = cvtpk(v[4], v[5]); w0o.w = cvtpk(v[6], v[7]); w1o.x = cvtpk(v[8], v[9]); w1o.y = cvtpk(v[10], v[11]); w1o.z = cvtpk(v[12], v[13]); w1o.w = cvtpk(v[14], v[15]);
                      *(GAS v4u*)mp = w0o; *(GAS v4u*)(mp + 8) = w1o; }
                }
            }
            __syncthreads();
        }
        if (!MODE) {
            bf16* Lp = sp.L + ((((size_t)(b * 4 + h0 + hh) * G::NSC + sc) * 2 + dir) * G::L_ITEM) + (size_t)((vcol0 - hh * G::DVH) + r) * 128;
#pragma unroll
            for (int kt = 0; kt < 4; ++kt)
#pragma unroll
                for (int g4 = 0; g4 < 4; ++g4) { v2u w; w.x = cvtpk(S[kt][4 * g4], S[kt][4 * g4 + 1]); w.y = cvtpk(S[kt][4 * g4 + 2], S[kt][4 * g4 + 3]); *(GAS v2u*)(Lp + 32 * kt + 8 * g4 + 4 * h) = w; }
            if (tid < G::KH) sp.LOGD[(((size_t)(b * 4 + h0 + (tid >> 7)) * G::NSC + sc) * 2 + dir) * 128 + (tid & 127)] = logd_acc;
        }
        if (MODE) { asm volatile("s_waitcnt vmcnt(0)" ::: "memory"); __syncthreads(); }
    }
}

template <int ODD>
__device__ __forceinline__ void scan_combine(const Ctx& C, const ScanPtrs& sp) {
    typedef Geo<ODD> G;
    const int nunits = 16 * 2 * G::DVH * 16;
    for (int u = C.bid * NTHR + C.tid; u < nunits; u += C.G * NTHR) {
        const int k8 = (u & 15) * 8, j = (u >> 4) % G::DVH, dir = ((u >> 4) / G::DVH) & 1, bh = (u >> 4) / (G::DVH * 2);
        float S[8];
#pragma unroll
        for (int e = 0; e < 8; ++e) S[e] = 0.f;
#pragma unroll 4
        for (int s = 0; s < G::NSC; ++s) { const int sc = dir ? (G::NSC - 1 - s) : s;
            bf16* p = sp.L + (((size_t)bh * G::NSC + sc) * 2 + dir) * G::L_ITEM + (size_t)j * 128 + k8;
            const float* ld = sp.LOGD + (((size_t)bh * G::NSC + sc) * 2 + dir) * 128 + k8;
            const v4u w = *(const GAS v4u*)p; const f32x4 d0 = *(const GAS f32x4*)ld, d1 = *(const GAS f32x4*)(ld + 4);
            v4u o; o.x = cvtpk(S[0], S[1]); o.y = cvtpk(S[2], S[3]); o.z = cvtpk(S[4], S[5]); o.w = cvtpk(S[6], S[7]);
            *(GAS v4u*)p = o;
            const float dd[8] = {d0[0], d0[1], d0[2], d0[3], d1[0], d1[1], d1[2], d1[3]};
#pragma unroll
            for (int e = 0; e < 4; ++e) { S[2 * e] = __expf(dd[2 * e]) * S[2 * e] + __uint_as_float(w[e] << 16); S[2 * e + 1] = __expf(dd[2 * e + 1]) * S[2 * e + 1] + __uint_as_float(w[e] & 0xffff0000u); }
        }
    }
}
}

namespace attn {
using scan::bf16x8; using scan::s16x4; using scan::f32x16; using scan::cvtpk; using scan::trd; using scan::pack8;
constexpr int WK_RS = 144, WV_RS = 192, WK_OFF = 0, WV_OFF = 384 * WK_RS;
static_assert(WV_OFF + 384 * WV_RS <= RING_BYTES, "window attention LDS");
constexpr int MK_RS = 272, MV_RS = 520, MK_OFF = 0, MV_OFF = 256 * MK_RS;
static_assert(MV_OFF + 128 * MV_RS <= RING_BYTES + 8192, "memory attention LDS");

__device__ __forceinline__ void winattn_unit(const Ctx& C, const bf16* P, bf16* MIX, const float* sink8, int b, int n, int c) {
    const int tid = C.tid, wave = C.wave; int lane = C.lane; asm volatile("" : "+v"(lane));
    const int r = lane & 31, h = lane >> 5, i16 = lane & 15, q4 = i16 >> 2, p4 = i16 & 3, g1 = (lane >> 4) & 1;
    LAS unsigned char* lds = C.lds;
    for (int u = tid; u < 384 * 8; u += NTHR) { const int j = u >> 3, c8 = (u & 7) * 8, s = 128 * (c - 1) + j;
        v4u kv = {0u, 0u, 0u, 0u}, vv = {0u, 0u, 0u, 0u};
        if (s >= 0 && s < T) { const bf16* row = P + (size_t)(b * T + s) * NP_E; kv = *(const GAS v4u*)(row + E_KA + n * 64 + c8); vv = *(const GAS v4u*)(row + E_VA + n * 64 + c8); }
        *(LAS v4u*)(lds + WK_OFF + j * WK_RS + c8 * 2) = kv; *(LAS v4u*)(lds + WV_OFF + j * WV_RS + c8 * 2) = vv; }
    __syncthreads();
    const int hq = 4 * n + (wave >> 1);
    const float slope = exp2f(-(float)(hq + 1)), sk = sink8[hq];
#pragma unroll 1
    for (int tt = 0; tt < 2; ++tt) {
        const int qt = 2 * (wave & 1) + tt; const int t = 128 * c + 32 * qt + r; const size_t m = (size_t)b * T + t;
        bf16x8 qf[4];
#pragma unroll
        for (int ks = 0; ks < 4; ++ks) qf[ks] = *(const GAS bf16x8*)(P + m * NP_E + E_QA + hq * 64 + 16 * ks + 8 * h);
        f32x16 o[2];
#pragma unroll
        for (int dt = 0; dt < 2; ++dt)
#pragma unroll
            for (int e = 0; e < 16; ++e) o[dt][e] = 0.f;
        float mrun = sk, lrun = 0.f;
#pragma unroll 1
        for (int kg = 0; kg < 3; ++kg) {
            f32x16 st[3];
#pragma unroll
            for (int k3 = 0; k3 < 3; ++k3) {
#pragma unroll
                for (int e = 0; e < 16; ++e) st[k3][e] = 0.f;
#pragma unroll
                for (int ks = 0; ks < 4; ++ks) { const bf16x8 a = *(const LAS bf16x8*)(lds + WK_OFF + (32 * (qt + 3 * kg + k3) + r) * WK_RS + (16 * ks + 8 * h) * 2); st[k3] = SC_MFMA(a, qf[ks], st[k3]); } }
            float mx = -3e38f;
#pragma unroll
            for (int k3 = 0; k3 < 3; ++k3)
#pragma unroll
                for (int e = 0; e < 16; ++e) { const int kt = 3 * kg + k3; const int cr = (e & 3) + 8 * (e >> 2) + 4 * h; const int dd = 128 - 32 * kt + r - cr; const int s = 128 * (c - 1) + 32 * (qt + kt) + cr;
                    const int ad = dd < 0 ? -dd : dd; const bool valid = (ad <= 128) && (s >= 0) && (s < T);
                    const float val = valid ? (st[k3][e] * 0.125f - slope * (float)ad) : -3e38f; st[k3][e] = val; mx = fmaxf(mx, val); }
            mx = fmaxf(mx, __shfl_xor(mx, 32));
            const float mnew = fmaxf(mrun, mx), alpha = __expf(mrun - mnew);
            mrun = mnew; lrun *= alpha;
#pragma unroll
            for (int dt = 0; dt < 2; ++dt)
#pragma unroll
                for (int e = 0; e < 16; ++e) o[dt][e] *= alpha;
#pragma unroll
            for (int k3 = 0; k3 < 3; ++k3)
#pragma unroll
                for (int e = 0; e < 16; ++e) { const float p = (st[k3][e] > -1e38f) ? __expf(st[k3][e] - mnew) : 0.f; st[k3][e] = p; lrun += p; }
#pragma unroll
            for (int k3 = 0; k3 < 3; ++k3)
#pragma unroll
                for (int s2 = 0; s2 < 2; ++s2) { const bf16x8 bx = pack8(st[k3], s2);
#pragma unroll
                    for (int dt = 0; dt < 2; ++dt) { const LAS unsigned char* vp = lds + WV_OFF + (32 * (qt + 3 * kg + k3) + 16 * s2 + 4 * h + q4) * WV_RS + (32 * dt + 16 * g1 + 4 * p4) * 2;
                        const s16x4 lo = trd(vp), hi = trd(vp + 8 * WV_RS);
                        const bf16x8 a = __builtin_shufflevector(lo, hi, 0, 1, 2, 3, 4, 5, 6, 7);
                        o[dt] = SC_MFMA(a, bx, o[dt]); } }
        }
        const float inv = 1.f / (lrun + __shfl_xor(lrun, 32) + __expf(sk - mrun));
        bf16* mp = MIX + m * NMIX + X_GA + hq * 64;
#pragma unroll
        for (int dt = 0; dt < 2; ++dt)
#pragma unroll
            for (int g4 = 0; g4 < 4; ++g4) { const int d = 32 * dt + 8 * g4 + 4 * h; const v2u gv = *(const GAS v2u*)(mp + d);
                const float g0 = __uint_as_float(gv.x << 16), g1f = __uint_as_float(gv.x & 0xffff0000u), g2 = __uint_as_float(gv.y << 16), g3 = __uint_as_float(gv.y & 0xffff0000u);
                v2u w; w.x = cvtpk(o[dt][4 * g4] * inv * siluf_(g0), o[dt][4 * g4 + 1] * inv * siluf_(g1f)); w.y = cvtpk(o[dt][4 * g4 + 2] * inv * siluf_(g2), o[dt][4 * g4 + 3] * inv * siluf_(g3));
                *(GAS v2u*)(mp + d) = w; }
    }
    __syncthreads();
}

__device__ __forceinline__ void memattn_unit(const Ctx& C, const bf16* P, int NP, int QOFF, bf16* MIX, const bf16* MK, const bf16* MVT, int b, int hh, int tb) {
    const int tid = C.tid, wave = C.wave; int lane = C.lane; asm volatile("" : "+v"(lane));
    const int r = lane & 31, h = lane >> 5;
    LAS unsigned char* lds = C.lds;
    for (int u = tid; u < 256 * 16; u += NTHR) { const int j = u >> 4, c8 = (u & 15) * 8;
        *(LAS v4u*)(lds + MK_OFF + j * MK_RS + c8 * 2) = *(const GAS v4u*)(MK + (size_t)(b * NMEM + j) * 512 + hh * 128 + c8); }
    for (int u = tid; u < 128 * 32; u += NTHR) { const int d = u >> 5, c8 = (u & 31) * 8;
        const v4u w = *(const GAS v4u*)(MVT + (size_t)(hh * 128 + d) * 1024 + b * NMEM + c8);
        v2u w0 = {w.x, w.y}, w1 = {w.z, w.w};
        *(LAS v2u*)(lds + MV_OFF + d * MV_RS + c8 * 2) = w0; *(LAS v2u*)(lds + MV_OFF + d * MV_RS + c8 * 2 + 8) = w1; }
    __syncthreads();
    const size_t m = (size_t)b * T + tb * 256 + wave * 32 + r;
    f32x16 st[8];
    { bf16x8 qf[8];
#pragma unroll
      for (int ks = 0; ks < 8; ++ks) qf[ks] = *(const GAS bf16x8*)(P + m * NP + QOFF + hh * 128 + 16 * ks + 8 * h);
#pragma unroll
      for (int kt = 0; kt < 8; ++kt) {
#pragma unroll
          for (int e = 0; e < 16; ++e) st[kt][e] = 0.f;
#pragma unroll
          for (int ks = 0; ks < 8; ++ks) { const bf16x8 a = *(const LAS bf16x8*)(lds + MK_OFF + (32 * kt + r) * MK_RS + (16 * ks + 8 * h) * 2); st[kt] = SC_MFMA(a, qf[ks], st[kt]); } } }
    float mx = -3e38f;
#pragma unroll
    for (int kt = 0; kt < 8; ++kt)
#pragma unroll
        for (int e = 0; e < 16; ++e) mx = fmaxf(mx, st[kt][e]);
    mx = fmaxf(mx, __shfl_xor(mx, 32));
    float sum = 0.f;
#pragma unroll
    for (int kt = 0; kt < 8; ++kt)
#pragma unroll
        for (int e = 0; e < 16; ++e) { const float p = __expf((st[kt][e] - mx) * 0.08838834764831845f); st[kt][e] = p; sum += p; }
    sum += __shfl_xor(sum, 32);
    const float inv = 1.f / sum;
    f32x16 o[4];
#pragma unroll
    for (int dt = 0; dt < 4; ++dt)
#pragma unroll
        for (int e = 0; e < 16; ++e) o[dt][e] = 0.f;
#pragma unroll
    for (int kt = 0; kt < 8; ++kt)
#pragma unroll
        for (int s2 = 0; s2 < 2; ++s2) { const bf16x8 bx = pack8(st[kt], s2);
#pragma unroll
            for (int dt = 0; dt < 4; ++dt) { const LAS unsigned char* vp = lds + MV_OFF + (32 * dt + r) * MV_RS + (32 * kt + 16 * s2 + 4 * h) * 2;
                const s16x4 lo = *(const LAS s16x4*)vp, hi = *(const LAS s16x4*)(vp + 16);
                const bf16x8 a = __builtin_shufflevector(lo, hi, 0, 1, 2, 3, 4, 5, 6, 7);
                o[dt] = SC_MFMA(a, bx, o[dt]); } }
    bf16* mp = MIX + m * NMIX + X_GM + hh * 128;
#pragma unroll
    for (int dt = 0; dt < 4; ++dt)
#pragma unroll
        for (int g4 = 0; g4 < 4; ++g4) { const int d = 32 * dt + 8 * g4 + 4 * h; const v2u gv = *(const GAS v2u*)(mp + d);
            const float g0 = __uint_as_float(gv.x << 16), g1f = __uint_as_float(gv.x & 0xffff0000u), g2 = __uint_as_float(gv.y << 16), g3 = __uint_as_float(gv.y & 0xffff0000u);
            v2u w; w.x = cvtpk(o[dt][4 * g4] * inv * siluf_(g0), o[dt][4 * g4 + 1] * inv * siluf_(g1f)); w.y = cvtpk(o[dt][4 * g4 + 2] * inv * siluf_(g2), o[dt][4 * g4 + 3] * inv * siluf_(g3));
            *(GAS v2u*)(mp + d) = w; }
    __syncthreads();
}
}

constexpr int STEPS_PER_LAYER = 6, NSTEPS = 2 + DEPTH * STEPS_PER_LAYER;

__global__ void __launch_bounds__(NTHR, 2) mk_fwd(Args args) {
    extern __shared__ __attribute__((aligned(16))) unsigned char lds_raw[];
    Ctx C;
    C.lds = (LAS unsigned char*)lds_raw;
    C.tid = threadIdx.x; C.lane = C.tid & 63; C.wave = __builtin_amdgcn_readfirstlane(C.tid >> 6);
    C.G = gridDim.x; C.bid = blockIdx.x;
    C.out = args.out; C.ws = args.ws;
    volatile LAS unsigned* MISC = (volatile LAS unsigned*)(C.lds + MISC_OFF);
    for (int u = C.tid; u < (LDS_BYTES - RING_BYTES) / 4; u += NTHR) ((LAS unsigned*)(C.lds + RING_BYTES))[u] = 0u;
    __syncthreads();
    XcdBarrier bar; bar.bar = (unsigned*)(C.ws + WS_CTL) + CW_BAR; bar.x = 0; bar.st = nullptr;
    const int lo = args.ph_lo, hi = args.ph_hi;
    if (hi - lo > 1) bar = xcd_barrier_post((unsigned*)(C.ws + WS_CTL) + CW_BAR, MISC + 8);
    int step = 0; bool run_ = false;
#define PHASE_BEGIN { int _st = step; asm volatile("" : "+s"(_st)); run_ = (_st >= lo && _st < hi); } if (run_) { { unsigned char* _w = args.ws; float* _o = args.out; asm volatile("" : "+s"(_w), "+s"(_o)); C.ws = _w; C.out = _o; \
        int _t = threadIdx.x; asm volatile("" : "+v"(_t)); C.tid = _t; C.lane = _t & 63; C.wave = __builtin_amdgcn_readfirstlane(_t >> 6); \
        gw = C.bid * NWAVES + C.wave; wscr = (LAS float*)(C.lds + C.wave * 16384); \
        P = (bf16*)(C.ws + WS_P); MIX = (bf16*)(C.ws + WS_MIX); HN = (bf16*)(C.ws + WS_HN); }
#define PHASE_END   if (step + 1 < hi) xcd_barrier(bar); } ++step;

    int gw = C.bid * NWAVES + C.wave; const int NGW = C.G * NWAVES;
    LAS float* wscr = (LAS float*)(C.lds + C.wave * 16384);
    bf16* P = (bf16*)(C.ws + WS_P); bf16* MIX = (bf16*)(C.ws + WS_MIX); bf16* HN = (bf16*)(C.ws + WS_HN);

    PHASE_BEGIN if (TEST_MASK & 1) phase_prep(C, args); PHASE_END
    PHASE_BEGIN
#pragma unroll 1
        for (int l = 0; l < DEPTH; ++l) {
            const bf16* WKV = (const bf16*)(C.ws + WS_WKV) + (size_t)l * 1024 * 1024; const bf16* MEMN = (const bf16*)(C.ws + WS_MEMN);
#if USE_PG8
            { pg8::Gemm g{MEMN, WKV, 1024, 512, 1024}; pg8::StaticOrder S; S.init(1024, 512, C.G, (C.bid + C.G - 16 * l) % C.G);
              pg8::EpiProj e{(bf16*)(C.ws + WS_MEMK) + (size_t)l * 1024 * 512, nullptr, 512, 1 << 20};
              pg8::gemm_phase<pg8::EpiProj, pg8::StaticOrder, false, true>(C.lds, g, S, e); }
            { pg8::Gemm g{WKV + (size_t)512 * 1024, MEMN, 512, 1024, 1024}; pg8::StaticOrder S; S.init(512, 1024, C.G, (C.bid + C.G - 16 * l - 8) % C.G);
              pg8::EpiProj e{(bf16*)(C.ws + WS_MEMVT) + (size_t)l * 512 * 1024, nullptr, 1024, 1 << 20};
              pg8::gemm_phase<pg8::EpiProj, pg8::StaticOrder, false, true>(C.lds, g, S, e); }
#else
            EpiStoreBf16 ek{(bf16*)(C.ws + WS_MEMK) + (size_t)l * 1024 * 512, 512};
            gemm_naive(C, MEMN, 1024, WKV, 1024, 1024, 512, 1024, (C.bid + 32 * l) % C.G, C.G, ek);
            EpiStoreBf16 ev{(bf16*)(C.ws + WS_MEMVT) + (size_t)l * 512 * 1024, 1024};
            gemm_naive(C, WKV + (size_t)512 * 1024, 1024, MEMN, 1024, 512, 1024, 1024, (C.bid + 32 * l + 128) % C.G, C.G, ev);
#endif
        }
    PHASE_END

#pragma unroll 1
    for (int l = 0; l < DEPTH; ++l) {
        const int odd = l & 1, li = l >> 1;
        PHASE_BEGIN
#if USE_PG8
            pg8::Gemm g{HN, (const bf16*)(C.ws + WS_WIN), M, odd ? NIN_O : NIN_E, 1024}; pg8::StaticOrder S; S.init(M, odd ? NIN_O : NIN_E, C.G, C.bid);
            pg8::EpiProj e{P, MIX, odd ? NP_O : NP_E, (odd ? NP_O : NP_E) / 256};
            pg8::gemm_phase<pg8::EpiProj, pg8::StaticOrder, true, true>(C.lds, g, S, e);
#else
            EpiInProj e{P, MIX, odd ? NP_O : NP_E};
            gemm_naive(C, HN, 1024, (const bf16*)(C.ws + WS_WIN), 1024, M, odd ? NIN_O : NIN_E, 1024, C.bid, C.G, e);
#endif
        PHASE_END
        PHASE_BEGIN
#if USE_MFMA_SCAN
            { scan::ScanPtrs sp{P, MIX, (bf16*)(C.ws + (odd ? WS_L_O : WS_L_E)), (float*)(C.ws + WS_LOGD), (bf16*)(C.ws + (odd ? WS_OG_O : WS_OG_E)), args.in[5], args.in[10], args.in[11], odd ? args.in[12] : args.in[6]};
              const int NHG = odd ? 4 : 2, NSC = odd ? 16 : 32;
              for (int it = C.bid; it < BATCH * NHG * NSC * 2; it += C.G) { const int dir = it & 1, sc = (it >> 1) % NSC, hg = ((it >> 1) / NSC) % NHG, b = (it >> 1) / (NSC * NHG);
                  if (odd) scan::scan_item<1, 0>(C, sp, li, b, hg, sc, dir); else scan::scan_item<0, 0>(C, sp, li, b, hg, sc, dir); } }
            const int nscan = 0;
#if USE_MFMA_ATTN
            if (!odd) for (int it = C.bid; it < BATCH * 2 * 32; it += C.G) { const int c = it & 31, n = (it >> 5) & 1, b = it >> 6; attn::winattn_unit(C, P, MIX, args.in[4] + li * 8, b, n, c); }
            for (int it = C.bid; it < BATCH * 4 * 16; it += C.G) { const int tb = it & 15, hh = (it >> 4) & 3, b = it >> 6;
                attn::memattn_unit(C, P, odd ? NP_O : NP_E, odd ? O_QM : E_QM, MIX, (const bf16*)(C.ws + WS_MEMK) + (size_t)l * 1024 * 512, (const bf16*)(C.ws + WS_MEMVT) + (size_t)l * 512 * 1024, b, hh, tb); }
#endif
#else
            const int nscan = odd ? 128 : 64;
#endif
            if (gw < nscan) { if (TEST_MASK & 4) { if (odd) naive_scan_item<1>(C, args.in[5], args.in[10], args.in[11], l, gw, wscr); else naive_scan_item<0>(C, args.in[5], args.in[10], args.in[11], l, gw, wscr); } }
            else {
                const int w2 = gw - nscan, NW2 = NGW - nscan;
                const int nA = (odd || USE_MFMA_ATTN) ? 0 : M * 8, nM = USE_MFMA_ATTN ? 0 : M * 4, nW = (l + 1 < DEPTH) ? win_items(l + 1) : 0;
                for (int it = w2; it < nA + nM + nW; it += NW2) {
                    if (it < nA) naive_winattn_item(C, args.in[4] + li * 8, it, wscr);
                    else if (it < nA + nM) naive_memattn_item(C, l, it - nA, wscr);
                    else win_item(C, args.in[3], args.in[9], l + 1, it - nA - nM, wscr);
                }
            }
        PHASE_END
        PHASE_BEGIN
#if USE_MFMA_SCAN
            { scan::ScanPtrs sp{P, MIX, (bf16*)(C.ws + (odd ? WS_L_O : WS_L_E)), (float*)(C.ws + WS_LOGD), (bf16*)(C.ws + (odd ? WS_OG_O : WS_OG_E)), args.in[5], args.in[10], args.in[11], odd ? args.in[12] : args.in[6]};
              if (odd) scan::scan_combine<1>(C, sp); else scan::scan_combine<0>(C, sp); }
#else
            for (int it = gw; it < M * 4; it += NGW) { if (odd) naive_gnorm_item<1>(C, args.in[12], l, it); else naive_gnorm_item<0>(C, args.in[6], l, it); }
#endif
        PHASE_END
        PHASE_BEGIN
#if USE_MFMA_SCAN
            { scan::ScanPtrs sp{P, MIX, (bf16*)(C.ws + (odd ? WS_L_O : WS_L_E)), (float*)(C.ws + WS_LOGD), (bf16*)(C.ws + (odd ? WS_OG_O : WS_OG_E)), args.in[5], args.in[10], args.in[11], odd ? args.in[12] : args.in[6]};
              const int NHG = odd ? 4 : 2, NSC = odd ? 16 : 32;
              for (int it = C.bid; it < BATCH * NHG * NSC; it += C.G) { const int sc = it % NSC, hg = (it / NSC) % NHG, b = it / (NSC * NHG);
                  if (odd) scan::scan_item<1, 1>(C, sp, li, b, hg, sc, 0); else scan::scan_item<0, 1>(C, sp, li, b, hg, sc, 0); } }
#endif
        PHASE_END
        PHASE_BEGIN
#if USE_PG8
            pg8::Gemm g{MIX, (const bf16*)(C.ws + WS_WOUT) + (size_t)l * 1024 * 1536, M, 1024, 1536}; pg8::StaticOrder S; S.init(M, 1024, C.G, C.bid);
            pg8::EpiResidF32 e{l == 0 ? args.in[0] : C.out, C.out};
            pg8::gemm_phase<pg8::EpiResidF32, pg8::StaticOrder, false, true>(C.lds, g, S, e);
#else
            EpiResid e{l == 0 ? args.in[0] : C.out, C.out};
            gemm_naive(C, MIX, NMIX, (const bf16*)(C.ws + WS_WOUT) + (size_t)l * 1024 * 1536, 1536, M, 1024, 1536, C.bid, C.G, e);
#endif
        PHASE_END
        PHASE_BEGIN
            if (!(TEST_MASK & 32)) {} else if (l + 1 < DEPTH) { const float* g = ((l + 1) & 1) ? args.in[8] + ((l + 1) >> 1) * D : args.in[2] + ((l + 1) >> 1) * D;
                for (int r = gw; r < M; r += NGW) rms_row_to_bf16(C.out + (size_t)r * D, g, HN + (size_t)r * D, C.lane); }
            else { for (int r = gw; r < M; r += NGW) rms_row_to_f32(C.out + (size_t)r * D, args.in[16], C.out + (size_t)r * D, C.lane); }
        PHASE_END
    }
#undef PHASE_BEGIN
#undef PHASE_END
}

extern "C" void kernel_launch(void* const* d_in, const int* in_sizes, int n_in, void* d_out, int out_size, void* d_ws, size_t ws_size, hipStream_t stream) {
    static int grid = 0;
    if (grid == 0) {
        if (n_in != 17 || out_size != M * D || ws_size < WS_END) { fprintf(stderr, "kernel_launch: unexpected shapes n_in %d out %d ws %zu\n", n_in, out_size, ws_size); grid = -1; return; }
        int dev = 0, cus = 0, per_cu = 0;
        if (hipGetDevice(&dev) != hipSuccess || hipDeviceGetAttribute(&cus, hipDeviceAttributeMultiprocessorCount, dev) != hipSuccess) { grid = -1; return; }
        if (hipFuncSetAttribute((const void*)mk_fwd, hipFuncAttributeMaxDynamicSharedMemorySize, LDS_BYTES) != hipSuccess) { fprintf(stderr, "kernel_launch: hipFuncSetAttribute failed\n"); grid = -1; return; }
        if (hipOccupancyMaxActiveBlocksPerMultiprocessor(&per_cu, (const void*)mk_fwd, NTHR, LDS_BYTES) != hipSuccess || per_cu < 1)
            fprintf(stderr, "kernel_launch: occupancy query reports %d blocks per CU\n", per_cu);
        (void)hipGetLastError();
        grid = cus;
    }
    if (grid < 0) return;
    if (hipMemsetAsync((char*)d_ws + WS_CTL, 0, CTL_ZERO_BYTES, stream) != hipSuccess) return;
    Args a{};
    for (int i = 0; i < 17; ++i) a.in[i] = (const float*)d_in[i];
    a.out = (float*)d_out; a.ws = (unsigned char*)d_ws;
#if MK_ONE_LAUNCH
    a.ph_lo = 0; a.ph_hi = NSTEPS;
    hipLaunchKernelGGL(mk_fwd, dim3(grid), dim3(NTHR), LDS_BYTES, stream, a);
#else
    for (int s = 0; s < NSTEPS; ++s) { a.ph_lo = s; a.ph_hi = s + 1; hipLaunchKernelGGL(mk_fwd, dim3(grid), dim3(NTHR), LDS_BYTES, stream, a); }
#endif
}
```

```cpp
#include <hip/hip_runtime.h>
#include <cstdio>
#include <cstdint>

#ifndef TEST_MASK
#define TEST_MASK 0xFFFF
#endif
#ifndef USE_MFMA_ATTN
#define USE_MFMA_ATTN 1
#endif
#ifndef USE_MFMA_SCAN
#define USE_MFMA_SCAN 1
#endif
#ifndef USE_PG8
#define USE_PG8 1
#endif
#ifndef MK_ONE_LAUNCH
#define MK_ONE_LAUNCH 1
#endif

#define GAS __attribute__((address_space(1)))
#define LAS __attribute__((address_space(3)))
typedef unsigned short bf16;
typedef unsigned v4u __attribute__((ext_vector_type(4)));
typedef unsigned v2u __attribute__((ext_vector_type(2)));
typedef float f32x4 __attribute__((ext_vector_type(4)));
typedef GAS unsigned gu32;
#define RLX_AGENT __ATOMIC_RELAXED, __HIP_MEMORY_SCOPE_AGENT
#define LDS_WAIT() asm volatile("s_waitcnt lgkmcnt(0)" ::: "memory")
#define VM_WAIT() asm volatile("s_waitcnt vmcnt(0)" ::: "memory")

constexpr int NWAVES = 8, NTHR = 512;
constexpr int BATCH = 4, T = 4096, D = 1024, M = BATCH * T, DEPTH = 4;
constexpr int NMEM = 256;
constexpr int NP_E = 3328, NP_O = 2816, NMIX = 1536, NIN_E = 4864, NIN_O = 4352, NIN_O_SRC = 4128;
constexpr int E_QA = 0, E_KA = 512, E_VA = 640, E_QB = 768, E_ZF = 1280, E_ZB = 1792, E_IB = 2304, E_QM = 2816;
constexpr int O_QC = 0, O_KC = 512, O_VC = 1024, O_QM = 2048, O_RF = 2560, O_RB = 2576;
constexpr int X_GA = 0, X_GB = 512, X_GM = 1024, X_GC = 0;
constexpr float EPS = 1e-6f;

constexpr size_t MiB = 1u << 20;
constexpr size_t WS_CTL = 0, CTL_ZERO_BYTES = 1 * MiB;
constexpr size_t WS_WIN = 2 * MiB;
constexpr size_t WS_WOUT = 12 * MiB;
constexpr size_t WS_WKV = 24 * MiB;
constexpr size_t WS_MEMK = 32 * MiB;
constexpr size_t WS_MEMVT = 36 * MiB;
constexpr size_t WS_MEMN = 40 * MiB;
constexpr size_t WS_MIX = 43 * MiB;
constexpr size_t WS_P = 91 * MiB;
constexpr size_t WS_HN = 195 * MiB;
constexpr size_t WS_OE = 195 * MiB;
constexpr size_t WS_OO = 192 * MiB;
constexpr size_t WS_L_E = 195 * MiB, WS_OG_E = 227 * MiB;
constexpr size_t WS_L_O = 179 * MiB, WS_OG_O = 211 * MiB;
constexpr size_t WS_LOGD = 243 * MiB;
constexpr size_t WS_END = 256 * MiB;

constexpr int CW_BAR = 4096;

__device__ __forceinline__ float bf2f(bf16 v) { return __uint_as_float(((unsigned)v) << 16); }
__device__ __forceinline__ unsigned f2bf(float f) { unsigned u = __float_as_uint(f); return (u + 0x7fffu + ((u >> 16) & 1u)) >> 16; }
__device__ __forceinline__ unsigned pk2(float lo, float hi) { return f2bf(lo) | (f2bf(hi) << 16); }
__device__ __forceinline__ float wave_sum(float v) {
#pragma unroll
    for (int o = 1; o < 64; o <<= 1) v += __shfl_xor(v, o);
    return v;
}
__device__ __forceinline__ float wave_max(float v) {
#pragma unroll
    for (int o = 1; o < 64; o <<= 1) v = fmaxf(v, __shfl_xor(v, o));
    return v;
}
__device__ __forceinline__ float sigmoidf_(float z) { return 1.f / (1.f + __expf(-z)); }
__device__ __forceinline__ float siluf_(float z) { return z / (1.f + __expf(-z)); }

#define XB_TMO      128
#define XB_XCNT(j)  (256  + 64 * (j))
#define XB_XSUB(j)  (1280 + 64 * (j))
#define XB_XGEN(j)  (2304 + 64 * (j))
#define XB_TOP      3328
#define XB_TOPGEN   3392
#define XCD_BAR_WORDS 3456
#define XB_SPIN_CAP (1u << 22)
__device__ __forceinline__ unsigned xb_ld(unsigned* p)              { return __hip_atomic_load(p, __ATOMIC_RELAXED, __HIP_MEMORY_SCOPE_AGENT); }
__device__ __forceinline__ unsigned xb_add(unsigned* p, unsigned v) { return __hip_atomic_fetch_add(p, v, __ATOMIC_RELAXED, __HIP_MEMORY_SCOPE_AGENT); }
__device__ __forceinline__ unsigned xb_xcc_id() { return (unsigned)__builtin_amdgcn_s_getreg((3 << 11) | 20) & 0xFu; }
#define XB_SPIN(cond, bar) do { unsigned _sp = 0; while (cond) { __builtin_amdgcn_s_sleep(1); \
    if ((++_sp & 255u) == 0u) { if (xb_ld(&(bar)[XB_TMO])) break; if (_sp > XB_SPIN_CAP) { atomicAdd(&(bar)[XB_TMO], 1u); break; } } } } while (0)
struct XcdBarrier { unsigned* bar; unsigned x; volatile LAS unsigned* st; };
__device__ __forceinline__ XcdBarrier xcd_barrier_post(unsigned* bar, volatile LAS unsigned* st) {
    XcdBarrier b; b.bar = bar; b.x = xb_xcc_id(); b.st = st;
    if (threadIdx.x == 0) (void)xb_add(&bar[XB_XCNT(b.x)], 1u);
    return b;
}
__device__ __forceinline__ void xcd_barrier_complete(unsigned* bar, unsigned x, unsigned& nloc, unsigned& nx) {
    const unsigned G = gridDim.x * gridDim.y * gridDim.z;
    unsigned sum, cnt, mine, sp = 0u;
    for (;;) {
        sum = 0u; cnt = 0u; mine = 0u;
#pragma unroll
        for (unsigned j = 0; j < 16; ++j) { const unsigned c = xb_ld(&bar[XB_XCNT(j)]); sum += c; cnt += (c > 0u) ? 1u : 0u; mine = (j == x) ? c : mine; }
        if (sum == G) break;
        __builtin_amdgcn_s_sleep(1);
        if ((++sp & 255u) == 0u) { if (xb_ld(&bar[XB_TMO])) break; if (sp > XB_SPIN_CAP) { atomicAdd(&bar[XB_TMO], 1u); break; } }
    }
    nloc = mine > 0u ? mine : 1u; nx = cnt > 0u ? cnt : 1u;
}
__device__ __forceinline__ void xcd_barrier(const XcdBarrier& b) {
    asm volatile("s_waitcnt vmcnt(0)" ::: "memory");
    __syncthreads();
    if (threadIdx.x == 0) {
        unsigned* bar = b.bar; unsigned bx = b.x; asm volatile("" : "+s"(bar), "+s"(bx));
        __builtin_amdgcn_s_waitcnt(0);
        unsigned nloc = b.st[0], nx = b.st[1];
        if (nloc == 0u) { xcd_barrier_complete(bar, bx, nloc, nx); b.st[0] = nloc; b.st[1] = nx; }
        const unsigned old = xb_add(&bar[XB_XSUB(bx)], 1u);
        const unsigned gen = old / nloc;
        if (old + 1u == (gen + 1u) * nloc) {
            __builtin_amdgcn_fence(__ATOMIC_RELEASE, "agent");
            asm volatile("s_waitcnt vmcnt(0)" ::: "memory");
            const unsigned og = xb_add(&bar[XB_TOP], 1u);
            const unsigned tg = og / nx;
            if (og + 1u == (tg + 1u) * nx) xb_add(&bar[XB_TOPGEN], 1u);
            else XB_SPIN(xb_ld(&bar[XB_TOPGEN]) == tg, bar);
            __builtin_amdgcn_fence(__ATOMIC_ACQUIRE, "agent");
            xb_add(&bar[XB_XGEN(bx)], 1u);
            asm volatile("s_waitcnt vmcnt(0)" ::: "memory");
        } else {
            XB_SPIN(xb_ld(&bar[XB_XGEN(bx)]) == gen, bar);
            __builtin_amdgcn_fence(__ATOMIC_ACQUIRE, "agent");
            asm volatile("s_waitcnt vmcnt(0)" ::: "memory");
        }
    }
    __syncthreads();
}

constexpr int RING_BYTES = 139264;
constexpr int MISC_OFF = RING_BYTES + 320;
constexpr int LDS_BYTES = 147456;

struct Args { const float* in[17]; float* out; unsigned char* ws; int ph_lo, ph_hi; };
static_assert(sizeof(Args) == 17 * 8 + 8 + 8 + 8, "Args has no padding");

struct Ctx {
    LAS unsigned char* lds;
    int tid, lane, wave, G, bid;
    float* out; unsigned char* ws;
};

__device__ __forceinline__ void transpose_item(const float* W, int K, int N, bf16* WT, int k0, int n0, int drow0, LAS float* scr, int lane) {
    asm volatile("" : "+v"(lane));
#pragma unroll 8
    for (int i = 0; i < 32; ++i) { const int kk = 2 * i + (lane >> 5); scr[kk * 33 + (lane & 31)] = W[(size_t)(k0 + kk) * N + n0 + (lane & 31)]; }
    LDS_WAIT(); asm volatile("" ::: "memory");
    const int c = lane & 7;
#pragma unroll
    for (int j = 0; j < 4; ++j) { const int n = (lane >> 3) + 8 * j; const LAS float* s = scr + (8 * c) * 33 + n;
        v4u o; o.x = pk2(s[0 * 33], s[1 * 33]); o.y = pk2(s[2 * 33], s[3 * 33]); o.z = pk2(s[4 * 33], s[5 * 33]); o.w = pk2(s[6 * 33], s[7 * 33]);
        *(GAS v4u*)(WT + (size_t)(drow0 + n) * K + k0 + 8 * c) = o; }
    LDS_WAIT(); asm volatile("" ::: "memory");
}
__device__ __forceinline__ int map_even(int n0) {
    if (n0 < 768) return n0;
    if (n0 < 1280) return NP_E + X_GA + (n0 - 768);
    if (n0 < 3328) return E_QB + (n0 - 1280);
    if (n0 < 3840) return NP_E + X_GB + (n0 - 3328);
    if (n0 < 4352) return E_QM + (n0 - 3840);
    return NP_E + X_GM + (n0 - 4352);
}
__device__ __forceinline__ int map_odd(int n0) {
    if (n0 < 2048) return n0;
    if (n0 < 3072) return NP_O + X_GC + (n0 - 2048);
    if (n0 < 3104) return O_RF + (n0 - 3072);
    if (n0 < 3616) return O_QM + (n0 - 3104);
    return NP_O + X_GM + (n0 - 3616);
}
__device__ __forceinline__ int win_items(int l) { return (l & 1) ? (16 * (NIN_O_SRC / 32) + 224) : (16 * (NIN_E / 32)); }
__device__ __forceinline__ void win_item(const Ctx& C, const float* w_even, const float* w_odd, int l, int it, LAS float* scr) {
    bf16* WT = (bf16*)(C.ws + WS_WIN);
    if (l & 1) {
        const int nconv = 16 * (NIN_O_SRC / 32);
        if (it < nconv) { const int nb = it % (NIN_O_SRC / 32), kb = it / (NIN_O_SRC / 32);
            transpose_item(w_odd + (size_t)(l >> 1) * D * NIN_O_SRC, D, NIN_O_SRC, WT, kb * 64, nb * 32, map_odd(nb * 32), scr, C.lane); }
        else { const int r = 2592 + (it - nconv);
            GAS v4u* p = (GAS v4u*)(WT + (size_t)r * D); v4u z = {0u, 0u, 0u, 0u}; p[C.lane] = z; p[C.lane + 64] = z; }
    } else {
        const int nb = it % (NIN_E / 32), kb = it / (NIN_E / 32);
        transpose_item(w_even + (size_t)(l >> 1) * D * NIN_E, D, NIN_E, WT, kb * 64, nb * 32, map_even(nb * 32), scr, C.lane);
    }
}
__device__ __forceinline__ void rms_row_to_bf16(const float* xrow, const float* g, bf16* orow, int lane) {
    asm volatile("" : "+v"(lane));
    const GAS f32x4* xr = (const GAS f32x4*)xrow + lane; const GAS f32x4* gr = (const GAS f32x4*)g + lane;
    f32x4 v[4]; float s = 0.f;
#pragma unroll
    for (int j = 0; j < 4; ++j) { v[j] = xr[64 * j]; s += (v[j].x * v[j].x + v[j].y * v[j].y) + (v[j].z * v[j].z + v[j].w * v[j].w); }
    const float rstd = 1.f / sqrtf(wave_sum(s) * (1.f / D) + EPS);
    GAS unsigned long long* o8 = (GAS unsigned long long*)orow + lane;
#pragma unroll
    for (int j = 0; j < 4; ++j) { const f32x4 gg = gr[64 * j];
        o8[64 * j] = (unsigned long long)pk2(v[j].x * rstd * gg.x, v[j].y * rstd * gg.y) | ((unsigned long long)pk2(v[j].z * rstd * gg.z, v[j].w * rstd * gg.w) << 32); }
}
__device__ __forceinline__ void rms_row_to_f32(const float* xrow, const float* g, float* orow, int lane) {
    asm volatile("" : "+v"(lane));
    const GAS f32x4* xr = (const GAS f32x4*)xrow + lane; const GAS f32x4* gr = (const GAS f32x4*)g + lane;
    f32x4 v[4]; float s = 0.f;
#pragma unroll
    for (int j = 0; j < 4; ++j) { v[j] = xr[64 * j]; s += (v[j].x * v[j].x + v[j].y * v[j].y) + (v[j].z * v[j].z + v[j].w * v[j].w); }
    const float rstd = 1.f / sqrtf(wave_sum(s) * (1.f / D) + EPS);
    GAS f32x4* o = (GAS f32x4*)orow + lane;
#pragma unroll
    for (int j = 0; j < 4; ++j) { const f32x4 gg = gr[64 * j]; o[64 * j] = v[j] * rstd * gg; }
}

__device__ __forceinline__ void phase_prep(const Ctx& C, const Args& A) {
    LAS float* scr = (LAS float*)(C.lds + C.wave * 16384);
    const int gw = C.bid * NWAVES + C.wave, NGW = C.G * NWAVES;
    constexpr int I_OUT = (1536 / 64) * (1024 / 32), I_KV = (1024 / 64) * (1024 / 32);
    const int I_IN = win_items(0);
    const int total = 4 * I_OUT + 4 * I_KV + I_IN + 1024 + M;
    for (int it = gw; it < total; it += NGW) {
        int r = it;
        if (r < 4 * I_OUT) { const int l = r / I_OUT; r -= l * I_OUT; const int nb = r % 32, kb = r / 32;
            const float* W = (l & 1) ? A.in[13] + (size_t)(l >> 1) * 1536 * 1024 : A.in[7] + (size_t)(l >> 1) * 1536 * 1024;
            transpose_item(W, 1536, 1024, (bf16*)(C.ws + WS_WOUT) + (size_t)l * 1024 * 1536, kb * 64, nb * 32, nb * 32, scr, C.lane); continue; }
        r -= 4 * I_OUT;
        if (r < 4 * I_KV) { const int l = r / I_KV; r -= l * I_KV; const int nb = r % 32, kb = r / 32;
            transpose_item(A.in[15] + (size_t)l * 1024 * 1024, 1024, 1024, (bf16*)(C.ws + WS_WKV) + (size_t)l * 1024 * 1024, kb * 64, nb * 32, nb * 32, scr, C.lane); continue; }
        r -= 4 * I_KV;
        if (r < I_IN) { win_item(C, A.in[3], A.in[9], 0, r, scr); continue; }
        r -= I_IN;
        if (r < 1024) { rms_row_to_bf16(A.in[1] + (size_t)r * D, A.in[14], (bf16*)(C.ws + WS_MEMN) + (size_t)r * D, C.lane); continue; }
        r -= 1024;
        rms_row_to_bf16(A.in[0] + (size_t)r * D, A.in[2], (bf16*)(C.ws + WS_HN) + (size_t)r * D, C.lane);
    }
}

namespace pg8 {
#define PG8_LAS __attribute__((address_space(3)))
typedef unsigned short bf16_t;
typedef short bf16x8 __attribute__((ext_vector_type(8)));
typedef float f32x4 __attribute__((ext_vector_type(4)));
typedef unsigned u32x4 __attribute__((ext_vector_type(4)));
constexpr int BM = 256, BK = 64, HALF = 128, HTB = HALF * BK * 2  , STAGE_BYTES = 8 * HTB, NXCD = 8, WGM = 8;

__host__ __device__ __forceinline__ int lds_byte(int r, int c) { const int st = (r >> 4) * 2 + (c >> 5), rr = r & 15, cc = c & 31, ob = rr * 64 + cc * 2; return st * 1024 + (ob ^ (((ob >> 9) & 1) << 5)); }
__host__ __device__ __forceinline__ void stage_rc(int b, int& R, int& C) { const int st = b / 1024, sb = b % 1024, swz = sb ^ (((sb >> 9) & 1) << 5); R = (st >> 1) * 16 + swz / 64; C = (st & 1) * 32 + (swz % 64) / 2; }
__host__ __device__ __forceinline__ int perm32(int rho) { const int n = rho >> 4, i = rho & 15; return 8 * (i >> 2) + 4 * n + (i & 3); }

struct Unit { int pm, pn; };
struct Gemm { const bf16_t* A; const bf16_t* Bt; int M, N, K; };

struct StaticOrder {
    int nM, nN, nwg, G, c;
    __host__ __device__ void init(int M, int N, int G_, int c_) { nM = M / BM; nN = N / BM; nwg = nM * nN; G = G_; c = c_; }
    __host__ __device__ bool next(int i, Unit& u) const {
        const long L = (long)i * G + c; if (L >= nwg) return false;
        int wgid = (int)L; { const int q = nwg / NXCD, r = nwg % NXCD, xcd = wgid % NXCD, off = wgid / NXCD; wgid = (xcd < r ? xcd * (q + 1) : r * (q + 1) + (xcd - r) * q) + off; }
        const int nig = WGM * nN, gid = wgid / nig, fm = gid * WGM, gsz = (nM - fm) < WGM ? (nM - fm) : WGM;
        u.pm = fm + ((wgid % nig) % gsz); u.pn = (wgid % nig) / gsz; return true;
    }
    __device__ __forceinline__ void a_ready(const Unit&) const {}
    __device__ __forceinline__ void done(const Unit&) const {}
};

__device__ __forceinline__ unsigned cvt_pk_bf16(float lo, float hi) { unsigned r; asm volatile("v_cvt_pk_bf16_f32 %0, %1, %2" : "=v"(r) : "v"(lo), "v"(hi)); return r; }

template <class Epi, class Sched, bool ALIGN_EPI = false, bool SP2 = false>
__device__ __forceinline__ void gemm_phase(PG8_LAS unsigned char* lds, const Gemm g, const Sched& S, const Epi& E) {
    int tid = threadIdx.x; asm volatile("" : "+v"(tid));
    const int wid = __builtin_amdgcn_readfirstlane(tid >> 6), lane = tid & 63, wr = wid >> 2, wc = wid & 3, fr = lane & 15, fq = lane >> 4;
    const int K = g.K, nt = K / BK;
    unsigned voffA[2], voffB[2];
#pragma unroll
    for (int i = 0; i < 2; ++i) { int R, C; stage_rc(tid * 16 + i * 8192, R, C); const int Rb = Epi::PERM ? ((R & ~31) + perm32(R & 31)) : R;
        voffA[i] = (unsigned)(R * K + C) * 2u; voffB[i] = (unsigned)(Rb * K + C) * 2u; }
    const size_t kstep = (size_t)(BK * 2);
    const size_t hstep = (size_t)HALF * K * 2;
    const size_t tstep = 2 * hstep;
    const unsigned ldsw = (unsigned)wid * 1024u;
    const int aoff = lds_byte(wr * 64 + fr, fq * 8), boff = lds_byte(wc * 32 + fr, fq * 8);
#define PG8_SA(b, h) (((b) * 2 + (h)) * HTB)
#define PG8_SB(b, h) ((4 + (b) * 2 + (h)) * HTB)
#define PG8_STAGE(bufoff, gbase, voff) do { _Pragma("unroll") for (int _i = 0; _i < 2; ++_i) \
        __builtin_amdgcn_global_load_lds((const unsigned*)((const char*)(gbase) + (voff)[_i]), (PG8_LAS unsigned*)(lds + (bufoff) + ldsw + _i * 8192), 16, 0, 0); } while (0)
#define PG8_LDA(dst, b, h) do { _Pragma("unroll") for (int m = 0; m < 4; ++m) _Pragma("unroll") for (int k = 0; k < 2; ++k) dst[m][k] = *(const PG8_LAS bf16x8*)(lds + PG8_SA(b, h) + aoff + m * 2048 + k * 1024); } while (0)
#define PG8_LDB(dst, b, h) do { _Pragma("unroll") for (int n = 0; n < 2; ++n) _Pragma("unroll") for (int k = 0; k < 2; ++k) dst[n][k] = *(const PG8_LAS bf16x8*)(lds + PG8_SB(b, h) + boff + n * 2048 + k * 1024); } while (0)
#define PG8_MMA(ai, bj, At, Bt) do { __builtin_amdgcn_s_setprio(1); _Pragma("unroll") for (int m = 0; m < 4; ++m) _Pragma("unroll") for (int n = 0; n < 2; ++n) _Pragma("unroll") for (int k = 0; k < 2; ++k) \
        acc[ai][bj][m][n] = __builtin_amdgcn_mfma_f32_16x16x32_bf16(Bt[n][k], At[m][k], acc[ai][bj][m][n], 0, 0, 0); __builtin_amdgcn_s_setprio(0); } while (0)
#define PG8_WAIT_V(n) asm volatile("s_waitcnt vmcnt(" #n ")" ::: "memory")
#define PG8_WAIT_L(n) asm volatile("s_waitcnt lgkmcnt(" #n ")" ::: "memory")
#define PG8_BAR __builtin_amdgcn_s_barrier()
#define PG8_SCHED __builtin_amdgcn_sched_barrier(0)
    Unit cur, nxt; int ui = 0;
    if (!S.next(0, cur)) return;
    f32x4 acc[2][2][4][2];
#pragma unroll
    for (int a = 0; a < 2; ++a)
#pragma unroll
        for (int b = 0; b < 2; ++b)
#pragma unroll
            for (int m = 0; m < 4; ++m)
#pragma unroll
                for (int n = 0; n < 2; ++n) acc[a][b][m][n] = (f32x4){0.f, 0.f, 0.f, 0.f};
    bf16x8 At[4][2], B0[2][2], B1[2][2];
    const char* cA = (const char*)g.A + (size_t)cur.pm * tstep; const char* cB = (const char*)g.Bt + (size_t)cur.pn * tstep;
    S.a_ready(cur);
    if constexpr (SP2) {
        PG8_STAGE(PG8_SB(0, 0), cB, voffB); PG8_STAGE(PG8_SB(0, 1), cB + hstep, voffB); PG8_STAGE(PG8_SA(0, 0), cA, voffA); PG8_STAGE(PG8_SA(0, 1), cA + hstep, voffA);
        if (wr == 1) PG8_BAR;
        PG8_WAIT_V(2); PG8_BAR;
        PG8_STAGE(PG8_SB(1, 0), cB + kstep, voffB); PG8_STAGE(PG8_SA(1, 0), cA + kstep, voffA); PG8_STAGE(PG8_SB(1, 1), cB + hstep + kstep, voffB);
        PG8_WAIT_V(6); PG8_BAR;
    } else {
        PG8_STAGE(PG8_SB(0, 0), cB, voffB); PG8_STAGE(PG8_SA(0, 0), cA, voffA); PG8_STAGE(PG8_SB(0, 1), cB + hstep, voffB); PG8_STAGE(PG8_SA(0, 1), cA + hstep, voffA);
        if (wr == 1) PG8_BAR;
        PG8_WAIT_V(4); PG8_BAR;
        PG8_STAGE(PG8_SB(1, 0), cB + kstep, voffB); PG8_STAGE(PG8_SA(1, 0), cA + kstep, voffA); PG8_STAGE(PG8_SB(1, 1), cB + hstep + kstep, voffB);
        PG8_WAIT_V(6); PG8_BAR;
    }
    for (;;) {
        const bool has_next = S.next(ui + 1, nxt);
        const char* nA = has_next ? (const char*)g.A + (size_t)nxt.pm * tstep : cA; const char* nB = has_next ? (const char*)g.Bt + (size_t)nxt.pn * tstep : cB;
        for (int t = 0; t < nt; t += 2) {
            const bool last = (t == nt - 2);
            const char* a1 = cA + (size_t)(t + 1) * kstep;
            const char* a2 = last ? nA : cA + (size_t)(t + 2) * kstep; const char* b2 = last ? nB : cB + (size_t)(t + 2) * kstep;
            const char* a3 = a2 + kstep; const char* b3 = b2 + kstep;
            if (last && has_next) S.a_ready(nxt);
            if constexpr (SP2) {
            PG8_LDB(B0, 0, 0); PG8_LDB(B1, 0, 1); PG8_SCHED; PG8_LDA(At, 0, 0); PG8_STAGE(PG8_SA(1, 1), a1 + hstep, voffA);
            PG8_WAIT_V(8); PG8_WAIT_L(0); PG8_BAR; PG8_MMA(0, 0, At, B0); PG8_MMA(0, 1, At, B1); PG8_BAR; PG8_SCHED;
            PG8_LDA(At, 0, 1); PG8_STAGE(PG8_SB(0, 0), b2, voffB); PG8_STAGE(PG8_SB(0, 1), b2 + hstep, voffB); PG8_STAGE(PG8_SA(0, 0), a2, voffA);
            PG8_WAIT_V(8); PG8_WAIT_L(0); PG8_BAR; PG8_MMA(1, 0, At, B0); PG8_MMA(1, 1, At, B1); PG8_BAR; PG8_SCHED;
            PG8_LDB(B0, 1, 0); PG8_LDB(B1, 1, 1); PG8_SCHED; PG8_LDA(At, 1, 0); PG8_STAGE(PG8_SA(0, 1), a2 + hstep, voffA);
            PG8_WAIT_V(8); PG8_WAIT_L(0); PG8_BAR; PG8_MMA(0, 0, At, B0); PG8_MMA(0, 1, At, B1); PG8_BAR; PG8_SCHED;
            PG8_LDA(At, 1, 1); PG8_STAGE(PG8_SB(1, 0), b3, voffB); PG8_STAGE(PG8_SB(1, 1), b3 + hstep, voffB); PG8_STAGE(PG8_SA(1, 0), a3, voffA);
            PG8_WAIT_V(8); PG8_WAIT_L(0); PG8_BAR; PG8_MMA(1, 0, At, B0); PG8_MMA(1, 1, At, B1); PG8_BAR; PG8_SCHED;
            } else {
            PG8_LDB(B0, 0, 0); PG8_SCHED; PG8_LDA(At, 0, 0); PG8_STAGE(PG8_SA(1, 1), a1 + hstep, voffA);
            PG8_WAIT_L(8); PG8_BAR; PG8_WAIT_L(0); PG8_MMA(0, 0, At, B0); PG8_BAR; PG8_SCHED;
            PG8_LDB(B1, 0, 1); PG8_STAGE(PG8_SB(0, 0), b2, voffB);
            PG8_BAR; PG8_WAIT_L(0); PG8_MMA(0, 1, At, B1); PG8_BAR;
            PG8_LDA(At, 0, 1); PG8_STAGE(PG8_SA(0, 0), a2, voffA);
            PG8_BAR; PG8_WAIT_L(0); PG8_MMA(1, 0, At, B0); PG8_BAR; PG8_SCHED;
            PG8_STAGE(PG8_SB(0, 1), b2 + hstep, voffB);
            PG8_WAIT_V(6); PG8_BAR; PG8_MMA(1, 1, At, B1); PG8_BAR;
            PG8_LDB(B0, 1, 0); PG8_SCHED; PG8_LDA(At, 1, 0); PG8_STAGE(PG8_SA(0, 1), a2 + hstep, voffA);
            PG8_WAIT_L(8); PG8_BAR; PG8_WAIT_L(0); PG8_MMA(0, 0, At, B0); PG8_BAR; PG8_SCHED;
            PG8_LDB(B1, 1, 1); PG8_STAGE(PG8_SB(1, 0), b3, voffB);
            PG8_BAR; PG8_WAIT_L(0); PG8_MMA(0, 1, At, B1); PG8_BAR;
            PG8_LDA(At, 1, 1); PG8_STAGE(PG8_SA(1, 0), a3, voffA);
            PG8_BAR; PG8_WAIT_L(0); PG8_MMA(1, 0, At, B0); PG8_BAR; PG8_SCHED;
            PG8_STAGE(PG8_SB(1, 1), b3 + hstep, voffB);
            PG8_WAIT_V(6); PG8_BAR; PG8_MMA(1, 1, At, B1); PG8_BAR;
            }
        }
        if constexpr (ALIGN_EPI) { if (wr == 0) PG8_BAR; }
        if constexpr (!Epi::AFTER_DRAIN) { E(acc, cur, wr, wc, fr, fq); S.done(cur); }
        if (!has_next) break;
#pragma unroll
        for (int a = 0; a < 2; ++a)
#pragma unroll
            for (int b = 0; b < 2; ++b)
#pragma unroll
                for (int m = 0; m < 4; ++m)
#pragma unroll
                    for (int n = 0; n < 2; ++n) acc[a][b][m][n] = (f32x4){0.f, 0.f, 0.f, 0.f};
        cur = nxt; cA = nA; cB = nB; ++ui;
        if constexpr (ALIGN_EPI) { if (wr == 1) PG8_BAR; }
    }
    PG8_WAIT_V(0);
    if constexpr (!ALIGN_EPI) { if (wr == 0) PG8_BAR; }
    PG8_BAR;
    if constexpr (Epi::AFTER_DRAIN) { E.fused(acc, cur, wr, wc, fr, fq, lds, wid, lane); S.done(cur); }
#undef PG8_SA
#undef PG8_SB
#undef PG8_STAGE
#undef PG8_LDA
#undef PG8_LDB
#undef PG8_MMA
#undef PG8_WAIT_V
#undef PG8_WAIT_L
#undef PG8_BAR
#undef PG8_SCHED
}

struct EpiProj {
    static constexpr bool PERM = true, AFTER_DRAIN = false;
    bf16_t* P; bf16_t* MIXp; int np_cols; int npt;
    __device__ __forceinline__ void operator()(const f32x4 (&acc)[2][2][4][2], const Unit& u, int wr, int wc, int fr, int fq) const {
        const int row0 = u.pm * BM + wr * 64 + fr;
        bf16_t* base; int ldc, colt;
        if (u.pn < npt) { base = P; ldc = np_cols; colt = u.pn * BM; } else { base = MIXp; ldc = 1536; colt = (u.pn - npt) * BM; }
        const int col0 = colt + wc * 32 + 8 * fq;
#pragma unroll
        for (int ai = 0; ai < 2; ++ai)
#pragma unroll
            for (int m = 0; m < 4; ++m) { bf16_t* rowp = base + (size_t)(row0 + ai * HALF + m * 16) * ldc + col0;
#pragma unroll
                for (int bj = 0; bj < 2; ++bj) { const f32x4 v0 = acc[ai][bj][m][0], v1 = acc[ai][bj][m][1];
                    u32x4 w; w.x = cvt_pk_bf16(v0[0], v0[1]); w.y = cvt_pk_bf16(v0[2], v0[3]); w.z = cvt_pk_bf16(v1[0], v1[1]); w.w = cvt_pk_bf16(v1[2], v1[3]);
                    *(u32x4*)(rowp + bj * HALF) = w; } }
    }
};
struct EpiResidF32 {
    static constexpr bool PERM = false, AFTER_DRAIN = false;
    const float* xi; float* xo;
    __device__ __forceinline__ void operator()(const f32x4 (&acc)[2][2][4][2], const Unit& u, int wr, int wc, int fr, int fq) const {
        const int col0 = u.pn * BM + wc * 32 + 4 * fq;
#pragma unroll
        for (int ai = 0; ai < 2; ++ai)
#pragma unroll
            for (int m = 0; m < 4; ++m) { const size_t off = (size_t)(u.pm * BM + ai * HALF + wr * 64 + m * 16 + fr) * 1024 + col0;
#pragma unroll
                for (int bj = 0; bj < 2; ++bj)
#pragma unroll
                    for (int n = 0; n < 2; ++n) { const f32x4 b = *(const f32x4*)(xi + off + bj * HALF + n * 16); *(f32x4*)(xo + off + bj * HALF + n * 16) = b + acc[ai][bj][m][n]; } }
    }
};
}

template <class Epi>
__device__ __forceinline__ void gemm_naive(const Ctx& C, const bf16* A, int lda, const bf16* Bt, int ldb, int Mr, int Nr, int K, int tile0, int tstride, const Epi& E) {
    LAS float* As = (LAS float*)C.lds;
    LAS float* Bs = As + 32 * 132;
    const int tid = C.tid, ty = tid >> 4, tx = tid & 15;
    const int nMt = Mr / 128, nNt = Nr / 128, ntiles = nMt * nNt;
    for (int tile = tile0; tile < ntiles; tile += tstride) {
        const int tm = tile % nMt, tn = tile / nMt;
        float acc[4][8];
#pragma unroll
        for (int i = 0; i < 4; ++i)
#pragma unroll
            for (int j = 0; j < 8; ++j) acc[i][j] = 0.f;
        const int lr = tid >> 2, lk = (tid & 3) * 8;
        for (int k0 = 0; k0 < K; k0 += 32) {
            const v4u av = *(const GAS v4u*)(A + (size_t)(tm * 128 + lr) * lda + k0 + lk);
            const v4u bv = *(const GAS v4u*)(Bt + (size_t)(tn * 128 + lr) * ldb + k0 + lk);
            __syncthreads();
#pragma unroll
            for (int j = 0; j < 4; ++j) {
                As[(lk + 2 * j) * 132 + lr] = __uint_as_float(av[j] << 16); As[(lk + 2 * j + 1) * 132 + lr] = __uint_as_float(av[j] & 0xffff0000u);
                Bs[(lk + 2 * j) * 132 + lr] = __uint_as_float(bv[j] << 16); Bs[(lk + 2 * j + 1) * 132 + lr] = __uint_as_float(bv[j] & 0xffff0000u);
            }
            __syncthreads();
#pragma unroll 2
            for (int k = 0; k < 32; ++k) {
                const f32x4 a = *(const LAS f32x4*)(As + k * 132 + ty * 4);
                const f32x4 b0 = *(const LAS f32x4*)(Bs + k * 132 + tx * 8), b1 = *(const LAS f32x4*)(Bs + k * 132 + tx * 8 + 4);
#pragma unroll
                for (int i = 0; i < 4; ++i) {
                    acc[i][0] += a[i] * b0[0]; acc[i][1] += a[i] * b0[1]; acc[i][2] += a[i] * b0[2]; acc[i][3] += a[i] * b0[3];
                    acc[i][4] += a[i] * b1[0]; acc[i][5] += a[i] * b1[1]; acc[i][6] += a[i] * b1[2]; acc[i][7] += a[i] * b1[3];
                }
            }
        }
#pragma unroll
        for (int i = 0; i < 4; ++i) E(tm * 128 + ty * 4 + i, tn * 128 + tx * 8, acc[i]);
    }
    __syncthreads();
}
struct EpiStoreBf16 {
    bf16* O; int ldc;
    __device__ __forceinline__ void operator()(int m, int n0, const float (&v)[8]) const {
        v4u w; w.x = pk2(v[0], v[1]); w.y = pk2(v[2], v[3]); w.z = pk2(v[4], v[5]); w.w = pk2(v[6], v[7]);
        *(GAS v4u*)(O + (size_t)m * ldc + n0) = w; }
};
struct EpiInProj {
    bf16* P; bf16* MIX; int NP;
    __device__ __forceinline__ void operator()(int m, int n0, const float (&v)[8]) const {
        v4u w; w.x = pk2(v[0], v[1]); w.y = pk2(v[2], v[3]); w.z = pk2(v[4], v[5]); w.w = pk2(v[6], v[7]);
        if (n0 < NP) *(GAS v4u*)(P + (size_t)m * NP + n0) = w; else *(GAS v4u*)(MIX + (size_t)m * NMIX + (n0 - NP)) = w; }
};
struct EpiResid {
    const float* xi; float* xo;
    __device__ __forceinline__ void operator()(int m, int n0, const float (&v)[8]) const {
        const f32x4 a = *(const GAS f32x4*)(xi + (size_t)m * D + n0), b = *(const GAS f32x4*)(xi + (size_t)m * D + n0 + 4);
        f32x4 o0 = {a[0] + v[0], a[1] + v[1], a[2] + v[2], a[3] + v[3]}, o1 = {b[0] + v[4], b[1] + v[5], b[2] + v[6], b[3] + v[7]};
        *(GAS f32x4*)(xo + (size_t)m * D + n0) = o0; *(GAS f32x4*)(xo + (size_t)m * D + n0 + 4) = o1; }
};

__device__ __forceinline__ float dot8(const v4u w, const LAS float* q) {
    const f32x4 q0 = *(const LAS f32x4*)q, q1 = *(const LAS f32x4*)(q + 4);
    return (__uint_as_float(w[0] << 16) * q0[0] + __uint_as_float(w[0] & 0xffff0000u) * q0[1]) + (__uint_as_float(w[1] << 16) * q0[2] + __uint_as_float(w[1] & 0xffff0000u) * q0[3])
         + (__uint_as_float(w[2] << 16) * q1[0] + __uint_as_float(w[2] & 0xffff0000u) * q1[1]) + (__uint_as_float(w[3] << 16) * q1[2] + __uint_as_float(w[3] & 0xffff0000u) * q1[3]);
}
__device__ __forceinline__ void naive_winattn_item(const Ctx& C, const float* sink, int item, LAS float* pw) {
    const bf16* P = (const bf16*)(C.ws + WS_P); bf16* MIX = (bf16*)(C.ws + WS_MIX);
    int lane = C.lane; asm volatile("" : "+v"(lane));
    const int hq = item & 7, m = item >> 3, t = m & (T - 1), b = m >> 12, n = hq >> 2;
    const float slope = exp2f(-(float)(hq + 1)), sk = sink[hq];
    LAS float* qs = pw + 320;
    qs[lane] = bf2f(P[(size_t)m * NP_E + E_QA + hq * 64 + lane]);
    LDS_WAIT(); asm volatile("" ::: "memory");
    float mx = -3e38f;
#pragma unroll 1
    for (int i = 0; i < 5; ++i) {
        const int j = lane + 64 * i, s = t - 128 + j; const bool valid = (j <= 256) && (s >= 0) && (s < T);
        float acc = -3e38f;
        if (valid) { const GAS v4u* kp = (const GAS v4u*)(P + (size_t)(b * T + s) * NP_E + E_KA + n * 64); acc = 0.f;
#pragma unroll
            for (int jj = 0; jj < 8; ++jj) acc += dot8(kp[jj], qs + 8 * jj);
            acc = acc * 0.125f - slope * fabsf((float)(t - s)); mx = fmaxf(mx, acc); }
        if (j <= 256) pw[j] = acc;
    }
    mx = fmaxf(wave_max(mx), sk);
    LDS_WAIT(); asm volatile("" ::: "memory");
    float sum = 0.f;
#pragma unroll 1
    for (int i = 0; i < 5; ++i) { const int j = lane + 64 * i; if (j <= 256) { const float sc = pw[j]; const float p = (sc > -1e38f) ? __expf(sc - mx) : 0.f; sum += p; pw[j] = p; } }
    sum = wave_sum(sum) + __expf(sk - mx);
    LDS_WAIT(); asm volatile("" ::: "memory");
    float o = 0.f;
    for (int j = 0; j <= 256; ++j) { const int s = t - 128 + j; if (s < 0 || s >= T) continue;
        o += pw[j] * bf2f(P[(size_t)(b * T + s) * NP_E + E_VA + n * 64 + lane]); }
    o /= sum;
    bf16* gp = MIX + (size_t)m * NMIX + X_GA + hq * 64 + lane;
    *gp = (bf16)f2bf(o * siluf_(bf2f(*gp)));
    LDS_WAIT(); asm volatile("" ::: "memory");
}
__device__ __forceinline__ void naive_memattn_item(const Ctx& C, int l, int item, LAS float* pw) {
    const int NP = (l & 1) ? NP_O : NP_E, QOFF = (l & 1) ? O_QM : E_QM;
    const bf16* P = (const bf16*)(C.ws + WS_P); bf16* MIX = (bf16*)(C.ws + WS_MIX);
    const bf16* MK = (const bf16*)(C.ws + WS_MEMK) + (size_t)l * 1024 * 512; const bf16* MVT = (const bf16*)(C.ws + WS_MEMVT) + (size_t)l * 512 * 1024;
    int lane = C.lane; asm volatile("" : "+v"(lane));
    const int h = item & 3, m = item >> 2, b = m >> 12;
    LAS float* qs = pw + 320;
    qs[lane] = bf2f(P[(size_t)m * NP + QOFF + h * 128 + lane]); qs[lane + 64] = bf2f(P[(size_t)m * NP + QOFF + h * 128 + lane + 64]);
    LDS_WAIT(); asm volatile("" ::: "memory");
    float mx = -3e38f;
#pragma unroll 1
    for (int i = 0; i < 4; ++i) { const int s = lane + 64 * i;
        const GAS v4u* kp = (const GAS v4u*)(MK + (size_t)(b * NMEM + s) * 512 + h * 128); float acc = 0.f;
#pragma unroll
        for (int jj = 0; jj < 16; ++jj) acc += dot8(kp[jj], qs + 8 * jj);
        acc *= 0.08838834764831845f; mx = fmaxf(mx, acc); pw[s] = acc; }
    mx = wave_max(mx);
    LDS_WAIT(); asm volatile("" ::: "memory");
    float sum = 0.f;
#pragma unroll 1
    for (int i = 0; i < 4; ++i) { const int s = lane + 64 * i; const float p = __expf(pw[s] - mx); sum += p; pw[s] = p; }
    sum = wave_sum(sum);
    LDS_WAIT(); asm volatile("" ::: "memory");
#pragma unroll 1
    for (int dd = 0; dd < 2; ++dd) { const int d = lane + 64 * dd; const bf16* vp = MVT + (size_t)(h * 128 + d) * 1024 + b * NMEM; float o = 0.f;
#pragma unroll 4
        for (int s = 0; s < NMEM; s += 8) o += dot8(*(const GAS v4u*)(vp + s), pw + s);
        o /= sum;
        bf16* gp = MIX + (size_t)m * NMIX + X_GM + h * 128 + d;
        *gp = (bf16)f2bf(o * siluf_(bf2f(*gp))); }
    LDS_WAIT(); asm volatile("" ::: "memory");
}
template <int ODD>
__device__ __forceinline__ void naive_scan_item(const Ctx& C, const float* lbp, const float* wgu, const float* bgp, int l, int item, LAS float* scr) {
    constexpr int DV = ODD ? 256 : 128, NCG = DV / 32, NP = ODD ? NP_O : NP_E, VOFF = ODD ? O_VC : E_IB, TS = 8;
    int lane = C.lane; asm volatile("" : "+v"(lane));
    const int li = l >> 1, kh = lane >> 5;
    const int cg = item % NCG, h = (item / NCG) & 3, b = item / (NCG * 4);
    const bf16* P = (const bf16*)(C.ws + WS_P);
    float* O = (float*)(C.ws + (ODD ? WS_OO : WS_OE));
    LAS float* fq = scr; LAS float* fk = scr + TS * 128; LAS float* ff = scr + 2 * TS * 128;
    const int col = h * DV + cg * 32 + (lane & 31);
    for (int dir = 0; dir < 2; ++dir) {
        float lbv[2] = {0.f, 0.f}, bg[2] = {0.f, 0.f};
#pragma unroll
        for (int c = 0; c < 2; ++c) { const int ch = h * 128 + lane + 64 * c;
            if (!ODD) { if (li == 1) { const float p0 = lbp[(0 * 2 + dir) * 512 + ch], p1 = lbp[(1 * 2 + dir) * 512 + ch]; lbv[c] = 1.f / (1.f + __expf(p0 - p1)); } }
            else bg[c] = bgp[(li * 2 + dir) * 512 + ch]; }
        const float* wup = wgu + (size_t)(li * 2 + dir) * 16 * 512 + h * 128 + lane;
        float S[64];
#pragma unroll
        for (int k = 0; k < 64; ++k) S[k] = 0.f;
        for (int tb = 0; tb < T; tb += TS) {
#pragma unroll 1
            for (int s = 0; s < TS; ++s) { const int t = dir ? (T - 1 - (tb + s)) : (tb + s); const size_t m = (size_t)b * T + t; const bf16* row = P + m * NP;
#pragma unroll
                for (int c = 0; c < 2; ++c) { const int k = lane + 64 * c, ch = h * 128 + k; float qv, kv, fv;
                    if (!ODD) { const float z = bf2f(row[(dir ? E_ZB : E_ZF) + ch]); const float sg = sigmoidf_(z);
                        fv = lbv[c] + (1.f - lbv[c]) * sg; kv = (1.f - lbv[c]) * (1.f - sg); qv = siluf_(bf2f(row[E_QB + ch])); }
                    else { float pre = bg[c];
#pragma unroll
                        for (int r = 0; r < 16; ++r) pre += bf2f(row[(dir ? O_RB : O_RF) + r]) * wup[r * 512 + 64 * c];
                        const float ls = fminf(pre, 0.f) - log1pf(__expf(-fabsf(pre)));
                        fv = __expf(ls * (1.f / 16.f)); kv = bf2f(row[O_KC + ch]); qv = bf2f(row[O_QC + ch]) * 0.08838834764831845f; }
                    fq[s * 128 + k] = qv; fk[s * 128 + k] = kv; ff[s * 128 + k] = fv; } }
            LDS_WAIT(); asm volatile("" ::: "memory");
#pragma unroll 1
            for (int s = 0; s < TS; ++s) { const int t = dir ? (T - 1 - (tb + s)) : (tb + s); const size_t m = (size_t)b * T + t;
                const float v = bf2f(P[m * NP + VOFF + col]); float o = 0.f;
                const LAS float* pf = ff + s * 128 + kh * 64; const LAS float* pk = fk + s * 128 + kh * 64; const LAS float* pq = fq + s * 128 + kh * 64;
#pragma unroll
                for (int k4 = 0; k4 < 16; ++k4) { const f32x4 f4 = *(const LAS f32x4*)(pf + 4 * k4), k4v = *(const LAS f32x4*)(pk + 4 * k4), q4 = *(const LAS f32x4*)(pq + 4 * k4);
#pragma unroll
                    for (int e = 0; e < 4; ++e) { S[4 * k4 + e] = f4[e] * S[4 * k4 + e] + k4v[e] * v; o += q4[e] * S[4 * k4 + e]; }
                    if ((k4 & 3) == 3) asm volatile("" ::: "memory"); }
                o += __shfl_xor(o, 32);
                float* op = O + m * (4 * DV) + col;
                if (kh == 0) { if (dir) *op += o; else *op = o; } }
            LDS_WAIT(); asm volatile("" ::: "memory");
        }
    }
}
template <int ODD>
__device__ __forceinline__ void naive_gnorm_item(const Ctx& C, const float* gw_, int l, int item) {
    constexpr int DV = ODD ? 256 : 128, NC = DV / 64, GOFF = ODD ? X_GC : X_GB;
    int lane = C.lane; asm volatile("" : "+v"(lane));
    const int li = l >> 1, h = item & 3, m = item >> 2;
    const float* O = (const float*)(C.ws + (ODD ? WS_OO : WS_OE)) + (size_t)m * (4 * DV) + h * DV;
    const float* g = gw_ + li * (4 * DV) + h * DV;
    bf16* MIX = (bf16*)(C.ws + WS_MIX) + (size_t)m * NMIX + GOFF + h * DV;
    float v[NC]; float s = 0.f;
#pragma unroll
    for (int c = 0; c < NC; ++c) { v[c] = O[lane + 64 * c]; s += v[c] * v[c]; }
    const float rstd = 1.f / sqrtf(wave_sum(s) * (1.f / DV) + EPS);
#pragma unroll
    for (int c = 0; c < NC; ++c) { bf16* gp = MIX + lane + 64 * c; *gp = (bf16)f2bf(v[c] * rstd * g[lane + 64 * c] * siluf_(bf2f(*gp))); }
}

namespace scan {
typedef short bf16x8 __attribute__((ext_vector_type(8)));
typedef short s16x4 __attribute__((ext_vector_type(4)));
typedef float f32x16 __attribute__((ext_vector_type(16)));
typedef float f32x2_t __attribute__((ext_vector_type(2)));
typedef __bf16 bf16x2_t __attribute__((ext_vector_type(2)));
typedef short v4i16_t __attribute__((ext_vector_type(4)));
__device__ __forceinline__ unsigned cvtpk(float lo, float hi) { f32x2_t v = {lo, hi}; bf16x2_t b = __builtin_convertvector(v, bf16x2_t); return __builtin_bit_cast(unsigned, b); }
__device__ __forceinline__ s16x4 trd(const LAS unsigned char* p) { return __builtin_bit_cast(s16x4, __builtin_amdgcn_ds_read_tr16_b64_v4i16((LAS v4i16_t*)p)); }
#define SC_MFMA(a, b, c) __builtin_amdgcn_mfma_f32_32x32x16_bf16((a), (b), (c), 0, 0, 0)
__device__ __forceinline__ bf16x8 pack8(const f32x16& x, int s) {
    v4u p; p.x = cvtpk(x[8 * s + 0], x[8 * s + 1]); p.y = cvtpk(x[8 * s + 2], x[8 * s + 3]); p.z = cvtpk(x[8 * s + 4], x[8 * s + 5]); p.w = cvtpk(x[8 * s + 6], x[8 * s + 7]);
    return __builtin_bit_cast(bf16x8, p);
}
__device__ __forceinline__ float expc(float x) { return __expf(fminf(x, 80.f)); }

template <int ODD> struct Geo {
    static constexpr int NH = ODD ? 1 : 2, DVH = ODD ? 256 : 128, KH = 128 * NH, NHG = 4 / NH, SCLEN = ODD ? 256 : 128, NSC = T / SCLEN, NCH = SCLEN / 32;
    static constexpr int NP = ODD ? NP_O : NP_E, QOFF = ODD ? O_QC : E_QB, VOFF = ODD ? O_VC : E_IB, GOFF = ODD ? X_GC : X_GB;
    static constexpr int RSB = KH * 4;
    static constexpr int RSK = KH * 2 + 16;
    static constexpr int RST = KH * 2 + 64;
    static constexpr int RSV = 512 + 64;
    static constexpr int RSO = 260 * 4;
    static constexpr int OFF_B = 0, OFF_Q1 = 34816, OFF_Q2 = OFF_Q1 + 32 * RSK, OFF_K2 = OFF_Q2 + 32 * RSK, OFF_W = OFF_K2 + 32 * RSK, OFF_V = OFF_W + 32 * RST, OFF_D = OFF_V + 32 * RSV, OFF_END = OFF_D + 1024;
    static_assert(OFF_END <= RING_BYTES, "scan LDS map");
    static constexpr size_t L_ITEM = (size_t)DVH * 128;
};
struct ScanPtrs { const bf16* P; bf16* MIX; bf16* L; float* LOGD; bf16* OG; const float* lbp; const float* wgu; const float* bgp; const float* gnw; };

template <int ODD, int MODE>
__device__ __forceinline__ void scan_item(const Ctx& C, const ScanPtrs& sp, int li, int b, int hg, int sc, int dir0) {
    typedef Geo<ODD> G;
    const int tid = C.tid, wave = C.wave; int lane = C.lane; asm volatile("" : "+v"(lane));
    const int r = lane & 31, h = lane >> 5, i16 = lane & 15, q4 = i16 >> 2, p4 = i16 & 3, g1 = (lane >> 4) & 1;
    const int hh = wave / (8 / G::NH), h0 = hg * G::NH;
    const int kc0 = hh * 128, vcol0 = wave * 32;
    LAS unsigned char* lds = C.lds;
    const int sc0 = sc * G::SCLEN;
    const bf16* Pb = sp.P + (size_t)b * T * G::NP;
    f32x16 S[4];
    for (int dd = 0; dd < (MODE ? 2 : 1); ++dd) {
        const int dir = MODE ? dd : dir0;
        float lbv = 0.f, bgv = 0.f, wupv[16]; float logd_acc = 0.f;
        if (tid < G::KH) {
            const int ch = h0 * 128 + tid;
            if (!ODD) { if (li == 1) { const float p0 = sp.lbp[(0 * 2 + dir) * 512 + ch], p1 = sp.lbp[(1 * 2 + dir) * 512 + ch]; lbv = 1.f / (1.f + __expf(p0 - p1)); } }
            else { bgv = sp.bgp[(li * 2 + dir) * 512 + ch];
#pragma unroll
                for (int rr = 0; rr < 16; ++rr) wupv[rr] = sp.wgu[((size_t)(li * 2 + dir) * 16 + rr) * 512 + ch]; }
        }
        if (MODE) { const bf16* Lp = sp.L + ((((size_t)(b * 4 + h0 + hh) * G::NSC + sc) * 2 + dir) * G::L_ITEM) + (size_t)((vcol0 - hh * G::DVH) + r) * 128;
#pragma unroll
            for (int kt = 0; kt < 4; ++kt)
#pragma unroll
                for (int g4 = 0; g4 < 4; ++g4) { const v2u w = *(const GAS v2u*)(Lp + 32 * kt + 8 * g4 + 4 * h);
                    S[kt][4 * g4 + 0] = __uint_as_float(w.x << 16); S[kt][4 * g4 + 1] = __uint_as_float(w.x & 0xffff0000u); S[kt][4 * g4 + 2] = __uint_as_float(w.y << 16); S[kt][4 * g4 + 3] = __uint_as_float(w.y & 0xffff0000u); } }
        else {
#pragma unroll
            for (int kt = 0; kt < 4; ++kt)
#pragma unroll
                for (int e = 0; e < 16; ++e) S[kt][e] = 0.f; }
#pragma unroll 1
        for (int ci = 0; ci < G::NCH; ++ci) {
            const int tbase = dir ? (sc0 + G::SCLEN - 1 - 32 * ci) : (sc0 + 32 * ci); const int tstep = dir ? -1 : 1;
            if (tid < G::KH) {
                float bacc = 0.f;
#pragma unroll 4
                for (int i = 0; i < 32; ++i) { const bf16* row = Pb + (size_t)(tbase + tstep * i) * G::NP; float gl;
                    if (!ODD) { const float z = bf2f(row[(dir ? E_ZB : E_ZF) + h0 * 128 + tid]); const float f = lbv + (1.f - lbv) * sigmoidf_(z); gl = __logf(fmaxf(f, 1e-30f)); }
                    else { const v4u r0 = *(const GAS v4u*)(row + (dir ? O_RB : O_RF)), r1 = *(const GAS v4u*)(row + (dir ? O_RB : O_RF) + 8); float pre = bgv;
#pragma unroll
                        for (int e = 0; e < 4; ++e) { pre += __uint_as_float(r0[e] << 16) * wupv[2 * e] + __uint_as_float(r0[e] & 0xffff0000u) * wupv[2 * e + 1];
                                                      pre += __uint_as_float(r1[e] << 16) * wupv[8 + 2 * e] + __uint_as_float(r1[e] & 0xffff0000u) * wupv[8 + 2 * e + 1]; }
                        gl = (fminf(pre, 0.f) - __logf(1.f + __expf(-fabsf(pre)))) * (1.f / 16.f); }
                    bacc += gl; *(LAS float*)(lds + G::OFF_B + i * G::RSB + tid * 4) = bacc; }
                *(LAS float*)(lds + G::OFF_D + tid * 4) = __expf(bacc); logd_acc += bacc;
            }
            __syncthreads();
            for (int u = tid; u < 32 * G::KH / 8; u += NTHR) {
                const int i = u / (G::KH / 8), c8 = (u % (G::KH / 8)) * 8; const bf16* row = Pb + (size_t)(tbase + tstep * i) * G::NP;
                const f32x4 b0 = *(const LAS f32x4*)(lds + G::OFF_B + i * G::RSB + c8 * 4), b1 = *(const LAS f32x4*)(lds + G::OFF_B + i * G::RSB + c8 * 4 + 16);
                const f32x4 r0 = *(const LAS f32x4*)(lds + G::OFF_B + 15 * G::RSB + c8 * 4), r1 = *(const LAS f32x4*)(lds + G::OFF_B + 15 * G::RSB + c8 * 4 + 16);
                const f32x4 e0 = *(const LAS f32x4*)(lds + G::OFF_B + 31 * G::RSB + c8 * 4), e1 = *(const LAS f32x4*)(lds + G::OFF_B + 31 * G::RSB + c8 * 4 + 16);
                float bb[8] = {b0[0], b0[1], b0[2], b0[3], b1[0], b1[1], b1[2], b1[3]}, rr[8] = {r0[0], r0[1], r0[2], r0[3], r1[0], r1[1], r1[2], r1[3]}, ee[8] = {e0[0], e0[1], e0[2], e0[3], e1[0], e1[1], e1[2], e1[3]};
                float kk[8], qq[8];
                if (!ODD) { const v4u zv = *(const GAS v4u*)(row + (dir ? E_ZB : E_ZF) + h0 * 128 + c8);
                    float lb8[8];
#pragma unroll
                    for (int e = 0; e < 8; ++e) { lb8[e] = 0.f; if (li == 1) { const int ch = h0 * 128 + c8 + e; lb8[e] = 1.f / (1.f + __expf(sp.lbp[(0 * 2 + dir) * 512 + ch] - sp.lbp[(1 * 2 + dir) * 512 + ch])); } }
#pragma unroll
                    for (int e = 0; e < 4; ++e) { kk[2 * e] = (1.f - lb8[2 * e]) * (1.f - sigmoidf_(__uint_as_float(zv[e] << 16))); kk[2 * e + 1] = (1.f - lb8[2 * e + 1]) * (1.f - sigmoidf_(__uint_as_float(zv[e] & 0xffff0000u))); }
                    if (MODE) { const v4u qv = *(const GAS v4u*)(row + E_QB + h0 * 128 + c8);
#pragma unroll
                        for (int e = 0; e < 4; ++e) { qq[2 * e] = siluf_(__uint_as_float(qv[e] << 16)); qq[2 * e + 1] = siluf_(__uint_as_float(qv[e] & 0xffff0000u)); } } }
                else { const v4u kv = *(const GAS v4u*)(row + O_KC + h0 * 128 + c8);
#pragma unroll
                    for (int e = 0; e < 4; ++e) { kk[2 * e] = __uint_as_float(kv[e] << 16); kk[2 * e + 1] = __uint_as_float(kv[e] & 0xffff0000u); }
                    if (MODE) { const v4u qv = *(const GAS v4u*)(row + O_QC + h0 * 128 + c8);
#pragma unroll
                        for (int e = 0; e < 4; ++e) { qq[2 * e] = __uint_as_float(qv[e] << 16) * 0.08838834764831845f; qq[2 * e + 1] = __uint_as_float(qv[e] & 0xffff0000u) * 0.08838834764831845f; } } }
                v4u w;
                w.x = cvtpk(kk[0] * __expf(ee[0] - bb[0]), kk[1] * __expf(ee[1] - bb[1])); w.y = cvtpk(kk[2] * __expf(ee[2] - bb[2]), kk[3] * __expf(ee[3] - bb[3]));
                w.z = cvtpk(kk[4] * __expf(ee[4] - bb[4]), kk[5] * __expf(ee[5] - bb[5])); w.w = cvtpk(kk[6] * __expf(ee[6] - bb[6]), kk[7] * __expf(ee[7] - bb[7]));
                *(LAS v4u*)(lds + G::OFF_W + i * G::RST + c8 * 2) = w;
                if (MODE) {
                    float dl[8];
#pragma unroll
                    for (int e = 0; e < 8; ++e) dl[e] = bb[e] - rr[e];
                    w.x = cvtpk(qq[0] * __expf(bb[0]), qq[1] * __expf(bb[1])); w.y = cvtpk(qq[2] * __expf(bb[2]), qq[3] * __expf(bb[3]));
                    w.z = cvtpk(qq[4] * __expf(bb[4]), qq[5] * __expf(bb[5])); w.w = cvtpk(qq[6] * __expf(bb[6]), qq[7] * __expf(bb[7]));
                    *(LAS v4u*)(lds + G::OFF_Q1 + i * G::RSK + c8 * 2) = w;
                    w.x = cvtpk(qq[0] * expc(dl[0]), qq[1] * expc(dl[1])); w.y = cvtpk(qq[2] * expc(dl[2]), qq[3] * expc(dl[3]));
                    w.z = cvtpk(qq[4] * expc(dl[4]), qq[5] * expc(dl[5])); w.w = cvtpk(qq[6] * expc(dl[6]), qq[7] * expc(dl[7]));
                    *(LAS v4u*)(lds + G::OFF_Q2 + i * G::RSK + c8 * 2) = w;
                    w.x = cvtpk(kk[0] * expc(-dl[0]), kk[1] * expc(-dl[1])); w.y = cvtpk(kk[2] * expc(-dl[2]), kk[3] * expc(-dl[3]));
                    w.z = cvtpk(kk[4] * expc(-dl[4]), kk[5] * expc(-dl[5])); w.w = cvtpk(kk[6] * expc(-dl[6]), kk[7] * expc(-dl[7]));
                    *(LAS v4u*)(lds + G::OFF_K2 + i * G::RSK + c8 * 2) = w;
                }
            }
            for (int u = tid; u < 32 * 32; u += NTHR) { const int i = u >> 5, c8 = (u & 31) * 8;
                *(LAS v4u*)(lds + G::OFF_V + i * G::RSV + c8 * 2) = *(const GAS v4u*)(Pb + (size_t)(tbase + tstep * i) * G::NP + G::VOFF + h0 * G::DVH + c8); }
            __syncthreads();
            f32x16 o;
            if (MODE) {
#pragma unroll
                for (int e = 0; e < 16; ++e) o[e] = 0.f;
#pragma unroll
                for (int kt = 0; kt < 4; ++kt)
#pragma unroll
                    for (int st = 0; st < 2; ++st) { const LAS unsigned char* qp = lds + G::OFF_Q1 + r * G::RSK + (kc0 + 32 * kt + 16 * st + 4 * h) * 2;
                        const s16x4 lo = *(const LAS s16x4*)qp, hi = *(const LAS s16x4*)(qp + 16);
                        const bf16x8 a = __builtin_shufflevector(lo, hi, 0, 1, 2, 3, 4, 5, 6, 7);
                        o = SC_MFMA(a, pack8(S[kt], st), o); }
                f32x16 at;
#pragma unroll
                for (int e = 0; e < 16; ++e) at[e] = 0.f;
#pragma unroll
                for (int ks = 0; ks < 8; ++ks) { const bf16x8 a = *(const LAS bf16x8*)(lds + G::OFF_K2 + r * G::RSK + (kc0 + 16 * ks + 8 * h) * 2), bq = *(const LAS bf16x8*)(lds + G::OFF_Q2 + r * G::RSK + (kc0 + 16 * ks + 8 * h) * 2);
                    at = SC_MFMA(a, bq, at); }
#pragma unroll
                for (int e = 0; e < 16; ++e) { const int srow = (e & 3) + 8 * (e >> 2) + 4 * h; at[e] = (srow <= r) ? at[e] : 0.f; }
#pragma unroll
                for (int st = 0; st < 2; ++st) { const LAS unsigned char* vp = lds + G::OFF_V + (16 * st + 4 * h + q4) * G::RSV + (vcol0 + 16 * g1 + 4 * p4) * 2;
                    const s16x4 lo = trd(vp), hi = trd(vp + 8 * G::RSV);
                    const bf16x8 bv = __builtin_shufflevector(lo, hi, 0, 1, 2, 3, 4, 5, 6, 7);
                    o = SC_MFMA(pack8(at, st), bv, o); }
            }
#pragma unroll
            for (int kt = 0; kt < 4; ++kt)
#pragma unroll
                for (int g4 = 0; g4 < 4; ++g4) { const f32x4 dv = *(const LAS f32x4*)(lds + G::OFF_D + (kc0 + 32 * kt + 8 * g4 + 4 * h) * 4);
#pragma unroll
                    for (int e = 0; e < 4; ++e) S[kt][4 * g4 + e] *= dv[e]; }
#pragma unroll
            for (int st = 0; st < 2; ++st) { const LAS unsigned char* vp = lds + G::OFF_V + (16 * st + 8 * h + q4) * G::RSV + (vcol0 + 16 * g1 + 4 * p4) * 2;
                const s16x4 vlo = trd(vp), vhi = trd(vp + 4 * G::RSV);
                const bf16x8 bv = __builtin_shufflevector(vlo, vhi, 0, 1, 2, 3, 4, 5, 6, 7);
#pragma unroll
                for (int kt = 0; kt < 4; ++kt) { const LAS unsigned char* wp = lds + G::OFF_W + (16 * st + 8 * h + q4) * G::RST + (kc0 + 32 * kt + 16 * g1 + 4 * p4) * 2;
                    const s16x4 wlo = trd(wp), whi = trd(wp + 4 * G::RST);
                    const bf16x8 aw = __builtin_shufflevector(wlo, whi, 0, 1, 2, 3, 4, 5, 6, 7);
                    S[kt] = SC_MFMA(aw, bv, S[kt]); } }
            if (MODE) {
#pragma unroll
                for (int e = 0; e < 16; ++e) *(LAS float*)(lds + G::OFF_B + ((e & 3) + 8 * (e >> 2) + 4 * h) * G::RSO + (vcol0 + r) * 4) = o[e];
                __syncthreads();
                { const int i = tid >> 4, seg = tid & 15, vc = seg * 16; const size_t m = (size_t)b * T + (tbase + tstep * i);
                  float v[16];
#pragma unroll
                  for (int e4 = 0; e4 < 4; ++e4) { const f32x4 x = *(const LAS f32x4*)(lds + G::OFF_B + i * G::RSO + (vc + 4 * e4) * 4); v[4 * e4] = x[0]; v[4 * e4 + 1] = x[1]; v[4 * e4 + 2] = x[2]; v[4 * e4 + 3] = x[3]; }
                  bf16* og = sp.OG + m * (G::NHG * 256) + hg * 256 + vc;
                  if (dd == 0) { v4u w0, w1; w0.x = cvtpk(v[0], v[1]); w0.y = cvtpk(v[2], v[3]); w0.z = cvtpk(v[4], v[5]); w0.w = cvtpk(v[6], v[7]); w1.x = cvtpk(v[8], v[9]); w1.y = cvtpk(v[10], v[11]); w1.z = cvtpk(v[12], v[13]); w1.w = cvtpk(v[14], v[15]);
                      *(GAS v4u*)og = w0; *(GAS v4u*)(og + 8) = w1; }
                  else { const v4u w0 = *(const GAS v4u*)og, w1 = *(const GAS v4u*)(og + 8); float ss = 0.f;
#pragma unroll
                      for (int e = 0; e < 4; ++e) { v[2 * e] += __uint_as_float(w0[e] << 16); v[2 * e + 1] += __uint_as_float(w0[e] & 0xffff0000u); v[8 + 2 * e] += __uint_as_float(w1[e] << 16); v[8 + 2 * e + 1] += __uint_as_float(w1[e] & 0xffff0000u); }
#pragma unroll
                      for (int e = 0; e < 16; ++e) ss += v[e] * v[e];
#pragma unroll
                      for (int o_ = 1; o_ < G::DVH / 16; o_ <<= 1) ss += __shfl_xor(ss, o_);
                      const float rstd = 1.f / sqrtf(ss * (1.f / G::DVH) + EPS);
                      bf16* mp = sp.MIX + m * NMIX + G::GOFF + h0 * G::DVH + vc; const float* gwp = sp.gnw + li * (4 * G::DVH) + h0 * G::DVH + vc;
                      const v4u g0 = *(const GAS v4u*)mp, g1v = *(const GAS v4u*)(mp + 8); float gt[16];
#pragma unroll
                      for (int e = 0; e < 4; ++e) { gt[2 * e] = __uint_as_float(g0[e] << 16); gt[2 * e + 1] = __uint_as_float(g0[e] & 0xffff0000u); gt[8 + 2 * e] = __uint_as_float(g1v[e] << 16); gt[8 + 2 * e + 1] = __uint_as_float(g1v[e] & 0xffff0000u); }
#pragma unroll
                      for (int e = 0; e < 16; ++e) v[e] = v[e] * rstd * gwp[e] * siluf_(gt[e]);
                      v4u w0o, w1o; w0o.x = cvtpk(v[0], v[1]); w0o.y = cvtpk(v[2], v[3]); w0o.z = cvtpk(v[4], v[5]); w0o.w = cvtpk(v[6], v[7]); w1o.x = cvtpk(v[8], v[9]); w1o.y = cvtpk(v[10], v[11]); w1o.z = cvtpk(v[12], v[13]); w1o.w = cvtpk(v[14], v[15]);
                      *(GAS v4u*)mp = w0o; *(GAS v4u*)(mp + 8) = w1o; }
                }
            }
            __syncthreads();
        }
        if (!MODE) {
            bf16* Lp = sp.L + ((((size_t)(b * 4 + h0 + hh) * G::NSC + sc) * 2 + dir) * G::L_ITEM) + (size_t)((vcol0 - hh * G::DVH) + r) * 128;
#pragma unroll
            for (int kt = 0; kt < 4; ++kt)
#pragma unroll
                for (int g4 = 0; g4 < 4; ++g4) { v2u w; w.x = cvtpk(S[kt][4 * g4], S[kt][4 * g4 + 1]); w.y = cvtpk(S[kt][4 * g4 + 2], S[kt][4 * g4 + 3]); *(GAS v2u*)(Lp + 32 * kt + 8 * g4 + 4 * h) = w; }
            if (tid < G::KH) sp.LOGD[(((size_t)(b * 4 + h0 + (tid >> 7)) * G::NSC + sc) * 2 + dir) * 128 + (tid & 127)] = logd_acc;
        }
        if (MODE) { asm volatile("s_waitcnt vmcnt(0)" ::: "memory"); __syncthreads(); }
    }
}

template <int ODD, int MODE>
__device__ __forceinline__ void scan_item2(const Ctx& C, const ScanPtrs& sp, int li, int b, int hg, int sc, int dir0) {
    typedef Geo<ODD> G;
    constexpr int NU = G::KH / 128;
    constexpr int UPR = G::KH / 8;
    constexpr int OFF_WUP = G::OFF_D + 1024;
    static_assert(OFF_WUP + 16 * 512 + 512 <= RING_BYTES, "scan LDS map (wup)");
    const int tid0 = C.tid, wave = C.wave; int lane0 = C.lane; asm volatile("" : "+v"(lane0));
    int tid = tid0, lane = lane0; int r = lane & 31, h = lane >> 5, i16 = lane & 15, q4 = i16 >> 2, p4 = i16 & 3, g1 = (lane >> 4) & 1;
    const int hh = wave / (8 / G::NH), h0 = hg * G::NH;
    const int kc0 = hh * 128, vcol0 = wave * 32;
    LAS unsigned char* lds = C.lds;
    const int sc0 = sc * G::SCLEN;
    const bf16* Pb = sp.P + (size_t)b * T * G::NP;
    int uc8 = (tid % UPR) * 8, ui0 = tid / UPR;
    int vi0 = tid >> 5, vc8 = (tid & 31) * 8;
    int ei = tid >> 4, evc = (tid & 15) * 16;
    f32x16 S[4];
    for (int dd = 0; dd < (MODE ? 2 : 1); ++dd) {
        const int dir = MODE ? dd : dir0;
        float lb8[8]; float logd8[8];
#pragma unroll
        for (int e = 0; e < 8; ++e) { lb8[e] = 0.f; logd8[e] = 0.f; }
        if (!ODD) { if (li == 1) {
#pragma unroll
            for (int e = 0; e < 8; ++e) { const int ch = h0 * 128 + uc8 + e; lb8[e] = 1.f / (1.f + __expf(sp.lbp[(0 * 2 + dir) * 512 + ch] - sp.lbp[(1 * 2 + dir) * 512 + ch])); } } }
        else {
            for (int u = tid; u < 16 * 128; u += NTHR) *(LAS float*)(lds + OFF_WUP + u * 4) = sp.wgu[((size_t)(li * 2 + dir) * 16 + (u >> 7)) * 512 + h0 * 128 + (u & 127)];
            if (tid < 128) *(LAS float*)(lds + OFF_WUP + 16 * 512 + tid * 4) = sp.bgp[(li * 2 + dir) * 512 + h0 * 128 + tid];
        }
        if (MODE) { const bf16* Lp = sp.L + ((((size_t)(b * 4 + h0 + hh) * G::NSC + sc) * 2 + dir) * G::L_ITEM) + (size_t)((vcol0 - hh * G::DVH) + r) * 128;
#pragma unroll
            for (int kt = 0; kt < 4; ++kt)
#pragma unroll
                for (int g4 = 0; g4 < 4; ++g4) { const v2u w = *(const GAS v2u*)(Lp + 32 * kt + 8 * g4 + 4 * h);
                    S[kt][4 * g4 + 0] = __uint_as_float(w.x << 16); S[kt][4 * g4 + 1] = __uint_as_float(w.x & 0xffff0000u); S[kt][4 * g4 + 2] = __uint_as_float(w.y << 16); S[kt][4 * g4 + 3] = __uint_as_float(w.y & 0xffff0000u); } }
        else {
#pragma unroll
            for (int kt = 0; kt < 4; ++kt)
#pragma unroll
                for (int e = 0; e < 16; ++e) S[kt][e] = 0.f; }
        v4u pz[NU], pq[NU], pv[2], pr[2], pog[2] = {{0u, 0u, 0u, 0u}, {0u, 0u, 0u, 0u}}, pgt[2] = {{0u, 0u, 0u, 0u}, {0u, 0u, 0u, 0u}};
#define SCAN_TOK(ci_, i_) (dir ? (sc0 + G::SCLEN - 1 - 32 * (ci_) - (i_)) : (sc0 + 32 * (ci_) + (i_)))
#define SCAN_LOAD(ci_) do { \
            _Pragma("unroll") for (int jj = 0; jj < NU; ++jj) { const bf16* row = Pb + (size_t)SCAN_TOK(ci_, ui0 + jj * (NTHR / UPR)) * G::NP; \
                pz[jj] = *(const GAS v4u*)(row + (ODD ? O_KC : (dir ? E_ZB : E_ZF)) + h0 * 128 + uc8); \
                if (MODE) pq[jj] = *(const GAS v4u*)(row + G::QOFF + h0 * 128 + uc8); \
                if (ODD) { pr[0] = *(const GAS v4u*)(row + (dir ? O_RB : O_RF)); pr[1] = *(const GAS v4u*)(row + (dir ? O_RB : O_RF) + 8); } } \
            _Pragma("unroll") for (int jj = 0; jj < 2; ++jj) pv[jj] = *(const GAS v4u*)(Pb + (size_t)SCAN_TOK(ci_, vi0 + 16 * jj) * G::NP + G::VOFF + h0 * G::DVH + vc8); \
            } while (0)
#define SCAN_LOAD_EPI(ci_) do { if (MODE && dd == 1) { const size_t m_ = (size_t)b * T + SCAN_TOK(ci_, ei); const bf16* og_ = sp.OG + m_ * (G::NHG * 256) + hg * 256 + evc; const bf16* mp_ = sp.MIX + m_ * NMIX + G::GOFF + h0 * G::DVH + evc; \
                pog[0] = *(const GAS v4u*)og_; pog[1] = *(const GAS v4u*)(og_ + 8); pgt[0] = *(const GAS v4u*)mp_; pgt[1] = *(const GAS v4u*)(mp_ + 8); } } while (0)
        if (ODD) __syncthreads();
        SCAN_LOAD(0); SCAN_LOAD_EPI(0);
#pragma unroll 1
        for (int ci = 0; ci < G::NCH; ++ci) {
            tid = tid0; lane = lane0; asm volatile("" : "+v"(tid), "+v"(lane));
            r = lane & 31; h = lane >> 5; i16 = lane & 15; q4 = i16 >> 2; p4 = i16 & 3; g1 = (lane >> 4) & 1;
            uc8 = (tid % UPR) * 8; ui0 = tid / UPR; vi0 = tid >> 5; vc8 = (tid & 31) * 8; ei = tid >> 4; evc = (tid & 15) * 16;
#pragma unroll
            for (int jj = 0; jj < NU; ++jj) { const int i = ui0 + jj * (NTHR / UPR); float gl[8];
                if (!ODD) {
#pragma unroll
                    for (int e = 0; e < 4; ++e) { const float z0 = __uint_as_float(pz[jj][e] << 16), z1 = __uint_as_float(pz[jj][e] & 0xffff0000u);
                        gl[2 * e] = __logf(fmaxf(lb8[2 * e] + (1.f - lb8[2 * e]) * sigmoidf_(z0), 1e-30f)); gl[2 * e + 1] = __logf(fmaxf(lb8[2 * e + 1] + (1.f - lb8[2 * e + 1]) * sigmoidf_(z1), 1e-30f)); } }
                else { float rv[16];
#pragma unroll
                    for (int e = 0; e < 4; ++e) { rv[2 * e] = __uint_as_float(pr[0][e] << 16); rv[2 * e + 1] = __uint_as_float(pr[0][e] & 0xffff0000u); rv[8 + 2 * e] = __uint_as_float(pr[1][e] << 16); rv[8 + 2 * e + 1] = __uint_as_float(pr[1][e] & 0xffff0000u); }
                    const f32x4 bb0 = *(const LAS f32x4*)(lds + OFF_WUP + 16 * 512 + uc8 * 4), bb1 = *(const LAS f32x4*)(lds + OFF_WUP + 16 * 512 + uc8 * 4 + 16);
                    float pre[8] = {bb0[0], bb0[1], bb0[2], bb0[3], bb1[0], bb1[1], bb1[2], bb1[3]};
#pragma unroll
                    for (int rr = 0; rr < 16; ++rr) { const f32x4 w0 = *(const LAS f32x4*)(lds + OFF_WUP + rr * 512 + uc8 * 4), w1 = *(const LAS f32x4*)(lds + OFF_WUP + rr * 512 + uc8 * 4 + 16);
                        pre[0] += rv[rr] * w0[0]; pre[1] += rv[rr] * w0[1]; pre[2] += rv[rr] * w0[2]; pre[3] += rv[rr] * w0[3]; pre[4] += rv[rr] * w1[0]; pre[5] += rv[rr] * w1[1]; pre[6] += rv[rr] * w1[2]; pre[7] += rv[rr] * w1[3]; }
#pragma unroll
                    for (int e = 0; e < 8; ++e) gl[e] = (fminf(pre[e], 0.f) - __logf(1.f + __expf(-fabsf(pre[e])))) * (1.f / 16.f); }
                f32x4 o0 = {gl[0], gl[1], gl[2], gl[3]}, o1 = {gl[4], gl[5], gl[6], gl[7]};
                *(LAS f32x4*)(lds + G::OFF_B + i * G::RSB + uc8 * 4) = o0; *(LAS f32x4*)(lds + G::OFF_B + i * G::RSB + uc8 * 4 + 16) = o1; }
            __syncthreads();
            if (tid < 2 * G::KH) { const int c = tid % G::KH, i0 = (tid / G::KH) * 16; float acc = 0.f;
#pragma unroll
                for (int i = 0; i < 16; ++i) { LAS float* p = (LAS float*)(lds + G::OFF_B + (i0 + i) * G::RSB + c * 4); acc += *p; *p = acc; } }
            __syncthreads();
#pragma unroll
            for (int jj = 0; jj < NU; ++jj) { const int i = ui0 + jj * (NTHR / UPR);
                const f32x4 b0 = *(const LAS f32x4*)(lds + G::OFF_B + i * G::RSB + uc8 * 4), b1 = *(const LAS f32x4*)(lds + G::OFF_B + i * G::RSB + uc8 * 4 + 16);
                const f32x4 r0 = *(const LAS f32x4*)(lds + G::OFF_B + 15 * G::RSB + uc8 * 4), r1 = *(const LAS f32x4*)(lds + G::OFF_B + 15 * G::RSB + uc8 * 4 + 16);
                const f32x4 e0 = *(const LAS f32x4*)(lds + G::OFF_B + 31 * G::RSB + uc8 * 4), e1 = *(const LAS f32x4*)(lds + G::OFF_B + 31 * G::RSB + uc8 * 4 + 16);
                float rr[8] = {r0[0], r0[1], r0[2], r0[3], r1[0], r1[1], r1[2], r1[3]};
                float bb[8] = {b0[0], b0[1], b0[2], b0[3], b1[0], b1[1], b1[2], b1[3]}, ee[8] = {e0[0], e0[1], e0[2], e0[3], e1[0], e1[1], e1[2], e1[3]};
#pragma unroll
                for (int e = 0; e < 8; ++e) { if (i >= 16) bb[e] += rr[e]; ee[e] += rr[e]; }
                float kk[8], qq[8];
                if (!ODD) {
#pragma unroll
                    for (int e = 0; e < 4; ++e) { kk[2 * e] = (1.f - lb8[2 * e]) * (1.f - sigmoidf_(__uint_as_float(pz[jj][e] << 16))); kk[2 * e + 1] = (1.f - lb8[2 * e + 1]) * (1.f - sigmoidf_(__uint_as_float(pz[jj][e] & 0xffff0000u))); }
                    if (MODE) {
#pragma unroll
                        for (int e = 0; e < 4; ++e) { qq[2 * e] = siluf_(__uint_as_float(pq[jj][e] << 16)); qq[2 * e + 1] = siluf_(__uint_as_float(pq[jj][e] & 0xffff0000u)); } } }
                else {
#pragma unroll
                    for (int e = 0; e < 4; ++e) { kk[2 * e] = __uint_as_float(pz[jj][e] << 16); kk[2 * e + 1] = __uint_as_float(pz[jj][e] & 0xffff0000u); }
                    if (MODE) {
#pragma unroll
                        for (int e = 0; e < 4; ++e) { qq[2 * e] = __uint_as_float(pq[jj][e] << 16) * 0.08838834764831845f; qq[2 * e + 1] = __uint_as_float(pq[jj][e] & 0xffff0000u) * 0.08838834764831845f; } } }
                v4u w;
                w.x = cvtpk(kk[0] * __expf(ee[0] - bb[0]), kk[1] * __expf(ee[1] - bb[1])); w.y = cvtpk(kk[2] * __expf(ee[2] - bb[2]), kk[3] * __expf(ee[3] - bb[3]));
                w.z = cvtpk(kk[4] * __expf(ee[4] - bb[4]), kk[5] * __expf(ee[5] - bb[5])); w.w = cvtpk(kk[6] * __expf(ee[6] - bb[6]), kk[7] * __expf(ee[7] - bb[7]));
                *(LAS v4u*)(lds + G::OFF_W + i * G::RST + uc8 * 2) = w;
                if (i == 31) { f32x4 d0 = {__expf(ee[0]), __expf(ee[1]), __expf(ee[2]), __expf(ee[3])}, d1 = {__expf(ee[4]), __expf(ee[5]), __expf(ee[6]), __expf(ee[7])};
                    *(LAS f32x4*)(lds + G::OFF_D + uc8 * 4) = d0; *(LAS f32x4*)(lds + G::OFF_D + uc8 * 4 + 16) = d1;
#pragma unroll
                    for (int e = 0; e < 8; ++e) logd8[e] += ee[e]; }
                if (MODE) {
                    float dl[8];
#pragma unroll
                    for (int e = 0; e < 8; ++e) dl[e] = bb[e] - rr[e];
                    w.x = cvtpk(qq[0] * __expf(bb[0]), qq[1] * __expf(bb[1])); w.y = cvtpk(qq[2] * __expf(bb[2]), qq[3] * __expf(bb[3]));
                    w.z = cvtpk(qq[4] * __expf(bb[4]), qq[5] * __expf(bb[5])); w.w = cvtpk(qq[6] * __expf(bb[6]), qq[7] * __expf(bb[7]));
                    *(LAS v4u*)(lds + G::OFF_Q1 + i * G::RSK + uc8 * 2) = w;
                    w.x = cvtpk(qq[0] * expc(dl[0]), qq[1] * expc(dl[1])); w.y = cvtpk(qq[2] * expc(dl[2]), qq[3] * expc(dl[3]));
                    w.z = cvtpk(qq[4] * expc(dl[4]), qq[5] * expc(dl[5])); w.w = cvtpk(qq[6] * expc(dl[6]), qq[7] * expc(dl[7]));
                    *(LAS v4u*)(lds + G::OFF_Q2 + i * G::RSK + uc8 * 2) = w;
                    w.x = cvtpk(kk[0] * expc(-dl[0]), kk[1] * expc(-dl[1])); w.y = cvtpk(kk[2] * expc(-dl[2]), kk[3] * expc(-dl[3]));
                    w.z = cvtpk(kk[4] * expc(-dl[4]), kk[5] * expc(-dl[5])); w.w = cvtpk(kk[6] * expc(-dl[6]), kk[7] * expc(-dl[7]));
                    *(LAS v4u*)(lds + G::OFF_K2 + i * G::RSK + uc8 * 2) = w;
                }
            }
#pragma unroll
            for (int jj = 0; jj < 2; ++jj) *(LAS v4u*)(lds + G::OFF_V + (vi0 + 16 * jj) * G::RSV + vc8 * 2) = pv[jj];
            if (ci + 1 < G::NCH) SCAN_LOAD(ci + 1);
            __syncthreads();
            f32x16 o;
            if (MODE) {
#pragma unroll
                for (int e = 0; e < 16; ++e) o[e] = 0.f;
#pragma unroll
                for (int kt = 0; kt < 4; ++kt)
#pragma unroll
                    for (int st = 0; st < 2; ++st) { const LAS unsigned char* qp = lds + G::OFF_Q1 + r * G::RSK + (kc0 + 32 * kt + 16 * st + 4 * h) * 2;
                        const s16x4 lo = *(const LAS s16x4*)qp, hi = *(const LAS s16x4*)(qp + 16);
                        const bf16x8 a = __builtin_shufflevector(lo, hi, 0, 1, 2, 3, 4, 5, 6, 7);
                        o = SC_MFMA(a, pack8(S[kt], st), o); }
                f32x16 at;
#pragma unroll
                for (int e = 0; e < 16; ++e) at[e] = 0.f;
#pragma unroll
                for (int ks = 0; ks < 8; ++ks) { const bf16x8 a = *(const LAS bf16x8*)(lds + G::OFF_K2 + r * G::RSK + (kc0 + 16 * ks + 8 * h) * 2), bq = *(const LAS bf16x8*)(lds + G::OFF_Q2 + r * G::RSK + (kc0 + 16 * ks + 8 * h) * 2);
                    at = SC_MFMA(a, bq, at); }
#pragma unroll
                for (int e = 0; e < 16; ++e) { const int srow = (e & 3) + 8 * (e >> 2) + 4 * h; at[e] = (srow <= r) ? at[e] : 0.f; }
#pragma unroll
                for (int st = 0; st < 2; ++st) { const LAS unsigned char* vp = lds + G::OFF_V + (16 * st + 4 * h + q4) * G::RSV + (vcol0 + 16 * g1 + 4 * p4) * 2;
                    const s16x4 lo = trd(vp), hi = trd(vp + 8 * G::RSV);
                    const bf16x8 bv = __builtin_shufflevector(lo, hi, 0, 1, 2, 3, 4, 5, 6, 7);
                    o = SC_MFMA(pack8(at, st), bv, o); }
            }
#pragma unroll
            for (int kt = 0; kt < 4; ++kt)
#pragma unroll
                for (int g4 = 0; g4 < 4; ++g4) { const f32x4 dv = *(const LAS f32x4*)(lds + G::OFF_D + (kc0 + 32 * kt + 8 * g4 + 4 * h) * 4);
#pragma unroll
                    for (int e = 0; e < 4; ++e) S[kt][4 * g4 + e] *= dv[e]; }
#pragma unroll
            for (int st = 0; st < 2; ++st) { const LAS unsigned char* vp = lds + G::OFF_V + (16 * st + 8 * h + q4) * G::RSV + (vcol0 + 16 * g1 + 4 * p4) * 2;
                const s16x4 vlo = trd(vp), vhi = trd(vp + 4 * G::RSV);
                const bf16x8 bv = __builtin_shufflevector(vlo, vhi, 0, 1, 2, 3, 4, 5, 6, 7);
#pragma unroll
                for (int kt = 0; kt < 4; ++kt) { const LAS unsigned char* wp = lds + G::OFF_W + (16 * st + 8 * h + q4) * G::RST + (kc0 + 32 * kt + 16 * g1 + 4 * p4) * 2;
                    const s16x4 wlo = trd(wp), whi = trd(wp + 4 * G::RST);
                    const bf16x8 aw = __builtin_shufflevector(wlo, whi, 0, 1, 2, 3, 4, 5, 6, 7);
                    S[kt] = SC_MFMA(aw, bv, S[kt]); } }
            if (MODE) {
#pragma unroll
                for (int e = 0; e < 16; ++e) *(LAS float*)(lds + G::OFF_B + ((e & 3) + 8 * (e >> 2) + 4 * h) * G::RSO + (vcol0 + r) * 4) = o[e];
                __syncthreads();
                { const size_t m = (size_t)b * T + SCAN_TOK(ci, ei);
                  float v[16];
#pragma unroll
                  for (int e4 = 0; e4 < 4; ++e4) { const f32x4 x = *(const LAS f32x4*)(lds + G::OFF_B + ei * G::RSO + (evc + 4 * e4) * 4); v[4 * e4] = x[0]; v[4 * e4 + 1] = x[1]; v[4 * e4 + 2] = x[2]; v[4 * e4 + 3] = x[3]; }
                  if (dd == 0) { bf16* og = sp.OG + m * (G::NHG * 256) + hg * 256 + evc;
                      v4u w0, w1; w0.x = cvtpk(v[0], v[1]); w0.y = cvtpk(v[2], v[3]); w0.z = cvtpk(v[4], v[5]); w0.w = cvtpk(v[6], v[7]); w1.x = cvtpk(v[8], v[9]); w1.y = cvtpk(v[10], v[11]); w1.z = cvtpk(v[12], v[13]); w1.w = cvtpk(v[14], v[15]);
                      *(GAS v4u*)og = w0; *(GAS v4u*)(og + 8) = w1; }
                  else { float ss = 0.f;
#pragma unroll
                      for (int e = 0; e < 4; ++e) { v[2 * e] += __uint_as_float(pog[0][e] << 16); v[2 * e + 1] += __uint_as_float(pog[0][e] & 0xffff0000u); v[8 + 2 * e] += __uint_as_float(pog[1][e] << 16); v[8 + 2 * e + 1] += __uint_as_float(pog[1][e] & 0xffff0000u); }
#pragma unroll
                      for (int e = 0; e < 16; ++e) ss += v[e] * v[e];
#pragma unroll
                      for (int o_ = 1; o_ < G::DVH / 16; o_ <<= 1) ss += __shfl_xor(ss, o_);
                      const float rstd = 1.f / sqrtf(ss * (1.f / G::DVH) + EPS);
                      bf16* mp = sp.MIX + m * NMIX + G::GOFF + h0 * G::DVH + evc; const float* gwp = sp.gnw + li * (4 * G::DVH) + h0 * G::DVH + evc;
                      float gt[16];
#pragma unroll
                      for (int e = 0; e < 4; ++e) { gt[2 * e] = __uint_as_float(pgt[0][e] << 16); gt[2 * e + 1] = __uint_as_float(pgt[0][e] & 0xffff0000u); gt[8 + 2 * e] = __uint_as_float(pgt[1][e] << 16); gt[8 + 2 * e + 1] = __uint_as_float(pgt[1][e] & 0xffff0000u); }
#pragma unroll
                      for (int e4 = 0; e4 < 4; ++e4) { const f32x4 gw4 = *(const GAS f32x4*)(gwp + 4 * e4);
#pragma unroll
                          for (int e = 0; e < 4; ++e) v[4 * e4 + e] = v[4 * e4 + e] * rstd * gw4[e] * siluf_(gt[4 * e4 + e]); }
                      v4u w0o, w1o; w0o.x = cvtpk(v[0], v[1]); w0o.y = cvtpk(v[2], v[3]); w0o.z = cvtpk(v[4], v[5]); w0o.w = cvtpk(v[6], v[7]); w1o.x = cvtpk(v[8], v[9]); w1o.y = cvtpk(v[10], v[11]); w1o.z = cvtpk(v[12], v[13]); w1o.w = cvtpk(v[14], v[15]);
                      *(GAS v4u*)mp = w0o; *(GAS v4u*)(mp + 8) = w1o; }
                }
                if (ci + 1 < G::NCH) SCAN_LOAD_EPI(ci + 1);
            }
            __syncthreads();
        }
#undef SCAN_LOAD_EPI
#undef SCAN_LOAD
#undef SCAN_TOK
        if (!MODE) {
            bf16* Lp = sp.L + ((((size_t)(b * 4 + h0 + hh) * G::NSC + sc) * 2 + dir) * G::L_ITEM) + (size_t)((vcol0 - hh * G::DVH) + r) * 128;
#pragma unroll
            for (int kt = 0; kt < 4; ++kt)
#pragma unroll
                for (int g4 = 0; g4 < 4; ++g4) { v2u w; w.x = cvtpk(S[kt][4 * g4], S[kt][4 * g4 + 1]); w.y = cvtpk(S[kt][4 * g4 + 2], S[kt][4 * g4 + 3]); *(GAS v2u*)(Lp + 32 * kt + 8 * g4 + 4 * h) = w; }
            if (ui0 + (NU - 1) * (NTHR / UPR) == 31) {
                float* ld = sp.LOGD + (((size_t)(b * 4 + h0 + (uc8 >> 7)) * G::NSC + sc) * 2 + dir) * 128 + (uc8 & 127);
                f32x4 l0 = {logd8[0], logd8[1], logd8[2], logd8[3]}, l1 = {logd8[4], logd8[5], logd8[6], logd8[7]};
                *(GAS f32x4*)ld = l0; *(GAS f32x4*)(ld + 4) = l1; }
        }
        if (MODE) { asm volatile("s_waitcnt vmcnt(0)" ::: "memory"); __syncthreads(); }
    }
}

template <int ODD>
__device__ __forceinline__ void scan_combine(const Ctx& C, const ScanPtrs& sp) {
    typedef Geo<ODD> G;
    const int nunits = 16 * 2 * G::DVH * 16;
    for (int u = C.bid * NTHR + C.tid; u < nunits; u += C.G * NTHR) {
        const int k8 = (u & 15) * 8, j = (u >> 4) % G::DVH, dir = ((u >> 4) / G::DVH) & 1, bh = (u >> 4) / (G::DVH * 2);
        float S[8];
#pragma unroll
        for (int e = 0; e < 8; ++e) S[e] = 0.f;
#pragma unroll 4
        for (int s = 0; s < G::NSC; ++s) { const int sc = dir ? (G::NSC - 1 - s) : s;
            bf16* p = sp.L + (((size_t)bh * G::NSC + sc) * 2 + dir) * G::L_ITEM + (size_t)j * 128 + k8;
            const float* ld = sp.LOGD + (((size_t)bh * G::NSC + sc) * 2 + dir) * 128 + k8;
            const v4u w = *(const GAS v4u*)p; const f32x4 d0 = *(const GAS f32x4*)ld, d1 = *(const GAS f32x4*)(ld + 4);
            v4u o; o.x = cvtpk(S[0], S[1]); o.y = cvtpk(S[2], S[3]); o.z = cvtpk(S[4], S[5]); o.w = cvtpk(S[6], S[7]);
            *(GAS v4u*)p = o;
            const float dd[8] = {d0[0], d0[1], d0[2], d0[3], d1[0], d1[1], d1[2], d1[3]};
#pragma unroll
            for (int e = 0; e < 4; ++e) { S[2 * e] = __expf(dd[2 * e]) * S[2 * e] + __uint_as_float(w[e] << 16); S[2 * e + 1] = __expf(dd[2 * e + 1]) * S[2 * e + 1] + __uint_as_float(w[e] & 0xffff0000u); }
        }
    }
}
}

namespace attn {
using scan::bf16x8; using scan::s16x4; using scan::f32x16; using scan::cvtpk; using scan::trd; using scan::pack8;
constexpr int WK_RS = 144, WV_RS = 192, WK_OFF = 0, WV_OFF = 384 * WK_RS;
static_assert(WV_OFF + 384 * WV_RS <= RING_BYTES, "window attention LDS");
constexpr int MK_RS = 272, MV_RS = 520, MK_OFF = 0, MV_OFF = 256 * MK_RS;
static_assert(MV_OFF + 128 * MV_RS <= RING_BYTES + 8192, "memory attention LDS");

__device__ __forceinline__ void winattn_unit(const Ctx& C, const bf16* P, bf16* MIX, const float* sink8, int b, int n, int c) {
    const int tid = C.tid, wave = C.wave; int lane = C.lane; asm volatile("" : "+v"(lane));
    const int r = lane & 31, h = lane >> 5, i16 = lane & 15, q4 = i16 >> 2, p4 = i16 & 3, g1 = (lane >> 4) & 1;
    LAS unsigned char* lds = C.lds;
    for (int u = tid; u < 384 * 8; u += NTHR) { const int j = u >> 3, c8 = (u & 7) * 8, s = 128 * (c - 1) + j;
        v4u kv = {0u, 0u, 0u, 0u}, vv = {0u, 0u, 0u, 0u};
        if (s >= 0 && s < T) { const bf16* row = P + (size_t)(b * T + s) * NP_E; kv = *(const GAS v4u*)(row + E_KA + n * 64 + c8); vv = *(const GAS v4u*)(row + E_VA + n * 64 + c8); }
        *(LAS v4u*)(lds + WK_OFF + j * WK_RS + c8 * 2) = kv; *(LAS v4u*)(lds + WV_OFF + j * WV_RS + c8 * 2) = vv; }
    __syncthreads();
    const int hq = 4 * n + (wave >> 1);
    const float slope = exp2f(-(float)(hq + 1)), sk = sink8[hq];
#pragma unroll 1
    for (int tt = 0; tt < 2; ++tt) {
        const int qt = 2 * (wave & 1) + tt; const int t = 128 * c + 32 * qt + r; const size_t m = (size_t)b * T + t;
        bf16x8 qf[4];
#pragma unroll
        for (int ks = 0; ks < 4; ++ks) qf[ks] = *(const GAS bf16x8*)(P + m * NP_E + E_QA + hq * 64 + 16 * ks + 8 * h);
        f32x16 o[2];
#pragma unroll
        for (int dt = 0; dt < 2; ++dt)
#pragma unroll
            for (int e = 0; e < 16; ++e) o[dt][e] = 0.f;
        float mrun = sk, lrun = 0.f;
#pragma unroll 1
        for (int kg = 0; kg < 3; ++kg) {
            f32x16 st[3];
#pragma unroll
            for (int k3 = 0; k3 < 3; ++k3) {
#pragma unroll
                for (int e = 0; e < 16; ++e) st[k3][e] = 0.f;
#pragma unroll
                for (int ks = 0; ks < 4; ++ks) { const bf16x8 a = *(const LAS bf16x8*)(lds + WK_OFF + (32 * (qt + 3 * kg + k3) + r) * WK_RS + (16 * ks + 8 * h) * 2); st[k3] = SC_MFMA(a, qf[ks], st[k3]); } }
            float mx = -3e38f;
#pragma unroll
            for (int k3 = 0; k3 < 3; ++k3)
#pragma unroll
                for (int e = 0; e < 16; ++e) { const int kt = 3 * kg + k3; const int cr = (e & 3) + 8 * (e >> 2) + 4 * h; const int dd = 128 - 32 * kt + r - cr; const int s = 128 * (c - 1) + 32 * (qt + kt) + cr;
                    const int ad = dd < 0 ? -dd : dd; const bool valid = (ad <= 128) && (s >= 0) && (s < T);
                    const float val = valid ? (st[k3][e] * 0.125f - slope * (float)ad) : -3e38f; st[k3][e] = val; mx = fmaxf(mx, val); }
            mx = fmaxf(mx, __shfl_xor(mx, 32));
            const float mnew = fmaxf(mrun, mx), alpha = __expf(mrun - mnew);
            mrun = mnew; lrun *= alpha;
#pragma unroll
            for (int dt = 0; dt < 2; ++dt)
#pragma unroll
                for (int e = 0; e < 16; ++e) o[dt][e] *= alpha;
#pragma unroll
            for (int k3 = 0; k3 < 3; ++k3)
#pragma unroll
                for (int e = 0; e < 16; ++e) { const float p = (st[k3][e] > -1e38f) ? __expf(st[k3][e] - mnew) : 0.f; st[k3][e] = p; lrun += p; }
#pragma unroll
            for (int k3 = 0; k3 < 3; ++k3)
#pragma unroll
                for (int s2 = 0; s2 < 2; ++s2) { const bf16x8 bx = pack8(st[k3], s2);
#pragma unroll
                    for (int dt = 0; dt < 2; ++dt) { const LAS unsigned char* vp = lds + WV_OFF + (32 * (qt + 3 * kg + k3) + 16 * s2 + 4 * h + q4) * WV_RS + (32 * dt + 16 * g1 + 4 * p4) * 2;
                        const s16x4 lo = trd(vp), hi = trd(vp + 8 * WV_RS);
                        const bf16x8 a = __builtin_shufflevector(lo, hi, 0, 1, 2, 3, 4, 5, 6, 7);
                        o[dt] = SC_MFMA(a, bx, o[dt]); } }
        }
        const float inv = 1.f / (lrun + __shfl_xor(lrun, 32) + __expf(sk - mrun));
        bf16* mp = MIX + m * NMIX + X_GA + hq * 64;
#pragma unroll
        for (int dt = 0; dt < 2; ++dt)
#pragma unroll
            for (int g4 = 0; g4 < 4; ++g4) { const int d = 32 * dt + 8 * g4 + 4 * h; const v2u gv = *(const GAS v2u*)(mp + d);
                const float g0 = __uint_as_float(gv.x << 16), g1f = __uint_as_float(gv.x & 0xffff0000u), g2 = __uint_as_float(gv.y << 16), g3 = __uint_as_float(gv.y & 0xffff0000u);
                v2u w; w.x = cvtpk(o[dt][4 * g4] * inv * siluf_(g0), o[dt][4 * g4 + 1] * inv * siluf_(g1f)); w.y = cvtpk(o[dt][4 * g4 + 2] * inv * siluf_(g2), o[dt][4 * g4 + 3] * inv * siluf_(g3));
                *(GAS v2u*)(mp + d) = w; }
    }
    __syncthreads();
}

__device__ __forceinline__ void memattn_unit(const Ctx& C, const bf16* P, int NP, int QOFF, bf16* MIX, const bf16* MK, const bf16* MVT, int b, int hh, int tb) {
    const int tid = C.tid, wave = C.wave; int lane = C.lane; asm volatile("" : "+v"(lane));
    const int r = lane & 31, h = lane >> 5;
    LAS unsigned char* lds = C.lds;
    for (int u = tid; u < 256 * 16; u += NTHR) { const int j = u >> 4, c8 = (u & 15) * 8;
        *(LAS v4u*)(lds + MK_OFF + j * MK_RS + c8 * 2) = *(const GAS v4u*)(MK + (size_t)(b * NMEM + j) * 512 + hh * 128 + c8); }
    for (int u = tid; u < 128 * 32; u += NTHR) { const int d = u >> 5, c8 = (u & 31) * 8;
        const v4u w = *(const GAS v4u*)(MVT + (size_t)(hh * 128 + d) * 1024 + b * NMEM + c8);
        v2u w0 = {w.x, w.y}, w1 = {w.z, w.w};
        *(LAS v2u*)(lds + MV_OFF + d * MV_RS + c8 * 2) = w0; *(LAS v2u*)(lds + MV_OFF + d * MV_RS + c8 * 2 + 8) = w1; }
    __syncthreads();
    const size_t m = (size_t)b * T + tb * 256 + wave * 32 + r;
    f32x16 st[8];
    { bf16x8 qf[8];
#pragma unroll
      for (int ks = 0; ks < 8; ++ks) qf[ks] = *(const GAS bf16x8*)(P + m * NP + QOFF + hh * 128 + 16 * ks + 8 * h);
#pragma unroll
      for (int kt = 0; kt < 8; ++kt) {
#pragma unroll
          for (int e = 0; e < 16; ++e) st[kt][e] = 0.f;
#pragma unroll
          for (int ks = 0; ks < 8; ++ks) { const bf16x8 a = *(const LAS bf16x8*)(lds + MK_OFF + (32 * kt + r) * MK_RS + (16 * ks + 8 * h) * 2); st[kt] = SC_MFMA(a, qf[ks], st[kt]); } } }
    float mx = -3e38f;
#pragma unroll
    for (int kt = 0; kt < 8; ++kt)
#pragma unroll
        for (int e = 0; e < 16; ++e) mx = fmaxf(mx, st[kt][e]);
    mx = fmaxf(mx, __shfl_xor(mx, 32));
    float sum = 0.f;
#pragma unroll
    for (int kt = 0; kt < 8; ++kt)
#pragma unroll
        for (int e = 0; e < 16; ++e) { const float p = __expf((st[kt][e] - mx) * 0.08838834764831845f); st[kt][e] = p; sum += p; }
    sum += __shfl_xor(sum, 32);
    const float inv = 1.f / sum;
    f32x16 o[4];
#pragma unroll
    for (int dt = 0; dt < 4; ++dt)
#pragma unroll
        for (int e = 0; e < 16; ++e) o[dt][e] = 0.f;
#pragma unroll
    for (int kt = 0; kt < 8; ++kt)
#pragma unroll
        for (int s2 = 0; s2 < 2; ++s2) { const bf16x8 bx = pack8(st[kt], s2);
#pragma unroll
            for (int dt = 0; dt < 4; ++dt) { const LAS unsigned char* vp = lds + MV_OFF + (32 * dt + r) * MV_RS + (32 * kt + 16 * s2 + 4 * h) * 2;
                const s16x4 lo = *(const LAS s16x4*)vp, hi = *(const LAS s16x4*)(vp + 16);
                const bf16x8 a = __builtin_shufflevector(lo, hi, 0, 1, 2, 3, 4, 5, 6, 7);
                o[dt] = SC_MFMA(a, bx, o[dt]); } }
    bf16* mp = MIX + m * NMIX + X_GM + hh * 128;
#pragma unroll
    for (int dt = 0; dt < 4; ++dt)
#pragma unroll
        for (int g4 = 0; g4 < 4; ++g4) { const int d = 32 * dt + 8 * g4 + 4 * h; const v2u gv = *(const GAS v2u*)(mp + d);
            const float g0 = __uint_as_float(gv.x << 16), g1f = __uint_as_float(gv.x & 0xffff0000u), g2 = __uint_as_float(gv.y << 16), g3 = __uint_as_float(gv.y & 0xffff0000u);
            v2u w; w.x = cvtpk(o[dt][4 * g4] * inv * siluf_(g0), o[dt][4 * g4 + 1] * inv * siluf_(g1f)); w.y = cvtpk(o[dt][4 * g4 + 2] * inv * siluf_(g2), o[dt][4 * g4 + 3] * inv * siluf_(g3));
            *(GAS v2u*)(mp + d) = w; }
    __syncthreads();
}
}

constexpr int STEPS_PER_LAYER = 6, NSTEPS = 2 + DEPTH * STEPS_PER_LAYER;

__global__ void __launch_bounds__(NTHR, 2) mk_fwd(Args args) {
    extern __shared__ __attribute__((aligned(16))) unsigned char lds_raw[];
    Ctx C;
    C.lds = (LAS unsigned char*)lds_raw;
    C.tid = threadIdx.x; C.lane = C.tid & 63; C.wave = __builtin_amdgcn_readfirstlane(C.tid >> 6);
    C.G = gridDim.x; C.bid = blockIdx.x;
    C.out = args.out; C.ws = args.ws;
    volatile LAS unsigned* MISC = (volatile LAS unsigned*)(C.lds + MISC_OFF);
    for (int u = C.tid; u < (LDS_BYTES - RING_BYTES) / 4; u += NTHR) ((LAS unsigned*)(C.lds + RING_BYTES))[u] = 0u;
    __syncthreads();
    XcdBarrier bar; bar.bar = (unsigned*)(C.ws + WS_CTL) + CW_BAR; bar.x = 0; bar.st = nullptr;
    const int lo = args.ph_lo, hi = args.ph_hi;
    if (hi - lo > 1) bar = xcd_barrier_post((unsigned*)(C.ws + WS_CTL) + CW_BAR, MISC + 8);
    int step = 0; bool run_ = false;
#define PHASE_BEGIN { int _st = step; asm volatile("" : "+s"(_st)); run_ = (_st >= lo && _st < hi); } if (run_) { { unsigned char* _w = args.ws; float* _o = args.out; asm volatile("" : "+s"(_w), "+s"(_o)); C.ws = _w; C.out = _o; \
        int _t = threadIdx.x; asm volatile("" : "+v"(_t)); C.tid = _t; C.lane = _t & 63; C.wave = __builtin_amdgcn_readfirstlane(_t >> 6); \
        gw = C.bid * NWAVES + C.wave; wscr = (LAS float*)(C.lds + C.wave * 16384); \
        P = (bf16*)(C.ws + WS_P); MIX = (bf16*)(C.ws + WS_MIX); HN = (bf16*)(C.ws + WS_HN); }
#define PHASE_END   if (step + 1 < hi) xcd_barrier(bar); } ++step;

    int gw = C.bid * NWAVES + C.wave; const int NGW = C.G * NWAVES;
    LAS float* wscr = (LAS float*)(C.lds + C.wave * 16384);
    bf16* P = (bf16*)(C.ws + WS_P); bf16* MIX = (bf16*)(C.ws + WS_MIX); bf16* HN = (bf16*)(C.ws + WS_HN);

    PHASE_BEGIN if (TEST_MASK & 1) phase_prep(C, args); PHASE_END
    PHASE_BEGIN
#pragma unroll 1
        for (int l = 0; l < DEPTH; ++l) {
            const bf16* WKV = (const bf16*)(C.ws + WS_WKV) + (size_t)l * 1024 * 1024; const bf16* MEMN = (const bf16*)(C.ws + WS_MEMN);
#if USE_PG8
            { pg8::Gemm g{MEMN, WKV, 1024, 512, 1024}; pg8::StaticOrder S; S.init(1024, 512, C.G, (C.bid + C.G - 16 * l) % C.G);
              pg8::EpiProj e{(bf16*)(C.ws + WS_MEMK) + (size_t)l * 1024 * 512, nullptr, 512, 1 << 20};
              pg8::gemm_phase<pg8::EpiProj, pg8::StaticOrder, false, true>(C.lds, g, S, e); }
            { pg8::Gemm g{WKV + (size_t)512 * 1024, MEMN, 512, 1024, 1024}; pg8::StaticOrder S; S.init(512, 1024, C.G, (C.bid + C.G - 16 * l - 8) % C.G);
              pg8::EpiProj e{(bf16*)(C.ws + WS_MEMVT) + (size_t)l * 512 * 1024, nullptr, 1024, 1 << 20};
              pg8::gemm_phase<pg8::EpiProj, pg8::StaticOrder, false, true>(C.lds, g, S, e); }
#else
            EpiStoreBf16 ek{(bf16*)(C.ws + WS_MEMK) + (size_t)l * 1024 * 512, 512};
            gemm_naive(C, MEMN, 1024, WKV, 1024, 1024, 512, 1024, (C.bid + 32 * l) % C.G, C.G, ek);
            EpiStoreBf16 ev{(bf16*)(C.ws + WS_MEMVT) + (size_t)l * 512 * 1024, 1024};
            gemm_naive(C, WKV + (size_t)512 * 1024, 1024, MEMN, 1024, 512, 1024, 1024, (C.bid + 32 * l + 128) % C.G, C.G, ev);
#endif
        }
    PHASE_END

#pragma unroll 1
    for (int l = 0; l < DEPTH; ++l) {
        const int odd = l & 1, li = l >> 1;
        PHASE_BEGIN
#if USE_PG8
            pg8::Gemm g{HN, (const bf16*)(C.ws + WS_WIN), M, odd ? NIN_O : NIN_E, 1024}; pg8::StaticOrder S; S.init(M, odd ? NIN_O : NIN_E, C.G, C.bid);
            pg8::EpiProj e{P, MIX, odd ? NP_O : NP_E, (odd ? NP_O : NP_E) / 256};
            pg8::gemm_phase<pg8::EpiProj, pg8::StaticOrder, true, true>(C.lds, g, S, e);
#else
            EpiInProj e{P, MIX, odd ? NP_O : NP_E};
            gemm_naive(C, HN, 1024, (const bf16*)(C.ws + WS_WIN), 1024, M, odd ? NIN_O : NIN_E, 1024, C.bid, C.G, e);
#endif
        PHASE_END
        PHASE_BEGIN
#if USE_MFMA_SCAN
            { scan::ScanPtrs sp{P, MIX, (bf16*)(C.ws + (odd ? WS_L_O : WS_L_E)), (float*)(C.ws + WS_LOGD), (bf16*)(C.ws + (odd ? WS_OG_O : WS_OG_E)), args.in[5], args.in[10], args.in[11], odd ? args.in[12] : args.in[6]};
              const int NHG = odd ? 4 : 2, NSC = odd ? 16 : 32;
              for (int it = C.bid; it < BATCH * NHG * NSC * 2; it += C.G) { const int dir = it & 1, sc = (it >> 1) % NSC, hg = ((it >> 1) / NSC) % NHG, b = (it >> 1) / (NSC * NHG);
                  if (odd) scan::scan_item2<1, 0>(C, sp, li, b, hg, sc, dir); else scan::scan_item2<0, 0>(C, sp, li, b, hg, sc, dir); } }
            const int nscan = 0;
#if USE_MFMA_ATTN
            if (!odd) for (int it = C.bid; it < BATCH * 2 * 32; it += C.G) { const int c = it & 31, n = (it >> 5) & 1, b = it >> 6; attn::winattn_unit(C, P, MIX, args.in[4] + li * 8, b, n, c); }
            for (int it = C.bid; it < BATCH * 4 * 16; it += C.G) { const int tb = it & 15, hh = (it >> 4) & 3, b = it >> 6;
                attn::memattn_unit(C, P, odd ? NP_O : NP_E, odd ? O_QM : E_QM, MIX, (const bf16*)(C.ws + WS_MEMK) + (size_t)l * 1024 * 512, (const bf16*)(C.ws + WS_MEMVT) + (size_t)l * 512 * 1024, b, hh, tb); }
#endif
#else
            const int nscan = odd ? 128 : 64;
#endif
            if (gw < nscan) { if (TEST_MASK & 4) { if (odd) naive_scan_item<1>(C, args.in[5], args.in[10], args.in[11], l, gw, wscr); else naive_scan_item<0>(C, args.in[5], args.in[10], args.in[11], l, gw, wscr); } }
            else {
                const int w2 = gw - nscan, NW2 = NGW - nscan;
                const int nA = (odd || USE_MFMA_ATTN) ? 0 : M * 8, nM = USE_MFMA_ATTN ? 0 : M * 4, nW = (l + 1 < DEPTH) ? win_items(l + 1) : 0;
                for (int it = w2; it < nA + nM + nW; it += NW2) {
                    if (it < nA) naive_winattn_item(C, args.in[4] + li * 8, it, wscr);
                    else if (it < nA + nM) naive_memattn_item(C, l, it - nA, wscr);
                    else win_item(C, args.in[3], args.in[9], l + 1, it - nA - nM, wscr);
                }
            }
        PHASE_END
        PHASE_BEGIN
#if USE_MFMA_SCAN
            { scan::ScanPtrs sp{P, MIX, (bf16*)(C.ws + (odd ? WS_L_O : WS_L_E)), (float*)(C.ws + WS_LOGD), (bf16*)(C.ws + (odd ? WS_OG_O : WS_OG_E)), args.in[5], args.in[10], args.in[11], odd ? args.in[12] : args.in[6]};
              if (odd) scan::scan_combine<1>(C, sp); else scan::scan_combine<0>(C, sp); }
#else
            for (int it = gw; it < M * 4; it += NGW) { if (odd) naive_gnorm_item<1>(C, args.in[12], l, it); else naive_gnorm_item<0>(C, args.in[6], l, it); }
#endif
        PHASE_END
        PHASE_BEGIN
#if USE_MFMA_SCAN
            { scan::ScanPtrs sp{P, MIX, (bf16*)(C.ws + (odd ? WS_L_O : WS_L_E)), (float*)(C.ws + WS_LOGD), (bf16*)(C.ws + (odd ? WS_OG_O : WS_OG_E)), args.in[5], args.in[10], args.in[11], odd ? args.in[12] : args.in[6]};
              const int NHG = odd ? 4 : 2, NSC = odd ? 16 : 32;
              for (int it = C.bid; it < BATCH * NHG * NSC; it += C.G) { const int sc = it % NSC, hg = (it / NSC) % NHG, b = it / (NSC * NHG);
                  if (odd) scan::scan_item2<1, 1>(C, sp, li, b, hg, sc, 0); else scan::scan_item2<0, 1>(C, sp, li, b, hg, sc, 0); } }
#endif
        PHASE_END
        PHASE_BEGIN
#if USE_PG8
            pg8::Gemm g{MIX, (const bf16*)(C.ws + WS_WOUT) + (size_t)l * 1024 * 1536, M, 1024, 1536}; pg8::StaticOrder S; S.init(M, 1024, C.G, C.bid);
            pg8::EpiResidF32 e{l == 0 ? args.in[0] : C.out, C.out};
            pg8::gemm_phase<pg8::EpiResidF32, pg8::StaticOrder, false, true>(C.lds, g, S, e);
#else
            EpiResid e{l == 0 ? args.in[0] : C.out, C.out};
            gemm_naive(C, MIX, NMIX, (const bf16*)(C.ws + WS_WOUT) + (size_t)l * 1024 * 1536, 1536, M, 1024, 1536, C.bid, C.G, e);
#endif
        PHASE_END
        PHASE_BEGIN
            if (!(TEST_MASK & 32)) {} else if (l + 1 < DEPTH) { const float* g = ((l + 1) & 1) ? args.in[8] + ((l + 1) >> 1) * D : args.in[2] + ((l + 1) >> 1) * D;
                for (int r = gw; r < M; r += NGW) rms_row_to_bf16(C.out + (size_t)r * D, g, HN + (size_t)r * D, C.lane); }
            else { for (int r = gw; r < M; r += NGW) rms_row_to_f32(C.out + (size_t)r * D, args.in[16], C.out + (size_t)r * D, C.lane); }
        PHASE_END
    }
#undef PHASE_BEGIN
#undef PHASE_END
}

extern "C" void kernel_launch(void* const* d_in, const int* in_sizes, int n_in, void* d_out, int out_size, void* d_ws, size_t ws_size, hipStream_t stream) {
    static int grid = 0;
    if (grid == 0) {
        if (n_in != 17 || out_size != M * D || ws_size < WS_END) { fprintf(stderr, "kernel_launch: unexpected shapes n_in %d out %d ws %zu\n", n_in, out_size, ws_size); grid = -1; return; }
        int dev = 0, cus = 0, per_cu = 0;
        if (hipGetDevice(&dev) != hipSuccess || hipDeviceGetAttribute(&cus, hipDeviceAttributeMultiprocessorCount, dev) != hipSuccess) { grid = -1; return; }
        if (hipFuncSetAttribute((const void*)mk_fwd, hipFuncAttributeMaxDynamicSharedMemorySize, LDS_BYTES) != hipSuccess) { fprintf(stderr, "kernel_launch: hipFuncSetAttribute failed\n"); grid = -1; return; }
        if (hipOccupancyMaxActiveBlocksPerMultiprocessor(&per_cu, (const void*)mk_fwd, NTHR, LDS_BYTES) != hipSuccess || per_cu < 1)
            fprintf(stderr, "kernel_launch: occupancy query reports %d blocks per CU\n", per_cu);
        (void)hipGetLastError();
        grid = cus;
    }
    if (grid < 0) return;
    if (hipMemsetAsync((char*)d_ws + WS_CTL, 0, CTL_ZERO_BYTES, stream) != hipSuccess) return;
    Args a{};
    for (int i = 0; i < 17; ++i) a.in[i] = (const float*)d_in[i];
    a.out = (float*)d_out; a.ws = (unsigned char*)d_ws;
#if MK_ONE_LAUNCH
    a.ph_lo = 0; a.ph_hi = NSTEPS;
    hipLaunchKernelGGL(mk_fwd, dim3(grid), dim3(NTHR), LDS_BYTES, stream, a);
#else
    for (int s = 0; s < NSTEPS; ++s) { a.ph_lo = s; a.ph_hi = s + 1; hipLaunchKernelGGL(mk_fwd, dim3(grid), dim3(NTHR), LDS_BYTES, stream, a); }
#endif
}
```

```cpp
#include <hip/hip_runtime.h>
#include <cstdio>
#include <cstdint>

#ifndef TEST_MASK
#define TEST_MASK 0xFFFF
#endif
#ifndef USE_MFMA_ATTN
#define USE_MFMA_ATTN 1
#endif
#ifndef USE_MFMA_SCAN
#define USE_MFMA_SCAN 1
#endif
#ifndef USE_PG8
#define USE_PG8 1
#endif
#ifndef MK_ONE_LAUNCH
#define MK_ONE_LAUNCH 1
#endif

#define GAS __attribute__((address_space(1)))
#define LAS __attribute__((address_space(3)))
typedef unsigned short bf16;
typedef unsigned v4u __attribute__((ext_vector_type(4)));
typedef unsigned v2u __attribute__((ext_vector_type(2)));
typedef float f32x4 __attribute__((ext_vector_type(4)));
typedef GAS unsigned gu32;
#define RLX_AGENT __ATOMIC_RELAXED, __HIP_MEMORY_SCOPE_AGENT
#define LDS_WAIT() asm volatile("s_waitcnt lgkmcnt(0)" ::: "memory")
#define VM_WAIT() asm volatile("s_waitcnt vmcnt(0)" ::: "memory")

constexpr int NWAVES = 8, NTHR = 512;
constexpr int BATCH = 4, T = 4096, D = 1024, M = BATCH * T, DEPTH = 4;
constexpr int NMEM = 256;
constexpr int NP_E = 3328, NP_O = 2816, NMIX = 1536, NIN_E = 4864, NIN_O = 4352, NIN_O_SRC = 4128;
constexpr int E_QA = 0, E_KA = 512, E_VA = 640, E_QB = 768, E_ZF = 1280, E_ZB = 1792, E_IB = 2304, E_QM = 2816;
constexpr int O_QC = 0, O_KC = 512, O_VC = 1024, O_QM = 2048, O_RF = 2560, O_RB = 2576;
constexpr int X_GA = 0, X_GB = 512, X_GM = 1024, X_GC = 0;
constexpr float EPS = 1e-6f;

constexpr size_t MiB = 1u << 20;
constexpr size_t WS_CTL = 0, CTL_ZERO_BYTES = 1 * MiB;
constexpr size_t WS_WIN = 2 * MiB;
constexpr size_t WS_WOUT = 12 * MiB;
constexpr size_t WS_WKV = 24 * MiB;
constexpr size_t WS_MEMK = 32 * MiB;
constexpr size_t WS_MEMVT = 36 * MiB;
constexpr size_t WS_MEMN = 40 * MiB;
constexpr size_t WS_MIX = 43 * MiB;
constexpr size_t WS_P = 91 * MiB;
constexpr size_t WS_HN = 195 * MiB;
constexpr size_t WS_OE = 195 * MiB;
constexpr size_t WS_OO = 192 * MiB;
constexpr size_t WS_L_E = 195 * MiB, WS_OG_E = 227 * MiB;
constexpr size_t WS_L_O = 179 * MiB, WS_OG_O = 211 * MiB;
constexpr size_t WS_LOGD = 243 * MiB;
constexpr size_t WS_END = 256 * MiB;

constexpr int CW_BAR = 4096;

__device__ __forceinline__ float bf2f(bf16 v) { return __uint_as_float(((unsigned)v) << 16); }
__device__ __forceinline__ unsigned f2bf(float f) { unsigned u = __float_as_uint(f); return (u + 0x7fffu + ((u >> 16) & 1u)) >> 16; }
__device__ __forceinline__ unsigned pk2(float lo, float hi) { return f2bf(lo) | (f2bf(hi) << 16); }
__device__ __forceinline__ float wave_sum(float v) {
#pragma unroll
    for (int o = 1; o < 64; o <<= 1) v += __shfl_xor(v, o);
    return v;
}
__device__ __forceinline__ float wave_max(float v) {
#pragma unroll
    for (int o = 1; o < 64; o <<= 1) v = fmaxf(v, __shfl_xor(v, o));
    return v;
}
__device__ __forceinline__ float sigmoidf_(float z) { return __builtin_amdgcn_rcpf(1.f + __expf(-z)); }
__device__ __forceinline__ float siluf_(float z) { return z * __builtin_amdgcn_rcpf(1.f + __expf(-z)); }

#define XB_TMO      128
#define XB_XCNT(j)  (256  + 64 * (j))
#define XB_XSUB(j)  (1280 + 64 * (j))
#define XB_XGEN(j)  (2304 + 64 * (j))
#define XB_TOP      3328
#define XB_TOPGEN   3392
#define XCD_BAR_WORDS 3456
#define XB_SPIN_CAP (1u << 22)
__device__ __forceinline__ unsigned xb_ld(unsigned* p)              { return __hip_atomic_load(p, __ATOMIC_RELAXED, __HIP_MEMORY_SCOPE_AGENT); }
__device__ __forceinline__ unsigned xb_add(unsigned* p, unsigned v) { return __hip_atomic_fetch_add(p, v, __ATOMIC_RELAXED, __HIP_MEMORY_SCOPE_AGENT); }
__device__ __forceinline__ unsigned xb_xcc_id() { return (unsigned)__builtin_amdgcn_s_getreg((3 << 11) | 20) & 0xFu; }
#define XB_SPIN(cond, bar) do { unsigned _sp = 0; while (cond) { __builtin_amdgcn_s_sleep(1); \
    if ((++_sp & 255u) == 0u) { if (xb_ld(&(bar)[XB_TMO])) break; if (_sp > XB_SPIN_CAP) { atomicAdd(&(bar)[XB_TMO], 1u); break; } } } } while (0)
struct XcdBarrier { unsigned* bar; unsigned x; volatile LAS unsigned* st; };
__device__ __forceinline__ XcdBarrier xcd_barrier_post(unsigned* bar, volatile LAS unsigned* st) {
    XcdBarrier b; b.bar = bar; b.x = xb_xcc_id(); b.st = st;
    if (threadIdx.x == 0) (void)xb_add(&bar[XB_XCNT(b.x)], 1u);
    return b;
}
__device__ __forceinline__ void xcd_barrier_complete(unsigned* bar, unsigned x, unsigned& nloc, unsigned& nx) {
    const unsigned G = gridDim.x * gridDim.y * gridDim.z;
    unsigned sum, cnt, mine, sp = 0u;
    for (;;) {
        sum = 0u; cnt = 0u; mine = 0u;
#pragma unroll
        for (unsigned j = 0; j < 16; ++j) { const unsigned c = xb_ld(&bar[XB_XCNT(j)]); sum += c; cnt += (c > 0u) ? 1u : 0u; mine = (j == x) ? c : mine; }
        if (sum == G) break;
        __builtin_amdgcn_s_sleep(1);
        if ((++sp & 255u) == 0u) { if (xb_ld(&bar[XB_TMO])) break; if (sp > XB_SPIN_CAP) { atomicAdd(&bar[XB_TMO], 1u); break; } }
    }
    nloc = mine > 0u ? mine : 1u; nx = cnt > 0u ? cnt : 1u;
}
__device__ __forceinline__ void xcd_barrier(const XcdBarrier& b) {
    asm volatile("s_waitcnt vmcnt(0)" ::: "memory");
    __syncthreads();
    if (threadIdx.x == 0) {
        unsigned* bar = b.bar; unsigned bx = b.x; asm volatile("" : "+s"(bar), "+s"(bx));
        __builtin_amdgcn_s_waitcnt(0);
        unsigned nloc = b.st[0], nx = b.st[1];
        if (nloc == 0u) { xcd_barrier_complete(bar, bx, nloc, nx); b.st[0] = nloc; b.st[1] = nx; }
        const unsigned old = xb_add(&bar[XB_XSUB(bx)], 1u);
        const unsigned gen = old / nloc;
        if (old + 1u == (gen + 1u) * nloc) {
            __builtin_amdgcn_fence(__ATOMIC_RELEASE, "agent");
            asm volatile("s_waitcnt vmcnt(0)" ::: "memory");
            const unsigned og = xb_add(&bar[XB_TOP], 1u);
            const unsigned tg = og / nx;
            if (og + 1u == (tg + 1u) * nx) xb_add(&bar[XB_TOPGEN], 1u);
            else XB_SPIN(xb_ld(&bar[XB_TOPGEN]) == tg, bar);
            __builtin_amdgcn_fence(__ATOMIC_ACQUIRE, "agent");
            xb_add(&bar[XB_XGEN(bx)], 1u);
            asm volatile("s_waitcnt vmcnt(0)" ::: "memory");
        } else {
            XB_SPIN(xb_ld(&bar[XB_XGEN(bx)]) == gen, bar);
            __builtin_amdgcn_fence(__ATOMIC_ACQUIRE, "agent");
            asm volatile("s_waitcnt vmcnt(0)" ::: "memory");
        }
    }
    __syncthreads();
}

constexpr int RING_BYTES = 157696;
constexpr int MISC_OFF = RING_BYTES + 320;
constexpr int LDS_BYTES = 161792;

struct Args { const float* in[17]; float* out; unsigned char* ws; int ph_lo, ph_hi; };
static_assert(sizeof(Args) == 17 * 8 + 8 + 8 + 8, "Args has no padding");

struct Ctx {
    LAS unsigned char* lds;
    int tid, lane, wave, G, bid;
    float* out; unsigned char* ws;
};

__device__ __forceinline__ void transpose_item(const float* W, int K, int N, bf16* WT, int k0, int n0, int drow0, LAS float* scr, int lane) {
    asm volatile("" : "+v"(lane));
#pragma unroll 8
    for (int i = 0; i < 32; ++i) { const int kk = 2 * i + (lane >> 5); scr[kk * 33 + (lane & 31)] = W[(size_t)(k0 + kk) * N + n0 + (lane & 31)]; }
    LDS_WAIT(); asm volatile("" ::: "memory");
    const int c = lane & 7;
#pragma unroll
    for (int j = 0; j < 4; ++j) { const int n = (lane >> 3) + 8 * j; const LAS float* s = scr + (8 * c) * 33 + n;
        v4u o; o.x = pk2(s[0 * 33], s[1 * 33]); o.y = pk2(s[2 * 33], s[3 * 33]); o.z = pk2(s[4 * 33], s[5 * 33]); o.w = pk2(s[6 * 33], s[7 * 33]);
        *(GAS v4u*)(WT + (size_t)(drow0 + n) * K + k0 + 8 * c) = o; }
    LDS_WAIT(); asm volatile("" ::: "memory");
}
__device__ __forceinline__ int map_even(int n0) {
    if (n0 < 768) return n0;
    if (n0 < 1280) return NP_E + X_GA + (n0 - 768);
    if (n0 < 3328) return E_QB + (n0 - 1280);
    if (n0 < 3840) return NP_E + X_GB + (n0 - 3328);
    if (n0 < 4352) return E_QM + (n0 - 3840);
    return NP_E + X_GM + (n0 - 4352);
}
__device__ __forceinline__ int map_odd(int n0) {
    if (n0 < 2048) return n0;
    if (n0 < 3072) return NP_O + X_GC + (n0 - 2048);
    if (n0 < 3104) return O_RF + (n0 - 3072);
    if (n0 < 3616) return O_QM + (n0 - 3104);
    return NP_O + X_GM + (n0 - 3616);
}
__device__ __forceinline__ int win_items(int l) { return (l & 1) ? (16 * (NIN_O_SRC / 32) + 224) : (16 * (NIN_E / 32)); }
__device__ __forceinline__ void win_item(const Ctx& C, const float* w_even, const float* w_odd, int l, int it, LAS float* scr) {
    bf16* WT = (bf16*)(C.ws + WS_WIN);
    if (l & 1) {
        const int nconv = 16 * (NIN_O_SRC / 32);
        if (it < nconv) { const int nb = it % (NIN_O_SRC / 32), kb = it / (NIN_O_SRC / 32);
            transpose_item(w_odd + (size_t)(l >> 1) * D * NIN_O_SRC, D, NIN_O_SRC, WT, kb * 64, nb * 32, map_odd(nb * 32), scr, C.lane); }
        else { const int r = 2592 + (it - nconv);
            GAS v4u* p = (GAS v4u*)(WT + (size_t)r * D); v4u z = {0u, 0u, 0u, 0u}; p[C.lane] = z; p[C.lane + 64] = z; }
    } else {
        const int nb = it % (NIN_E / 32), kb = it / (NIN_E / 32);
        transpose_item(w_even + (size_t)(l >> 1) * D * NIN_E, D, NIN_E, WT, kb * 64, nb * 32, map_even(nb * 32), scr, C.lane);
    }
}
__device__ __forceinline__ void rms_row_to_bf16(const float* xrow, const float* g, bf16* orow, int lane) {
    asm volatile("" : "+v"(lane));
    const GAS f32x4* xr = (const GAS f32x4*)xrow + lane; const GAS f32x4* gr = (const GAS f32x4*)g + lane;
    f32x4 v[4]; float s = 0.f;
#pragma unroll
    for (int j = 0; j < 4; ++j) { v[j] = xr[64 * j]; s += (v[j].x * v[j].x + v[j].y * v[j].y) + (v[j].z * v[j].z + v[j].w * v[j].w); }
    const float rstd = 1.f / sqrtf(wave_sum(s) * (1.f / D) + EPS);
    GAS unsigned long long* o8 = (GAS unsigned long long*)orow + lane;
#pragma unroll
    for (int j = 0; j < 4; ++j) { const f32x4 gg = gr[64 * j];
        o8[64 * j] = (unsigned long long)pk2(v[j].x * rstd * gg.x, v[j].y * rstd * gg.y) | ((unsigned long long)pk2(v[j].z * rstd * gg.z, v[j].w * rstd * gg.w) << 32); }
}
__device__ __forceinline__ void rms_row_to_f32(const float* xrow, const float* g, float* orow, int lane) {
    asm volatile("" : "+v"(lane));
    const GAS f32x4* xr = (const GAS f32x4*)xrow + lane; const GAS f32x4* gr = (const GAS f32x4*)g + lane;
    f32x4 v[4]; float s = 0.f;
#pragma unroll
    for (int j = 0; j < 4; ++j) { v[j] = xr[64 * j]; s += (v[j].x * v[j].x + v[j].y * v[j].y) + (v[j].z * v[j].z + v[j].w * v[j].w); }
    const float rstd = 1.f / sqrtf(wave_sum(s) * (1.f / D) + EPS);
    GAS f32x4* o = (GAS f32x4*)orow + lane;
#pragma unroll
    for (int j = 0; j < 4; ++j) { const f32x4 gg = gr[64 * j]; o[64 * j] = v[j] * rstd * gg; }
}

__device__ __forceinline__ void phase_prep(const Ctx& C, const Args& A) {
    LAS float* scr = (LAS float*)(C.lds + C.wave * 16384);
    const int gw = C.bid * NWAVES + C.wave, NGW = C.G * NWAVES;
    constexpr int I_OUT = (1536 / 64) * (1024 / 32), I_KV = (1024 / 64) * (1024 / 32);
    const int I_IN = win_items(0);
    const int total = 4 * I_OUT + 4 * I_KV + I_IN + 1024 + M;
    for (int it = gw; it < total; it += NGW) {
        int r = it;
        if (r < 4 * I_OUT) { const int l = r / I_OUT; r -= l * I_OUT; const int nb = r % 32, kb = r / 32;
            const float* W = (l & 1) ? A.in[13] + (size_t)(l >> 1) * 1536 * 1024 : A.in[7] + (size_t)(l >> 1) * 1536 * 1024;
            transpose_item(W, 1536, 1024, (bf16*)(C.ws + WS_WOUT) + (size_t)l * 1024 * 1536, kb * 64, nb * 32, nb * 32, scr, C.lane); continue; }
        r -= 4 * I_OUT;
        if (r < 4 * I_KV) { const int l = r / I_KV; r -= l * I_KV; const int nb = r % 32, kb = r / 32;
            transpose_item(A.in[15] + (size_t)l * 1024 * 1024, 1024, 1024, (bf16*)(C.ws + WS_WKV) + (size_t)l * 1024 * 1024, kb * 64, nb * 32, nb * 32, scr, C.lane); continue; }
        r -= 4 * I_KV;
        if (r < I_IN) { win_item(C, A.in[3], A.in[9], 0, r, scr); continue; }
        r -= I_IN;
        if (r < 1024) { rms_row_to_bf16(A.in[1] + (size_t)r * D, A.in[14], (bf16*)(C.ws + WS_MEMN) + (size_t)r * D, C.lane); continue; }
        r -= 1024;
        rms_row_to_bf16(A.in[0] + (size_t)r * D, A.in[2], (bf16*)(C.ws + WS_HN) + (size_t)r * D, C.lane);
    }
}

namespace pg8 {
#define PG8_LAS __attribute__((address_space(3)))
typedef unsigned short bf16_t;
typedef short bf16x8 __attribute__((ext_vector_type(8)));
typedef float f32x4 __attribute__((ext_vector_type(4)));
typedef unsigned u32x4 __attribute__((ext_vector_type(4)));
constexpr int BM = 256, BK = 64, HALF = 128, HTB = HALF * BK * 2  , STAGE_BYTES = 8 * HTB, NXCD = 8, WGM = 8;

__host__ __device__ __forceinline__ int lds_byte(int r, int c) { const int st = (r >> 4) * 2 + (c >> 5), rr = r & 15, cc = c & 31, ob = rr * 64 + cc * 2; return st * 1024 + (ob ^ (((ob >> 9) & 1) << 5)); }
__host__ __device__ __forceinline__ void stage_rc(int b, int& R, int& C) { const int st = b / 1024, sb = b % 1024, swz = sb ^ (((sb >> 9) & 1) << 5); R = (st >> 1) * 16 + swz / 64; C = (st & 1) * 32 + (swz % 64) / 2; }
__host__ __device__ __forceinline__ int perm32(int rho) { const int n = rho >> 4, i = rho & 15; return 8 * (i >> 2) + 4 * n + (i & 3); }

struct Unit { int pm, pn; };
struct Gemm { const bf16_t* A; const bf16_t* Bt; int M, N, K; };

struct StaticOrder {
    int nM, nN, nwg, G, c;
    __host__ __device__ void init(int M, int N, int G_, int c_) { nM = M / BM; nN = N / BM; nwg = nM * nN; G = G_; c = c_; }
    __host__ __device__ bool next(int i, Unit& u) const {
        const long L = (long)i * G + c; if (L >= nwg) return false;
        int wgid = (int)L; { const int q = nwg / NXCD, r = nwg % NXCD, xcd = wgid % NXCD, off = wgid / NXCD; wgid = (xcd < r ? xcd * (q + 1) : r * (q + 1) + (xcd - r) * q) + off; }
        const int nig = WGM * nN, gid = wgid / nig, fm = gid * WGM, gsz = (nM - fm) < WGM ? (nM - fm) : WGM;
        u.pm = fm + ((wgid % nig) % gsz); u.pn = (wgid % nig) / gsz; return true;
    }
    __device__ __forceinline__ void a_ready(const Unit&) const {}
    __device__ __forceinline__ void done(const Unit&) const {}
};

__device__ __forceinline__ unsigned cvt_pk_bf16(float lo, float hi) { unsigned r; asm volatile("v_cvt_pk_bf16_f32 %0, %1, %2" : "=v"(r) : "v"(lo), "v"(hi)); return r; }

template <class Epi, class Sched, bool ALIGN_EPI = false, bool SP2 = false>
__device__ __forceinline__ void gemm_phase(PG8_LAS unsigned char* lds, const Gemm g, const Sched& S, const Epi& E) {
    int tid = threadIdx.x; asm volatile("" : "+v"(tid));
    const int wid = __builtin_amdgcn_readfirstlane(tid >> 6), lane = tid & 63, wr = wid >> 2, wc = wid & 3, fr = lane & 15, fq = lane >> 4;
    const int K = g.K, nt = K / BK;
    unsigned voffA[2], voffB[2];
#pragma unroll
    for (int i = 0; i < 2; ++i) { int R, C; stage_rc(tid * 16 + i * 8192, R, C); const int Rb = Epi::PERM ? ((R & ~31) + perm32(R & 31)) : R;
        voffA[i] = (unsigned)(R * K + C) * 2u; voffB[i] = (unsigned)(Rb * K + C) * 2u; }
    const size_t kstep = (size_t)(BK * 2);
    const size_t hstep = (size_t)HALF * K * 2;
    const size_t tstep = 2 * hstep;
    const unsigned ldsw = (unsigned)wid * 1024u;
    const int aoff = lds_byte(wr * 64 + fr, fq * 8), boff = lds_byte(wc * 32 + fr, fq * 8);
#define PG8_SA(b, h) (((b) * 2 + (h)) * HTB)
#define PG8_SB(b, h) ((4 + (b) * 2 + (h)) * HTB)
#define PG8_STAGE(bufoff, gbase, voff) do { _Pragma("unroll") for (int _i = 0; _i < 2; ++_i) \
        __builtin_amdgcn_global_load_lds((const unsigned*)((const char*)(gbase) + (voff)[_i]), (PG8_LAS unsigned*)(lds + (bufoff) + ldsw + _i * 8192), 16, 0, 0); } while (0)
#define PG8_LDA(dst, b, h) do { _Pragma("unroll") for (int m = 0; m < 4; ++m) _Pragma("unroll") for (int k = 0; k < 2; ++k) dst[m][k] = *(const PG8_LAS bf16x8*)(lds + PG8_SA(b, h) + aoff + m * 2048 + k * 1024); } while (0)
#define PG8_LDB(dst, b, h) do { _Pragma("unroll") for (int n = 0; n < 2; ++n) _Pragma("unroll") for (int k = 0; k < 2; ++k) dst[n][k] = *(const PG8_LAS bf16x8*)(lds + PG8_SB(b, h) + boff + n * 2048 + k * 1024); } while (0)
#define PG8_MMA(ai, bj, At, Bt) do { __builtin_amdgcn_s_setprio(1); _Pragma("unroll") for (int m = 0; m < 4; ++m) _Pragma("unroll") for (int n = 0; n < 2; ++n) _Pragma("unroll") for (int k = 0; k < 2; ++k) \
        acc[ai][bj][m][n] = __builtin_amdgcn_mfma_f32_16x16x32_bf16(Bt[n][k], At[m][k], acc[ai][bj][m][n], 0, 0, 0); __builtin_amdgcn_s_setprio(0); } while (0)
#define PG8_WAIT_V(n) asm volatile("s_waitcnt vmcnt(" #n ")" ::: "memory")
#define PG8_WAIT_L(n) asm volatile("s_waitcnt lgkmcnt(" #n ")" ::: "memory")
#define PG8_BAR __builtin_amdgcn_s_barrier()
#define PG8_SCHED __builtin_amdgcn_sched_barrier(0)
    Unit cur, nxt; int ui = 0;
    if (!S.next(0, cur)) return;
    f32x4 acc[2][2][4][2];
#pragma unroll
    for (int a = 0; a < 2; ++a)
#pragma unroll
        for (int b = 0; b < 2; ++b)
#pragma unroll
            for (int m = 0; m < 4; ++m)
#pragma unroll
                for (int n = 0; n < 2; ++n) acc[a][b][m][n] = (f32x4){0.f, 0.f, 0.f, 0.f};
    bf16x8 At[4][2], B0[2][2], B1[2][2];
    const char* cA = (const char*)g.A + (size_t)cur.pm * tstep; const char* cB = (const char*)g.Bt + (size_t)cur.pn * tstep;
    S.a_ready(cur);
    if constexpr (SP2) {
        PG8_STAGE(PG8_SB(0, 0), cB, voffB); PG8_STAGE(PG8_SB(0, 1), cB + hstep, voffB); PG8_STAGE(PG8_SA(0, 0), cA, voffA); PG8_STAGE(PG8_SA(0, 1), cA + hstep, voffA);
        if (wr == 1) PG8_BAR;
        PG8_WAIT_V(2); PG8_BAR;
        PG8_STAGE(PG8_SB(1, 0), cB + kstep, voffB); PG8_STAGE(PG8_SA(1, 0), cA + kstep, voffA); PG8_STAGE(PG8_SB(1, 1), cB + hstep + kstep, voffB);
        PG8_WAIT_V(6); PG8_BAR;
    } else {
        PG8_STAGE(PG8_SB(0, 0), cB, voffB); PG8_STAGE(PG8_SA(0, 0), cA, voffA); PG8_STAGE(PG8_SB(0, 1), cB + hstep, voffB); PG8_STAGE(PG8_SA(0, 1), cA + hstep, voffA);
        if (wr == 1) PG8_BAR;
        PG8_WAIT_V(4); PG8_BAR;
        PG8_STAGE(PG8_SB(1, 0), cB + kstep, voffB); PG8_STAGE(PG8_SA(1, 0), cA + kstep, voffA); PG8_STAGE(PG8_SB(1, 1), cB + hstep + kstep, voffB);
        PG8_WAIT_V(6); PG8_BAR;
    }
    for (;;) {
        const bool has_next = S.next(ui + 1, nxt);
        const char* nA = has_next ? (const char*)g.A + (size_t)nxt.pm * tstep : cA; const char* nB = has_next ? (const char*)g.Bt + (size_t)nxt.pn * tstep : cB;
        for (int t = 0; t < nt; t += 2) {
            const bool last = (t == nt - 2);
            const char* a1 = cA + (size_t)(t + 1) * kstep;
            const char* a2 = last ? nA : cA + (size_t)(t + 2) * kstep; const char* b2 = last ? nB : cB + (size_t)(t + 2) * kstep;
            const char* a3 = a2 + kstep; const char* b3 = b2 + kstep;
            if (last && has_next) S.a_ready(nxt);
            if constexpr (SP2) {
            PG8_LDB(B0, 0, 0); PG8_LDB(B1, 0, 1); PG8_SCHED; PG8_LDA(At, 0, 0); PG8_STAGE(PG8_SA(1, 1), a1 + hstep, voffA);
            PG8_WAIT_V(8); PG8_WAIT_L(0); PG8_BAR; PG8_MMA(0, 0, At, B0); PG8_MMA(0, 1, At, B1); PG8_BAR; PG8_SCHED;
            PG8_LDA(At, 0, 1); PG8_STAGE(PG8_SB(0, 0), b2, voffB); PG8_STAGE(PG8_SB(0, 1), b2 + hstep, voffB); PG8_STAGE(PG8_SA(0, 0), a2, voffA);
            PG8_WAIT_V(8); PG8_WAIT_L(0); PG8_BAR; PG8_MMA(1, 0, At, B0); PG8_MMA(1, 1, At, B1); PG8_BAR; PG8_SCHED;
            PG8_LDB(B0, 1, 0); PG8_LDB(B1, 1, 1); PG8_SCHED; PG8_LDA(At, 1, 0); PG8_STAGE(PG8_SA(0, 1), a2 + hstep, voffA);
            PG8_WAIT_V(8); PG8_WAIT_L(0); PG8_BAR; PG8_MMA(0, 0, At, B0); PG8_MMA(0, 1, At, B1); PG8_BAR; PG8_SCHED;
            PG8_LDA(At, 1, 1); PG8_STAGE(PG8_SB(1, 0), b3, voffB); PG8_STAGE(PG8_SB(1, 1), b3 + hstep, voffB); PG8_STAGE(PG8_SA(1, 0), a3, voffA);
            PG8_WAIT_V(8); PG8_WAIT_L(0); PG8_BAR; PG8_MMA(1, 0, At, B0); PG8_MMA(1, 1, At, B1); PG8_BAR; PG8_SCHED;
            } else {
            PG8_LDB(B0, 0, 0); PG8_SCHED; PG8_LDA(At, 0, 0); PG8_STAGE(PG8_SA(1, 1), a1 + hstep, voffA);
            PG8_WAIT_L(8); PG8_BAR; PG8_WAIT_L(0); PG8_MMA(0, 0, At, B0); PG8_BAR; PG8_SCHED;
            PG8_LDB(B1, 0, 1); PG8_STAGE(PG8_SB(0, 0), b2, voffB);
            PG8_BAR; PG8_WAIT_L(0); PG8_MMA(0, 1, At, B1); PG8_BAR;
            PG8_LDA(At, 0, 1); PG8_STAGE(PG8_SA(0, 0), a2, voffA);
            PG8_BAR; PG8_WAIT_L(0); PG8_MMA(1, 0, At, B0); PG8_BAR; PG8_SCHED;
            PG8_STAGE(PG8_SB(0, 1), b2 + hstep, voffB);
            PG8_WAIT_V(6); PG8_BAR; PG8_MMA(1, 1, At, B1); PG8_BAR;
            PG8_LDB(B0, 1, 0); PG8_SCHED; PG8_LDA(At, 1, 0); PG8_STAGE(PG8_SA(0, 1), a2 + hstep, voffA);
            PG8_WAIT_L(8); PG8_BAR; PG8_WAIT_L(0); PG8_MMA(0, 0, At, B0); PG8_BAR; PG8_SCHED;
            PG8_LDB(B1, 1, 1); PG8_STAGE(PG8_SB(1, 0), b3, voffB);
            PG8_BAR; PG8_WAIT_L(0); PG8_MMA(0, 1, At, B1); PG8_BAR;
            PG8_LDA(At, 1, 1); PG8_STAGE(PG8_SA(1, 0), a3, voffA);
            PG8_BAR; PG8_WAIT_L(0); PG8_MMA(1, 0, At, B0); PG8_BAR; PG8_SCHED;
            PG8_STAGE(PG8_SB(1, 1), b3 + hstep, voffB);
            PG8_WAIT_V(6); PG8_BAR; PG8_MMA(1, 1, At, B1); PG8_BAR;
            }
        }
        if constexpr (ALIGN_EPI) { if (wr == 0) PG8_BAR; }
        if constexpr (!Epi::AFTER_DRAIN) { E(acc, cur, wr, wc, fr, fq); S.done(cur); }
        if (!has_next) break;
#pragma unroll
        for (int a = 0; a < 2; ++a)
#pragma unroll
            for (int b = 0; b < 2; ++b)
#pragma unroll
                for (int m = 0; m < 4; ++m)
#pragma unroll
                    for (int n = 0; n < 2; ++n) acc[a][b][m][n] = (f32x4){0.f, 0.f, 0.f, 0.f};
        cur = nxt; cA = nA; cB = nB; ++ui;
        if constexpr (ALIGN_EPI) { if (wr == 1) PG8_BAR; }
    }
    PG8_WAIT_V(0);
    if constexpr (!ALIGN_EPI) { if (wr == 0) PG8_BAR; }
    PG8_BAR;
    if constexpr (Epi::AFTER_DRAIN) { E.fused(acc, cur, wr, wc, fr, fq, lds, wid, lane); S.done(cur); }
#undef PG8_SA
#undef PG8_SB
#undef PG8_STAGE
#undef PG8_LDA
#undef PG8_LDB
#undef PG8_MMA
#undef PG8_WAIT_V
#undef PG8_WAIT_L
#undef PG8_BAR
#undef PG8_SCHED
}

struct EpiProj {
    static constexpr bool PERM = true, AFTER_DRAIN = false;
    bf16_t* P; bf16_t* MIXp; int np_cols; int npt;
    __device__ __forceinline__ void operator()(const f32x4 (&acc)[2][2][4][2], const Unit& u, int wr, int wc, int fr, int fq) const {
        const int row0 = u.pm * BM + wr * 64 + fr;
        bf16_t* base; int ldc, colt;
        if (u.pn < npt) { base = P; ldc = np_cols; colt = u.pn * BM; } else { base = MIXp; ldc = 1536; colt = (u.pn - npt) * BM; }
        const int col0 = colt + wc * 32 + 8 * fq;
#pragma unroll
        for (int ai = 0; ai < 2; ++ai)
#pragma unroll
            for (int m = 0; m < 4; ++m) { bf16_t* rowp = base + (size_t)(row0 + ai * HALF + m * 16) * ldc + col0;
#pragma unroll
                for (int bj = 0; bj < 2; ++bj) { const f32x4 v0 = acc[ai][bj][m][0], v1 = acc[ai][bj][m][1];
                    u32x4 w; w.x = cvt_pk_bf16(v0[0], v0[1]); w.y = cvt_pk_bf16(v0[2], v0[3]); w.z = cvt_pk_bf16(v1[0], v1[1]); w.w = cvt_pk_bf16(v1[2], v1[3]);
                    *(u32x4*)(rowp + bj * HALF) = w; } }
    }
};
struct EpiResidF32 {
    static constexpr bool PERM = false, AFTER_DRAIN = false;
    const float* xi; float* xo;
    __device__ __forceinline__ void operator()(const f32x4 (&acc)[2][2][4][2], const Unit& u, int wr, int wc, int fr, int fq) const {
        const int col0 = u.pn * BM + wc * 32 + 4 * fq;
#pragma unroll
        for (int ai = 0; ai < 2; ++ai)
#pragma unroll
            for (int m = 0; m < 4; ++m) { const size_t off = (size_t)(u.pm * BM + ai * HALF + wr * 64 + m * 16 + fr) * 1024 + col0;
#pragma unroll
                for (int bj = 0; bj < 2; ++bj)
#pragma unroll
                    for (int n = 0; n < 2; ++n) { const f32x4 b = *(const f32x4*)(xi + off + bj * HALF + n * 16); *(f32x4*)(xo + off + bj * HALF + n * 16) = b + acc[ai][bj][m][n]; } }
    }
};
}

template <class Epi>
__device__ __forceinline__ void gemm_naive(const Ctx& C, const bf16* A, int lda, const bf16* Bt, int ldb, int Mr, int Nr, int K, int tile0, int tstride, const Epi& E) {
    LAS float* As = (LAS float*)C.lds;
    LAS float* Bs = As + 32 * 132;
    const int tid = C.tid, ty = tid >> 4, tx = tid & 15;
    const int nMt = Mr / 128, nNt = Nr / 128, ntiles = nMt * nNt;
    for (int tile = tile0; tile < ntiles; tile += tstride) {
        const int tm = tile % nMt, tn = tile / nMt;
        float acc[4][8];
#pragma unroll
        for (int i = 0; i < 4; ++i)
#pragma unroll
            for (int j = 0; j < 8; ++j) acc[i][j] = 0.f;
        const int lr = tid >> 2, lk = (tid & 3) * 8;
        for (int k0 = 0; k0 < K; k0 += 32) {
            const v4u av = *(const GAS v4u*)(A + (size_t)(tm * 128 + lr) * lda + k0 + lk);
            const v4u bv = *(const GAS v4u*)(Bt + (size_t)(tn * 128 + lr) * ldb + k0 + lk);
            __syncthreads();
#pragma unroll
            for (int j = 0; j < 4; ++j) {
                As[(lk + 2 * j) * 132 + lr] = __uint_as_float(av[j] << 16); As[(lk + 2 * j + 1) * 132 + lr] = __uint_as_float(av[j] & 0xffff0000u);
                Bs[(lk + 2 * j) * 132 + lr] = __uint_as_float(bv[j] << 16); Bs[(lk + 2 * j + 1) * 132 + lr] = __uint_as_float(bv[j] & 0xffff0000u);
            }
            __syncthreads();
#pragma unroll 2
            for (int k = 0; k < 32; ++k) {
                const f32x4 a = *(const LAS f32x4*)(As + k * 132 + ty * 4);
                const f32x4 b0 = *(const LAS f32x4*)(Bs + k * 132 + tx * 8), b1 = *(const LAS f32x4*)(Bs + k * 132 + tx * 8 + 4);
#pragma unroll
                for (int i = 0; i < 4; ++i) {
                    acc[i][0] += a[i] * b0[0]; acc[i][1] += a[i] * b0[1]; acc[i][2] += a[i] * b0[2]; acc[i][3] += a[i] * b0[3];
                    acc[i][4] += a[i] * b1[0]; acc[i][5] += a[i] * b1[1]; acc[i][6] += a[i] * b1[2]; acc[i][7] += a[i] * b1[3];
                }
            }
        }
#pragma unroll
        for (int i = 0; i < 4; ++i) E(tm * 128 + ty * 4 + i, tn * 128 + tx * 8, acc[i]);
    }
    __syncthreads();
}
struct EpiStoreBf16 {
    bf16* O; int ldc;
    __device__ __forceinline__ void operator()(int m, int n0, const float (&v)[8]) const {
        v4u w; w.x = pk2(v[0], v[1]); w.y = pk2(v[2], v[3]); w.z = pk2(v[4], v[5]); w.w = pk2(v[6], v[7]);
        *(GAS v4u*)(O + (size_t)m * ldc + n0) = w; }
};
struct EpiInProj {
    bf16* P; bf16* MIX; int NP;
    __device__ __forceinline__ void operator()(int m, int n0, const float (&v)[8]) const {
        v4u w; w.x = pk2(v[0], v[1]); w.y = pk2(v[2], v[3]); w.z = pk2(v[4], v[5]); w.w = pk2(v[6], v[7]);
        if (n0 < NP) *(GAS v4u*)(P + (size_t)m * NP + n0) = w; else *(GAS v4u*)(MIX + (size_t)m * NMIX + (n0 - NP)) = w; }
};
struct EpiResid {
    const float* xi; float* xo;
    __device__ __forceinline__ void operator()(int m, int n0, const float (&v)[8]) const {
        const f32x4 a = *(const GAS f32x4*)(xi + (size_t)m * D + n0), b = *(const GAS f32x4*)(xi + (size_t)m * D + n0 + 4);
        f32x4 o0 = {a[0] + v[0], a[1] + v[1], a[2] + v[2], a[3] + v[3]}, o1 = {b[0] + v[4], b[1] + v[5], b[2] + v[6], b[3] + v[7]};
        *(GAS f32x4*)(xo + (size_t)m * D + n0) = o0; *(GAS f32x4*)(xo + (size_t)m * D + n0 + 4) = o1; }
};

__device__ __forceinline__ float dot8(const v4u w, const LAS float* q) {
    const f32x4 q0 = *(const LAS f32x4*)q, q1 = *(const LAS f32x4*)(q + 4);
    return (__uint_as_float(w[0] << 16) * q0[0] + __uint_as_float(w[0] & 0xffff0000u) * q0[1]) + (__uint_as_float(w[1] << 16) * q0[2] + __uint_as_float(w[1] & 0xffff0000u) * q0[3])
         + (__uint_as_float(w[2] << 16) * q1[0] + __uint_as_float(w[2] & 0xffff0000u) * q1[1]) + (__uint_as_float(w[3] << 16) * q1[2] + __uint_as_float(w[3] & 0xffff0000u) * q1[3]);
}
__device__ __forceinline__ void naive_winattn_item(const Ctx& C, const float* sink, int item, LAS float* pw) {
    const bf16* P = (const bf16*)(C.ws + WS_P); bf16* MIX = (bf16*)(C.ws + WS_MIX);
    int lane = C.lane; asm volatile("" : "+v"(lane));
    const int hq = item & 7, m = item >> 3, t = m & (T - 1), b = m >> 12, n = hq >> 2;
    const float slope = exp2f(-(float)(hq + 1)), sk = sink[hq];
    LAS float* qs = pw + 320;
    qs[lane] = bf2f(P[(size_t)m * NP_E + E_QA + hq * 64 + lane]);
    LDS_WAIT(); asm volatile("" ::: "memory");
    float mx = -3e38f;
#pragma unroll 1
    for (int i = 0; i < 5; ++i) {
        const int j = lane + 64 * i, s = t - 128 + j; const bool valid = (j <= 256) && (s >= 0) && (s < T);
        float acc = -3e38f;
        if (valid) { const GAS v4u* kp = (const GAS v4u*)(P + (size_t)(b * T + s) * NP_E + E_KA + n * 64); acc = 0.f;
#pragma unroll
            for (int jj = 0; jj < 8; ++jj) acc += dot8(kp[jj], qs + 8 * jj);
            acc = acc * 0.125f - slope * fabsf((float)(t - s)); mx = fmaxf(mx, acc); }
        if (j <= 256) pw[j] = acc;
    }
    mx = fmaxf(wave_max(mx), sk);
    LDS_WAIT(); asm volatile("" ::: "memory");
    float sum = 0.f;
#pragma unroll 1
    for (int i = 0; i < 5; ++i) { const int j = lane + 64 * i; if (j <= 256) { const float sc = pw[j]; const float p = (sc > -1e38f) ? __expf(sc - mx) : 0.f; sum += p; pw[j] = p; } }
    sum = wave_sum(sum) + __expf(sk - mx);
    LDS_WAIT(); asm volatile("" ::: "memory");
    float o = 0.f;
    for (int j = 0; j <= 256; ++j) { const int s = t - 128 + j; if (s < 0 || s >= T) continue;
        o += pw[j] * bf2f(P[(size_t)(b * T + s) * NP_E + E_VA + n * 64 + lane]); }
    o /= sum;
    bf16* gp = MIX + (size_t)m * NMIX + X_GA + hq * 64 + lane;
    *gp = (bf16)f2bf(o * siluf_(bf2f(*gp)));
    LDS_WAIT(); asm volatile("" ::: "memory");
}
__device__ __forceinline__ void naive_memattn_item(const Ctx& C, int l, int item, LAS float* pw) {
    const int NP = (l & 1) ? NP_O : NP_E, QOFF = (l & 1) ? O_QM : E_QM;
    const bf16* P = (const bf16*)(C.ws + WS_P); bf16* MIX = (bf16*)(C.ws + WS_MIX);
    const bf16* MK = (const bf16*)(C.ws + WS_MEMK) + (size_t)l * 1024 * 512; const bf16* MVT = (const bf16*)(C.ws + WS_MEMVT) + (size_t)l * 512 * 1024;
    int lane = C.lane; asm volatile("" : "+v"(lane));
    const int h = item & 3, m = item >> 2, b = m >> 12;
    LAS float* qs = pw + 320;
    qs[lane] = bf2f(P[(size_t)m * NP + QOFF + h * 128 + lane]); qs[lane + 64] = bf2f(P[(size_t)m * NP + QOFF + h * 128 + lane + 64]);
    LDS_WAIT(); asm volatile("" ::: "memory");
    float mx = -3e38f;
#pragma unroll 1
    for (int i = 0; i < 4; ++i) { const int s = lane + 64 * i;
        const GAS v4u* kp = (const GAS v4u*)(MK + (size_t)(b * NMEM + s) * 512 + h * 128); float acc = 0.f;
#pragma unroll
        for (int jj = 0; jj < 16; ++jj) acc += dot8(kp[jj], qs + 8 * jj);
        acc *= 0.08838834764831845f; mx = fmaxf(mx, acc); pw[s] = acc; }
    mx = wave_max(mx);
    LDS_WAIT(); asm volatile("" ::: "memory");
    float sum = 0.f;
#pragma unroll 1
    for (int i = 0; i < 4; ++i) { const int s = lane + 64 * i; const float p = __expf(pw[s] - mx); sum += p; pw[s] = p; }
    sum = wave_sum(sum);
    LDS_WAIT(); asm volatile("" ::: "memory");
#pragma unroll 1
    for (int dd = 0; dd < 2; ++dd) { const int d = lane + 64 * dd; const bf16* vp = MVT + (size_t)(h * 128 + d) * 1024 + b * NMEM; float o = 0.f;
#pragma unroll 4
        for (int s = 0; s < NMEM; s += 8) o += dot8(*(const GAS v4u*)(vp + s), pw + s);
        o /= sum;
        bf16* gp = MIX + (size_t)m * NMIX + X_GM + h * 128 + d;
        *gp = (bf16)f2bf(o * siluf_(bf2f(*gp))); }
    LDS_WAIT(); asm volatile("" ::: "memory");
}
template <int ODD>
__device__ __forceinline__ void naive_scan_item(const Ctx& C, const float* lbp, const float* wgu, const float* bgp, int l, int item, LAS float* scr) {
    constexpr int DV = ODD ? 256 : 128, NCG = DV / 32, NP = ODD ? NP_O : NP_E, VOFF = ODD ? O_VC : E_IB, TS = 8;
    int lane = C.lane; asm volatile("" : "+v"(lane));
    const int li = l >> 1, kh = lane >> 5;
    const int cg = item % NCG, h = (item / NCG) & 3, b = item / (NCG * 4);
    const bf16* P = (const bf16*)(C.ws + WS_P);
    float* O = (float*)(C.ws + (ODD ? WS_OO : WS_OE));
    LAS float* fq = scr; LAS float* fk = scr + TS * 128; LAS float* ff = scr + 2 * TS * 128;
    const int col = h * DV + cg * 32 + (lane & 31);
    for (int dir = 0; dir < 2; ++dir) {
        float lbv[2] = {0.f, 0.f}, bg[2] = {0.f, 0.f};
#pragma unroll
        for (int c = 0; c < 2; ++c) { const int ch = h * 128 + lane + 64 * c;
            if (!ODD) { if (li == 1) { const float p0 = lbp[(0 * 2 + dir) * 512 + ch], p1 = lbp[(1 * 2 + dir) * 512 + ch]; lbv[c] = 1.f / (1.f + __expf(p0 - p1)); } }
            else bg[c] = bgp[(li * 2 + dir) * 512 + ch]; }
        const float* wup = wgu + (size_t)(li * 2 + dir) * 16 * 512 + h * 128 + lane;
        float S[64];
#pragma unroll
        for (int k = 0; k < 64; ++k) S[k] = 0.f;
        for (int tb = 0; tb < T; tb += TS) {
#pragma unroll 1
            for (int s = 0; s < TS; ++s) { const int t = dir ? (T - 1 - (tb + s)) : (tb + s); const size_t m = (size_t)b * T + t; const bf16* row = P + m * NP;
#pragma unroll
                for (int c = 0; c < 2; ++c) { const int k = lane + 64 * c, ch = h * 128 + k; float qv, kv, fv;
                    if (!ODD) { const float z = bf2f(row[(dir ? E_ZB : E_ZF) + ch]); const float sg = sigmoidf_(z);
                        fv = lbv[c] + (1.f - lbv[c]) * sg; kv = (1.f - lbv[c]) * (1.f - sg); qv = siluf_(bf2f(row[E_QB + ch])); }
                    else { float pre = bg[c];
#pragma unroll
                        for (int r = 0; r < 16; ++r) pre += bf2f(row[(dir ? O_RB : O_RF) + r]) * wup[r * 512 + 64 * c];
                        const float ls = fminf(pre, 0.f) - log1pf(__expf(-fabsf(pre)));
                        fv = __expf(ls * (1.f / 16.f)); kv = bf2f(row[O_KC + ch]); qv = bf2f(row[O_QC + ch]) * 0.08838834764831845f; }
                    fq[s * 128 + k] = qv; fk[s * 128 + k] = kv; ff[s * 128 + k] = fv; } }
            LDS_WAIT(); asm volatile("" ::: "memory");
#pragma unroll 1
            for (int s = 0; s < TS; ++s) { const int t = dir ? (T - 1 - (tb + s)) : (tb + s); const size_t m = (size_t)b * T + t;
                const float v = bf2f(P[m * NP + VOFF + col]); float o = 0.f;
                const LAS float* pf = ff + s * 128 + kh * 64; const LAS float* pk = fk + s * 128 + kh * 64; const LAS float* pq = fq + s * 128 + kh * 64;
#pragma unroll
                for (int k4 = 0; k4 < 16; ++k4) { const f32x4 f4 = *(const LAS f32x4*)(pf + 4 * k4), k4v = *(const LAS f32x4*)(pk + 4 * k4), q4 = *(const LAS f32x4*)(pq + 4 * k4);
#pragma unroll
                    for (int e = 0; e < 4; ++e) { S[4 * k4 + e] = f4[e] * S[4 * k4 + e] + k4v[e] * v; o += q4[e] * S[4 * k4 + e]; }
                    if ((k4 & 3) == 3) asm volatile("" ::: "memory"); }
                o += __shfl_xor(o, 32);
                float* op = O + m * (4 * DV) + col;
                if (kh == 0) { if (dir) *op += o; else *op = o; } }
            LDS_WAIT(); asm volatile("" ::: "memory");
        }
    }
}
template <int ODD>
__device__ __forceinline__ void naive_gnorm_item(const Ctx& C, const float* gw_, int l, int item) {
    constexpr int DV = ODD ? 256 : 128, NC = DV / 64, GOFF = ODD ? X_GC : X_GB;
    int lane = C.lane; asm volatile("" : "+v"(lane));
    const int li = l >> 1, h = item & 3, m = item >> 2;
    const float* O = (const float*)(C.ws + (ODD ? WS_OO : WS_OE)) + (size_t)m * (4 * DV) + h * DV;
    const float* g = gw_ + li * (4 * DV) + h * DV;
    bf16* MIX = (bf16*)(C.ws + WS_MIX) + (size_t)m * NMIX + GOFF + h * DV;
    float v[NC]; float s = 0.f;
#pragma unroll
    for (int c = 0; c < NC; ++c) { v[c] = O[lane + 64 * c]; s += v[c] * v[c]; }
    const float rstd = 1.f / sqrtf(wave_sum(s) * (1.f / DV) + EPS);
#pragma unroll
    for (int c = 0; c < NC; ++c) { bf16* gp = MIX + lane + 64 * c; *gp = (bf16)f2bf(v[c] * rstd * g[lane + 64 * c] * siluf_(bf2f(*gp))); }
}

namespace scan {
typedef short bf16x8 __attribute__((ext_vector_type(8)));
typedef short s16x4 __attribute__((ext_vector_type(4)));
typedef float f32x16 __attribute__((ext_vector_type(16)));
typedef float f32x2_t __attribute__((ext_vector_type(2)));
typedef __bf16 bf16x2_t __attribute__((ext_vector_type(2)));
typedef short v4i16_t __attribute__((ext_vector_type(4)));
__device__ __forceinline__ unsigned cvtpk(float lo, float hi) { f32x2_t v = {lo, hi}; bf16x2_t b = __builtin_convertvector(v, bf16x2_t); return __builtin_bit_cast(unsigned, b); }
__device__ __forceinline__ s16x4 trd(const LAS unsigned char* p) { return __builtin_bit_cast(s16x4, __builtin_amdgcn_ds_read_tr16_b64_v4i16((LAS v4i16_t*)p)); }
#define SC_MFMA(a, b, c) __builtin_amdgcn_mfma_f32_32x32x16_bf16((a), (b), (c), 0, 0, 0)
__device__ __forceinline__ bf16x8 pack8(const f32x16& x, int s) {
    v4u p; p.x = cvtpk(x[8 * s + 0], x[8 * s + 1]); p.y = cvtpk(x[8 * s + 2], x[8 * s + 3]); p.z = cvtpk(x[8 * s + 4], x[8 * s + 5]); p.w = cvtpk(x[8 * s + 6], x[8 * s + 7]);
    return __builtin_bit_cast(bf16x8, p);
}
__device__ __forceinline__ float expc(float x) { return __expf(fminf(x, 80.f)); }

template <int ODD> struct Geo {
    static constexpr int NH = ODD ? 1 : 2, DVH = ODD ? 256 : 128, KH = 128 * NH, NHG = 4 / NH, SCLEN = ODD ? 256 : 128, NSC = T / SCLEN, NCH = SCLEN / 32;
    static constexpr int NP = ODD ? NP_O : NP_E, QOFF = ODD ? O_QC : E_QB, VOFF = ODD ? O_VC : E_IB, GOFF = ODD ? X_GC : X_GB;
    static constexpr int RSB = KH * 4;
    static constexpr int RSK = KH * 2 + 16;
    static constexpr int RST = KH * 2 + 64;
    static constexpr int RSV = 512 + 64;
    static constexpr int RSO = 260 * 4;
    static constexpr int OFF_B = 0, OFF_Q1 = 34816, OFF_Q2 = OFF_Q1 + 32 * RSK, OFF_K2 = OFF_Q2 + 32 * RSK, OFF_W = OFF_K2 + 32 * RSK, OFF_V = OFF_W + 32 * RST, OFF_D = OFF_V + 32 * RSV, OFF_END = OFF_D + 1024;
    static_assert(OFF_END <= RING_BYTES, "scan LDS map");
    static constexpr size_t L_ITEM = (size_t)DVH * 128;
};
struct ScanPtrs { const bf16* P; bf16* MIX; bf16* L; float* LOGD; bf16* OG; const float* lbp; const float* wgu; const float* bgp; const float* gnw; };

template <int ODD, int MODE>
__device__ __forceinline__ void scan_item(const Ctx& C, const ScanPtrs& sp, int li, int b, int hg, int sc, int dir0) {
    typedef Geo<ODD> G;
    const int tid = C.tid, wave = C.wave; int lane = C.lane; asm volatile("" : "+v"(lane));
    const int r = lane & 31, h = lane >> 5, i16 = lane & 15, q4 = i16 >> 2, p4 = i16 & 3, g1 = (lane >> 4) & 1;
    const int hh = wave / (8 / G::NH), h0 = hg * G::NH;
    const int kc0 = hh * 128, vcol0 = wave * 32;
    LAS unsigned char* lds = C.lds;
    const int sc0 = sc * G::SCLEN;
    const bf16* Pb = sp.P + (size_t)b * T * G::NP;
    f32x16 S[4];
    for (int dd = 0; dd < (MODE ? 2 : 1); ++dd) {
        const int dir = MODE ? dd : dir0;
        float lbv = 0.f, bgv = 0.f, wupv[16]; float logd_acc = 0.f;
        if (tid < G::KH) {
            const int ch = h0 * 128 + tid;
            if (!ODD) { if (li == 1) { const float p0 = sp.lbp[(0 * 2 + dir) * 512 + ch], p1 = sp.lbp[(1 * 2 + dir) * 512 + ch]; lbv = 1.f / (1.f + __expf(p0 - p1)); } }
            else { bgv = sp.bgp[(li * 2 + dir) * 512 + ch];
#pragma unroll
                for (int rr = 0; rr < 16; ++rr) wupv[rr] = sp.wgu[((size_t)(li * 2 + dir) * 16 + rr) * 512 + ch]; }
        }
        if (MODE) { const bf16* Lp = sp.L + ((((size_t)(b * 4 + h0 + hh) * G::NSC + sc) * 2 + dir) * G::L_ITEM) + (size_t)((vcol0 - hh * G::DVH) + r) * 128;
#pragma unroll
            for (int kt = 0; kt < 4; ++kt)
#pragma unroll
                for (int g4 = 0; g4 < 4; ++g4) { const v2u w = *(const GAS v2u*)(Lp + 32 * kt + 8 * g4 + 4 * h);
                    S[kt][4 * g4 + 0] = __uint_as_float(w.x << 16); S[kt][4 * g4 + 1] = __uint_as_float(w.x & 0xffff0000u); S[kt][4 * g4 + 2] = __uint_as_float(w.y << 16); S[kt][4 * g4 + 3] = __uint_as_float(w.y & 0xffff0000u); } }
        else {
#pragma unroll
            for (int kt = 0; kt < 4; ++kt)
#pragma unroll
                for (int e = 0; e < 16; ++e) S[kt][e] = 0.f; }
#pragma unroll 1
        for (int ci = 0; ci < G::NCH; ++ci) {
            const int tbase = dir ? (sc0 + G::SCLEN - 1 - 32 * ci) : (sc0 + 32 * ci); const int tstep = dir ? -1 : 1;
            if (tid < G::KH) {
                float bacc = 0.f;
#pragma unroll 4
                for (int i = 0; i < 32; ++i) { const bf16* row = Pb + (size_t)(tbase + tstep * i) * G::NP; float gl;
                    if (!ODD) { const float z = bf2f(row[(dir ? E_ZB : E_ZF) + h0 * 128 + tid]); const float f = lbv + (1.f - lbv) * sigmoidf_(z); gl = __logf(fmaxf(f, 1e-30f)); }
                    else { const v4u r0 = *(const GAS v4u*)(row + (dir ? O_RB : O_RF)), r1 = *(const GAS v4u*)(row + (dir ? O_RB : O_RF) + 8); float pre = bgv;
#pragma unroll
                        for (int e = 0; e < 4; ++e) { pre += __uint_as_float(r0[e] << 16) * wupv[2 * e] + __uint_as_float(r0[e] & 0xffff0000u) * wupv[2 * e + 1];
                                                      pre += __uint_as_float(r1[e] << 16) * wupv[8 + 2 * e] + __uint_as_float(r1[e] & 0xffff0000u) * wupv[8 + 2 * e + 1]; }
                        gl = (fminf(pre, 0.f) - __logf(1.f + __expf(-fabsf(pre)))) * (1.f / 16.f); }
                    bacc += gl; *(LAS float*)(lds + G::OFF_B + i * G::RSB + tid * 4) = bacc; }
                *(LAS float*)(lds + G::OFF_D + tid * 4) = __expf(bacc); logd_acc += bacc;
            }
            __syncthreads();
            for (int u = tid; u < 32 * G::KH / 8; u += NTHR) {
                const int i = u / (G::KH / 8), c8 = (u % (G::KH / 8)) * 8; const bf16* row = Pb + (size_t)(tbase + tstep * i) * G::NP;
                const f32x4 b0 = *(const LAS f32x4*)(lds + G::OFF_B + i * G::RSB + c8 * 4), b1 = *(const LAS f32x4*)(lds + G::OFF_B + i * G::RSB + c8 * 4 + 16);
                const f32x4 r0 = *(const LAS f32x4*)(lds + G::OFF_B + 15 * G::RSB + c8 * 4), r1 = *(const LAS f32x4*)(lds + G::OFF_B + 15 * G::RSB + c8 * 4 + 16);
                const f32x4 e0 = *(const LAS f32x4*)(lds + G::OFF_B + 31 * G::RSB + c8 * 4), e1 = *(const LAS f32x4*)(lds + G::OFF_B + 31 * G::RSB + c8 * 4 + 16);
                float bb[8] = {b0[0], b0[1], b0[2], b0[3], b1[0], b1[1], b1[2], b1[3]}, rr[8] = {r0[0], r0[1], r0[2], r0[3], r1[0], r1[1], r1[2], r1[3]}, ee[8] = {e0[0], e0[1], e0[2], e0[3], e1[0], e1[1], e1[2], e1[3]};
                float kk[8], qq[8];
                if (!ODD) { const v4u zv = *(const GAS v4u*)(row + (dir ? E_ZB : E_ZF) + h0 * 128 + c8);
                    float lb8[8];
#pragma unroll
                    for (int e = 0; e < 8; ++e) { lb8[e] = 0.f; if (li == 1) { const int ch = h0 * 128 + c8 + e; lb8[e] = 1.f / (1.f + __expf(sp.lbp[(0 * 2 + dir) * 512 + ch] - sp.lbp[(1 * 2 + dir) * 512 + ch])); } }
#pragma unroll
                    for (int e = 0; e < 4; ++e) { kk[2 * e] = (1.f - lb8[2 * e]) * (1.f - sigmoidf_(__uint_as_float(zv[e] << 16))); kk[2 * e + 1] = (1.f - lb8[2 * e + 1]) * (1.f - sigmoidf_(__uint_as_float(zv[e] & 0xffff0000u))); }
                    if (MODE) { const v4u qv = *(const GAS v4u*)(row + E_QB + h0 * 128 + c8);
#pragma unroll
                        for (int e = 0; e < 4; ++e) { qq[2 * e] = siluf_(__uint_as_float(qv[e] << 16)); qq[2 * e + 1] = siluf_(__uint_as_float(qv[e] & 0xffff0000u)); } } }
                else { const v4u kv = *(const GAS v4u*)(row + O_KC + h0 * 128 + c8);
#pragma unroll
                    for (int e = 0; e < 4; ++e) { kk[2 * e] = __uint_as_float(kv[e] << 16); kk[2 * e + 1] = __uint_as_float(kv[e] & 0xffff0000u); }
                    if (MODE) { const v4u qv = *(const GAS v4u*)(row + O_QC + h0 * 128 + c8);
#pragma unroll
                        for (int e = 0; e < 4; ++e) { qq[2 * e] = __uint_as_float(qv[e] << 16) * 0.08838834764831845f; qq[2 * e + 1] = __uint_as_float(qv[e] & 0xffff0000u) * 0.08838834764831845f; } } }
                v4u w;
                w.x = cvtpk(kk[0] * __expf(ee[0] - bb[0]), kk[1] * __expf(ee[1] - bb[1])); w.y = cvtpk(kk[2] * __expf(ee[2] - bb[2]), kk[3] * __expf(ee[3] - bb[3]));
                w.z = cvtpk(kk[4] * __expf(ee[4] - bb[4]), kk[5] * __expf(ee[5] - bb[5])); w.w = cvtpk(kk[6] * __expf(ee[6] - bb[6]), kk[7] * __expf(ee[7] - bb[7]));
                *(LAS v4u*)(lds + G::OFF_W + i * G::RST + c8 * 2) = w;
                if (MODE) {
                    float dl[8];
#pragma unroll
                    for (int e = 0; e < 8; ++e) dl[e] = bb[e] - rr[e];
                    w.x = cvtpk(qq[0] * __expf(bb[0]), qq[1] * __expf(bb[1])); w.y = cvtpk(qq[2] * __expf(bb[2]), qq[3] * __expf(bb[3]));
                    w.z = cvtpk(qq[4] * __expf(bb[4]), qq[5] * __expf(bb[5])); w.w = cvtpk(qq[6] * __expf(bb[6]), qq[7] * __expf(bb[7]));
                    *(LAS v4u*)(lds + G::OFF_Q1 + i * G::RSK + c8 * 2) = w;
                    w.x = cvtpk(qq[0] * expc(dl[0]), qq[1] * expc(dl[1])); w.y = cvtpk(qq[2] * expc(dl[2]), qq[3] * expc(dl[3]));
                    w.z = cvtpk(qq[4] * expc(dl[4]), qq[5] * expc(dl[5])); w.w = cvtpk(qq[6] * expc(dl[6]), qq[7] * expc(dl[7]));
                    *(LAS v4u*)(lds + G::OFF_Q2 + i * G::RSK + c8 * 2) = w;
                    w.x = cvtpk(kk[0] * expc(-dl[0]), kk[1] * expc(-dl[1])); w.y = cvtpk(kk[2] * expc(-dl[2]), kk[3] * expc(-dl[3]));
                    w.z = cvtpk(kk[4] * expc(-dl[4]), kk[5] * expc(-dl[5])); w.w = cvtpk(kk[6] * expc(-dl[6]), kk[7] * expc(-dl[7]));
                    *(LAS v4u*)(lds + G::OFF_K2 + i * G::RSK + c8 * 2) = w;
                }
            }
            for (int u = tid; u < 32 * 32; u += NTHR) { const int i = u >> 5, c8 = (u & 31) * 8;
                *(LAS v4u*)(lds + G::OFF_V + i * G::RSV + c8 * 2) = *(const GAS v4u*)(Pb + (size_t)(tbase + tstep * i) * G::NP + G::VOFF + h0 * G::DVH + c8); }
            __syncthreads();
            f32x16 o;
            if (MODE) {
#pragma unroll
                for (int e = 0; e < 16; ++e) o[e] = 0.f;
#pragma unroll
                for (int kt = 0; kt < 4; ++kt)
#pragma unroll
                    for (int st = 0; st < 2; ++st) { const LAS unsigned char* qp = lds + G::OFF_Q1 + r * G::RSK + (kc0 + 32 * kt + 16 * st + 4 * h) * 2;
                        const s16x4 lo = *(const LAS s16x4*)qp, hi = *(const LAS s16x4*)(qp + 16);
                        const bf16x8 a = __builtin_shufflevector(lo, hi, 0, 1, 2, 3, 4, 5, 6, 7);
                        o = SC_MFMA(a, pack8(S[kt], st), o); }
                f32x16 at;
#pragma unroll
                for (int e = 0; e < 16; ++e) at[e] = 0.f;
#pragma unroll
                for (int ks = 0; ks < 8; ++ks) { const bf16x8 a = *(const LAS bf16x8*)(lds + G::OFF_K2 + r * G::RSK + (kc0 + 16 * ks + 8 * h) * 2), bq = *(const LAS bf16x8*)(lds + G::OFF_Q2 + r * G::RSK + (kc0 + 16 * ks + 8 * h) * 2);
                    at = SC_MFMA(a, bq, at); }
#pragma unroll
                for (int e = 0; e < 16; ++e) { const int srow = (e & 3) + 8 * (e >> 2) + 4 * h; at[e] = (srow <= r) ? at[e] : 0.f; }
#pragma unroll
                for (int st = 0; st < 2; ++st) { const LAS unsigned char* vp = lds + G::OFF_V + (16 * st + 4 * h + q4) * G::RSV + (vcol0 + 16 * g1 + 4 * p4) * 2;
                    const s16x4 lo = trd(vp), hi = trd(vp + 8 * G::RSV);
                    const bf16x8 bv = __builtin_shufflevector(lo, hi, 0, 1, 2, 3, 4, 5, 6, 7);
                    o = SC_MFMA(pack8(at, st), bv, o); }
            }
#pragma unroll
            for (int kt = 0; kt < 4; ++kt)
#pragma unroll
                for (int g4 = 0; g4 < 4; ++g4) { const f32x4 dv = *(const LAS f32x4*)(lds + G::OFF_D + (kc0 + 32 * kt + 8 * g4 + 4 * h) * 4);
#pragma unroll
                    for (int e = 0; e < 4; ++e) S[kt][4 * g4 + e] *= dv[e]; }
#pragma unroll
            for (int st = 0; st < 2; ++st) { const LAS unsigned char* vp = lds + G::OFF_V + (16 * st + 8 * h + q4) * G::RSV + (vcol0 + 16 * g1 + 4 * p4) * 2;
                const s16x4 vlo = trd(vp), vhi = trd(vp + 4 * G::RSV);
                const bf16x8 bv = __builtin_shufflevector(vlo, vhi, 0, 1, 2, 3, 4, 5, 6, 7);
#pragma unroll
                for (int kt = 0; kt < 4; ++kt) { const LAS unsigned char* wp = lds + G::OFF_W + (16 * st + 8 * h + q4) * G::RST + (kc0 + 32 * kt + 16 * g1 + 4 * p4) * 2;
                    const s16x4 wlo = trd(wp), whi = trd(wp + 4 * G::RST);
                    const bf16x8 aw = __builtin_shufflevector(wlo, whi, 0, 1, 2, 3, 4, 5, 6, 7);
                    S[kt] = SC_MFMA(aw, bv, S[kt]); } }
            if (MODE) {
#pragma unroll
                for (int e = 0; e < 16; ++e) *(LAS float*)(lds + G::OFF_B + ((e & 3) + 8 * (e >> 2) + 4 * h) * G::RSO + (vcol0 + r) * 4) = o[e];
                __syncthreads();
                { const int i = tid >> 4, seg = tid & 15, vc = seg * 16; const size_t m = (size_t)b * T + (tbase + tstep * i);
                  float v[16];
#pragma unroll
                  for (int e4 = 0; e4 < 4; ++e4) { const f32x4 x = *(const LAS f32x4*)(lds + G::OFF_B + i * G::RSO + (vc + 4 * e4) * 4); v[4 * e4] = x[0]; v[4 * e4 + 1] = x[1]; v[4 * e4 + 2] = x[2]; v[4 * e4 + 3] = x[3]; }
                  bf16* og = sp.OG + m * (G::NHG * 256) + hg * 256 + vc;
                  if (dd == 0) { v4u w0, w1; w0.x = cvtpk(v[0], v[1]); w0.y = cvtpk(v[2], v[3]); w0.z = cvtpk(v[4], v[5]); w0.w = cvtpk(v[6], v[7]); w1.x = cvtpk(v[8], v[9]); w1.y = cvtpk(v[10], v[11]); w1.z = cvtpk(v[12], v[13]); w1.w = cvtpk(v[14], v[15]);
                      *(GAS v4u*)og = w0; *(GAS v4u*)(og + 8) = w1; }
                  else { const v4u w0 = *(const GAS v4u*)og, w1 = *(const GAS v4u*)(og + 8); float ss = 0.f;
#pragma unroll
                      for (int e = 0; e < 4; ++e) { v[2 * e] += __uint_as_float(w0[e] << 16); v[2 * e + 1] += __uint_as_float(w0[e] & 0xffff0000u); v[8 + 2 * e] += __uint_as_float(w1[e] << 16); v[8 + 2 * e + 1] += __uint_as_float(w1[e] & 0xffff0000u); }
#pragma unroll
                      for (int e = 0; e < 16; ++e) ss += v[e] * v[e];
#pragma unroll
                      for (int o_ = 1; o_ < G::DVH / 16; o_ <<= 1) ss += __shfl_xor(ss, o_);
                      const float rstd = 1.f / sqrtf(ss * (1.f / G::DVH) + EPS);
                      bf16* mp = sp.MIX + m * NMIX + G::GOFF + h0 * G::DVH + vc; const float* gwp = sp.gnw + li * (4 * G::DVH) + h0 * G::DVH + vc;
                      const v4u g0 = *(const GAS v4u*)mp, g1v = *(const GAS v4u*)(mp + 8); float gt[16];
#pragma unroll
                      for (int e = 0; e < 4; ++e) { gt[2 * e] = __uint_as_float(g0[e] << 16); gt[2 * e + 1] = __uint_as_float(g0[e] & 0xffff0000u); gt[8 + 2 * e] = __uint_as_float(g1v[e] << 16); gt[8 + 2 * e + 1] = __uint_as_float(g1v[e] & 0xffff0000u); }
#pragma unroll
                      for (int e = 0; e < 16; ++e) v[e] = v[e] * rstd * gwp[e] * siluf_(gt[e]);
                      v4u w0o, w1o; w0o.x = cvtpk(v[0], v[1]); w0o.y = cvtpk(v[2], v[3]); w0o.z = cvtpk(v[4], v[5]); w0o.w = cvtpk(v[6], v[7]); w1o.x = cvtpk(v[8], v[9]); w1o.y = cvtpk(v[10], v[11]); w1o.z = cvtpk(v[12], v[13]); w1o.w = cvtpk(v[14], v[15]);
                      *(GAS v4u*)mp = w0o; *(GAS v4u*)(mp + 8) = w1o; }
                }
            }
            __syncthreads();
        }
        if (!MODE) {
            bf16* Lp = sp.L + ((((size_t)(b * 4 + h0 + hh) * G::NSC + sc) * 2 + dir) * G::L_ITEM) + (size_t)((vcol0 - hh * G::DVH) + r) * 128;
#pragma unroll
            for (int kt = 0; kt < 4; ++kt)
#pragma unroll
                for (int g4 = 0; g4 < 4; ++g4) { v2u w; w.x = cvtpk(S[kt][4 * g4], S[kt][4 * g4 + 1]); w.y = cvtpk(S[kt][4 * g4 + 2], S[kt][4 * g4 + 3]); *(GAS v2u*)(Lp + 32 * kt + 8 * g4 + 4 * h) = w; }
            if (tid < G::KH) sp.LOGD[(((size_t)(b * 4 + h0 + (tid >> 7)) * G::NSC + sc) * 2 + dir) * 128 + (tid & 127)] = logd_acc;
        }
        if (MODE) { asm volatile("s_waitcnt vmcnt(0)" ::: "memory"); __syncthreads(); }
    }
}

template <int ODD, int MODE>
__device__ __forceinline__ void scan_item2(const Ctx& C, const ScanPtrs& sp, int li, int b, int hg, int sc, int dir0) {
    typedef Geo<ODD> G;
    constexpr int NU = G::KH / 128;
    constexpr int UPR = G::KH / 8;
    constexpr int OFF_WUP = G::OFF_D + 1024;
    static_assert(OFF_WUP + 16 * 512 + 512 <= RING_BYTES, "scan LDS map (wup)");
    const int tid0 = C.tid, wave = C.wave; int lane0 = C.lane; asm volatile("" : "+v"(lane0));
    int tid = tid0, lane = lane0; int r = lane & 31, h = lane >> 5, i16 = lane & 15, q4 = i16 >> 2, p4 = i16 & 3, g1 = (lane >> 4) & 1;
    const int hh = wave / (8 / G::NH), h0 = hg * G::NH;
    const int kc0 = hh * 128, vcol0 = wave * 32;
    LAS unsigned char* lds = C.lds;
    const int sc0 = sc * G::SCLEN;
    const bf16* Pb = sp.P + (size_t)b * T * G::NP;
    int uc8 = (tid % UPR) * 8, ui0 = tid / UPR;
    int vi0 = tid >> 5, vc8 = (tid & 31) * 8;
    int ei = tid >> 4, evc = (tid & 15) * 16;
    f32x16 S[4];
    for (int dd = 0; dd < (MODE ? 2 : 1); ++dd) {
        const int dir = MODE ? dd : dir0;
        float lb8[8]; float logd8[8];
#pragma unroll
        for (int e = 0; e < 8; ++e) { lb8[e] = 0.f; logd8[e] = 0.f; }
        if (!ODD) { if (li == 1) {
#pragma unroll
            for (int e = 0; e < 8; ++e) { const int ch = h0 * 128 + uc8 + e; lb8[e] = 1.f / (1.f + __expf(sp.lbp[(0 * 2 + dir) * 512 + ch] - sp.lbp[(1 * 2 + dir) * 512 + ch])); } } }
        else {
            for (int u = tid; u < 16 * 128; u += NTHR) *(LAS float*)(lds + OFF_WUP + u * 4) = sp.wgu[((size_t)(li * 2 + dir) * 16 + (u >> 7)) * 512 + h0 * 128 + (u & 127)];
            if (tid < 128) *(LAS float*)(lds + OFF_WUP + 16 * 512 + tid * 4) = sp.bgp[(li * 2 + dir) * 512 + h0 * 128 + tid];
        }
        if (MODE) { const bf16* Lp = sp.L + ((((size_t)(b * 4 + h0 + hh) * G::NSC + sc) * 2 + dir) * G::L_ITEM) + (size_t)((vcol0 - hh * G::DVH) + r) * 128;
#pragma unroll
            for (int kt = 0; kt < 4; ++kt)
#pragma unroll
                for (int g4 = 0; g4 < 4; ++g4) { const v2u w = *(const GAS v2u*)(Lp + 32 * kt + 8 * g4 + 4 * h);
                    S[kt][4 * g4 + 0] = __uint_as_float(w.x << 16); S[kt][4 * g4 + 1] = __uint_as_float(w.x & 0xffff0000u); S[kt][4 * g4 + 2] = __uint_as_float(w.y << 16); S[kt][4 * g4 + 3] = __uint_as_float(w.y & 0xffff0000u); } }
        else {
#pragma unroll
            for (int kt = 0; kt < 4; ++kt)
#pragma unroll
                for (int e = 0; e < 16; ++e) S[kt][e] = 0.f; }
        v4u pz[NU], pq[NU], pv[2], pr[2], pog[2] = {{0u, 0u, 0u, 0u}, {0u, 0u, 0u, 0u}}, pgt[2] = {{0u, 0u, 0u, 0u}, {0u, 0u, 0u, 0u}};
#define SCAN_TOK(ci_, i_) (dir ? (sc0 + G::SCLEN - 1 - 32 * (ci_) - (i_)) : (sc0 + 32 * (ci_) + (i_)))
#define SCAN_LOAD(ci_) do { \
            _Pragma("unroll") for (int jj = 0; jj < NU; ++jj) { const bf16* row = Pb + (size_t)SCAN_TOK(ci_, ui0 + jj * (NTHR / UPR)) * G::NP; \
                pz[jj] = *(const GAS v4u*)(row + (ODD ? O_KC : (dir ? E_ZB : E_ZF)) + h0 * 128 + uc8); \
                if (MODE) pq[jj] = *(const GAS v4u*)(row + G::QOFF + h0 * 128 + uc8); \
                if (ODD) { pr[0] = *(const GAS v4u*)(row + (dir ? O_RB : O_RF)); pr[1] = *(const GAS v4u*)(row + (dir ? O_RB : O_RF) + 8); } } \
            _Pragma("unroll") for (int jj = 0; jj < 2; ++jj) pv[jj] = *(const GAS v4u*)(Pb + (size_t)SCAN_TOK(ci_, vi0 + 16 * jj) * G::NP + G::VOFF + h0 * G::DVH + vc8); \
            } while (0)
#define SCAN_LOAD_EPI(ci_) do { if (MODE && dd == 1) { const size_t m_ = (size_t)b * T + SCAN_TOK(ci_, ei); const bf16* og_ = sp.OG + m_ * (G::NHG * 256) + hg * 256 + evc; const bf16* mp_ = sp.MIX + m_ * NMIX + G::GOFF + h0 * G::DVH + evc; \
                pog[0] = *(const GAS v4u*)og_; pog[1] = *(const GAS v4u*)(og_ + 8); pgt[0] = *(const GAS v4u*)mp_; pgt[1] = *(const GAS v4u*)(mp_ + 8); } } while (0)
        if (ODD) __syncthreads();
        SCAN_LOAD(0); SCAN_LOAD_EPI(0);
#pragma unroll 1
        for (int ci = 0; ci < G::NCH; ++ci) {
            tid = tid0; lane = lane0; asm volatile("" : "+v"(tid), "+v"(lane));
            r = lane & 31; h = lane >> 5; i16 = lane & 15; q4 = i16 >> 2; p4 = i16 & 3; g1 = (lane >> 4) & 1;
            uc8 = (tid % UPR) * 8; ui0 = tid / UPR; vi0 = tid >> 5; vc8 = (tid & 31) * 8; ei = tid >> 4; evc = (tid & 15) * 16;
#pragma unroll
            for (int jj = 0; jj < NU; ++jj) { const int i = ui0 + jj * (NTHR / UPR); float gl[8];
                if (!ODD) {
#pragma unroll
                    for (int e = 0; e < 4; ++e) { const float z0 = __uint_as_float(pz[jj][e] << 16), z1 = __uint_as_float(pz[jj][e] & 0xffff0000u);
                        gl[2 * e] = __logf(fmaxf(lb8[2 * e] + (1.f - lb8[2 * e]) * sigmoidf_(z0), 1e-30f)); gl[2 * e + 1] = __logf(fmaxf(lb8[2 * e + 1] + (1.f - lb8[2 * e + 1]) * sigmoidf_(z1), 1e-30f)); } }
                else { float rv[16];
#pragma unroll
                    for (int e = 0; e < 4; ++e) { rv[2 * e] = __uint_as_float(pr[0][e] << 16); rv[2 * e + 1] = __uint_as_float(pr[0][e] & 0xffff0000u); rv[8 + 2 * e] = __uint_as_float(pr[1][e] << 16); rv[8 + 2 * e + 1] = __uint_as_float(pr[1][e] & 0xffff0000u); }
                    const f32x4 bb0 = *(const LAS f32x4*)(lds + OFF_WUP + 16 * 512 + uc8 * 4), bb1 = *(const LAS f32x4*)(lds + OFF_WUP + 16 * 512 + uc8 * 4 + 16);
                    float pre[8] = {bb0[0], bb0[1], bb0[2], bb0[3], bb1[0], bb1[1], bb1[2], bb1[3]};
#pragma unroll
                    for (int rr = 0; rr < 16; ++rr) { const f32x4 w0 = *(const LAS f32x4*)(lds + OFF_WUP + rr * 512 + uc8 * 4), w1 = *(const LAS f32x4*)(lds + OFF_WUP + rr * 512 + uc8 * 4 + 16);
                        pre[0] += rv[rr] * w0[0]; pre[1] += rv[rr] * w0[1]; pre[2] += rv[rr] * w0[2]; pre[3] += rv[rr] * w0[3]; pre[4] += rv[rr] * w1[0]; pre[5] += rv[rr] * w1[1]; pre[6] += rv[rr] * w1[2]; pre[7] += rv[rr] * w1[3]; }
#pragma unroll
                    for (int e = 0; e < 8; ++e) gl[e] = (fminf(pre[e], 0.f) - __logf(1.f + __expf(-fabsf(pre[e])))) * (1.f / 16.f); }
                f32x4 o0 = {gl[0], gl[1], gl[2], gl[3]}, o1 = {gl[4], gl[5], gl[6], gl[7]};
                *(LAS f32x4*)(lds + G::OFF_B + i * G::RSB + uc8 * 4) = o0; *(LAS f32x4*)(lds + G::OFF_B + i * G::RSB + uc8 * 4 + 16) = o1; }
            __syncthreads();
            if (tid < 2 * G::KH) { const int c = tid % G::KH, i0 = (tid / G::KH) * 16; float acc = 0.f;
#pragma unroll
                for (int i = 0; i < 16; ++i) { LAS float* p = (LAS float*)(lds + G::OFF_B + (i0 + i) * G::RSB + c * 4); acc += *p; *p = acc; } }
            __syncthreads();
#pragma unroll
            for (int jj = 0; jj < NU; ++jj) { const int i = ui0 + jj * (NTHR / UPR);
                const f32x4 b0 = *(const LAS f32x4*)(lds + G::OFF_B + i * G::RSB + uc8 * 4), b1 = *(const LAS f32x4*)(lds + G::OFF_B + i * G::RSB + uc8 * 4 + 16);
                const f32x4 r0 = *(const LAS f32x4*)(lds + G::OFF_B + 15 * G::RSB + uc8 * 4), r1 = *(const LAS f32x4*)(lds + G::OFF_B + 15 * G::RSB + uc8 * 4 + 16);
                const f32x4 e0 = *(const LAS f32x4*)(lds + G::OFF_B + 31 * G::RSB + uc8 * 4), e1 = *(const LAS f32x4*)(lds + G::OFF_B + 31 * G::RSB + uc8 * 4 + 16);
                float rr[8] = {r0[0], r0[1], r0[2], r0[3], r1[0], r1[1], r1[2], r1[3]};
                float bb[8] = {b0[0], b0[1], b0[2], b0[3], b1[0], b1[1], b1[2], b1[3]}, ee[8] = {e0[0], e0[1], e0[2], e0[3], e1[0], e1[1], e1[2], e1[3]};
#pragma unroll
                for (int e = 0; e < 8; ++e) { if (i >= 16) bb[e] += rr[e]; ee[e] += rr[e]; }
                float kk[8], qq[8];
                if (!ODD) {
#pragma unroll
                    for (int e = 0; e < 4; ++e) { kk[2 * e] = (1.f - lb8[2 * e]) * (1.f - sigmoidf_(__uint_as_float(pz[jj][e] << 16))); kk[2 * e + 1] = (1.f - lb8[2 * e + 1]) * (1.f - sigmoidf_(__uint_as_float(pz[jj][e] & 0xffff0000u))); }
                    if (MODE) {
#pragma unroll
                        for (int e = 0; e < 4; ++e) { qq[2 * e] = siluf_(__uint_as_float(pq[jj][e] << 16)); qq[2 * e + 1] = siluf_(__uint_as_float(pq[jj][e] & 0xffff0000u)); } } }
                else {
#pragma unroll
                    for (int e = 0; e < 4; ++e) { kk[2 * e] = __uint_as_float(pz[jj][e] << 16); kk[2 * e + 1] = __uint_as_float(pz[jj][e] & 0xffff0000u); }
                    if (MODE) {
#pragma unroll
                        for (int e = 0; e < 4; ++e) { qq[2 * e] = __uint_as_float(pq[jj][e] << 16) * 0.08838834764831845f; qq[2 * e + 1] = __uint_as_float(pq[jj][e] & 0xffff0000u) * 0.08838834764831845f; } } }
                v4u w;
                w.x = cvtpk(kk[0] * __expf(ee[0] - bb[0]), kk[1] * __expf(ee[1] - bb[1])); w.y = cvtpk(kk[2] * __expf(ee[2] - bb[2]), kk[3] * __expf(ee[3] - bb[3]));
                w.z = cvtpk(kk[4] * __expf(ee[4] - bb[4]), kk[5] * __expf(ee[5] - bb[5])); w.w = cvtpk(kk[6] * __expf(ee[6] - bb[6]), kk[7] * __expf(ee[7] - bb[7]));
                *(LAS v4u*)(lds + G::OFF_W + i * G::RST + uc8 * 2) = w;
                if (i == 31) { f32x4 d0 = {__expf(ee[0]), __expf(ee[1]), __expf(ee[2]), __expf(ee[3])}, d1 = {__expf(ee[4]), __expf(ee[5]), __expf(ee[6]), __expf(ee[7])};
                    *(LAS f32x4*)(lds + G::OFF_D + uc8 * 4) = d0; *(LAS f32x4*)(lds + G::OFF_D + uc8 * 4 + 16) = d1;
#pragma unroll
                    for (int e = 0; e < 8; ++e) logd8[e] += ee[e]; }
                if (MODE) {
                    float dl[8];
#pragma unroll
                    for (int e = 0; e < 8; ++e) dl[e] = bb[e] - rr[e];
                    w.x = cvtpk(qq[0] * __expf(bb[0]), qq[1] * __expf(bb[1])); w.y = cvtpk(qq[2] * __expf(bb[2]), qq[3] * __expf(bb[3]));
                    w.z = cvtpk(qq[4] * __expf(bb[4]), qq[5] * __expf(bb[5])); w.w = cvtpk(qq[6] * __expf(bb[6]), qq[7] * __expf(bb[7]));
                    *(LAS v4u*)(lds + G::OFF_Q1 + i * G::RSK + uc8 * 2) = w;
                    w.x = cvtpk(qq[0] * expc(dl[0]), qq[1] * expc(dl[1])); w.y = cvtpk(qq[2] * expc(dl[2]), qq[3] * expc(dl[3]));
                    w.z = cvtpk(qq[4] * expc(dl[4]), qq[5] * expc(dl[5])); w.w = cvtpk(qq[6] * expc(dl[6]), qq[7] * expc(dl[7]));
                    *(LAS v4u*)(lds + G::OFF_Q2 + i * G::RSK + uc8 * 2) = w;
                    w.x = cvtpk(kk[0] * expc(-dl[0]), kk[1] * expc(-dl[1])); w.y = cvtpk(kk[2] * expc(-dl[2]), kk[3] * expc(-dl[3]));
                    w.z = cvtpk(kk[4] * expc(-dl[4]), kk[5] * expc(-dl[5])); w.w = cvtpk(kk[6] * expc(-dl[6]), kk[7] * expc(-dl[7]));
                    *(LAS v4u*)(lds + G::OFF_K2 + i * G::RSK + uc8 * 2) = w;
                }
            }
#pragma unroll
            for (int jj = 0; jj < 2; ++jj) *(LAS v4u*)(lds + G::OFF_V + (vi0 + 16 * jj) * G::RSV + vc8 * 2) = pv[jj];
            if (ci + 1 < G::NCH) SCAN_LOAD(ci + 1);
            __syncthreads();
            f32x16 o;
            if (MODE) {
#pragma unroll
                for (int e = 0; e < 16; ++e) o[e] = 0.f;
#pragma unroll
                for (int kt = 0; kt < 4; ++kt)
#pragma unroll
                    for (int st = 0; st < 2; ++st) { const LAS unsigned char* qp = lds + G::OFF_Q1 + r * G::RSK + (kc0 + 32 * kt + 16 * st + 4 * h) * 2;
                        const s16x4 lo = *(const LAS s16x4*)qp, hi = *(const LAS s16x4*)(qp + 16);
                        const bf16x8 a = __builtin_shufflevector(lo, hi, 0, 1, 2, 3, 4, 5, 6, 7);
                        o = SC_MFMA(a, pack8(S[kt], st), o); }
                f32x16 at;
#pragma unroll
                for (int e = 0; e < 16; ++e) at[e] = 0.f;
#pragma unroll
                for (int ks = 0; ks < 8; ++ks) { const bf16x8 a = *(const LAS bf16x8*)(lds + G::OFF_K2 + r * G::RSK + (kc0 + 16 * ks + 8 * h) * 2), bq = *(const LAS bf16x8*)(lds + G::OFF_Q2 + r * G::RSK + (kc0 + 16 * ks + 8 * h) * 2);
                    at = SC_MFMA(a, bq, at); }
#pragma unroll
                for (int e = 0; e < 16; ++e) { const int srow = (e & 3) + 8 * (e >> 2) + 4 * h; at[e] = (srow <= r) ? at[e] : 0.f; }
#pragma unroll
                for (int st = 0; st < 2; ++st) { const LAS unsigned char* vp = lds + G::OFF_V + (16 * st + 4 * h + q4) * G::RSV + (vcol0 + 16 * g1 + 4 * p4) * 2;
                    const s16x4 lo = trd(vp), hi = trd(vp + 8 * G::RSV);
                    const bf16x8 bv = __builtin_shufflevector(lo, hi, 0, 1, 2, 3, 4, 5, 6, 7);
                    o = SC_MFMA(pack8(at, st), bv, o); }
            }
#pragma unroll
            for (int kt = 0; kt < 4; ++kt)
#pragma unroll
                for (int g4 = 0; g4 < 4; ++g4) { const f32x4 dv = *(const LAS f32x4*)(lds + G::OFF_D + (kc0 + 32 * kt + 8 * g4 + 4 * h) * 4);
#pragma unroll
                    for (int e = 0; e < 4; ++e) S[kt][4 * g4 + e] *= dv[e]; }
#pragma unroll
            for (int st = 0; st < 2; ++st) { const LAS unsigned char* vp = lds + G::OFF_V + (16 * st + 8 * h + q4) * G::RSV + (vcol0 + 16 * g1 + 4 * p4) * 2;
                const s16x4 vlo = trd(vp), vhi = trd(vp + 4 * G::RSV);
                const bf16x8 bv = __builtin_shufflevector(vlo, vhi, 0, 1, 2, 3, 4, 5, 6, 7);
#pragma unroll
                for (int kt = 0; kt < 4; ++kt) { const LAS unsigned char* wp = lds + G::OFF_W + (16 * st + 8 * h + q4) * G::RST + (kc0 + 32 * kt + 16 * g1 + 4 * p4) * 2;
                    const s16x4 wlo = trd(wp), whi = trd(wp + 4 * G::RST);
                    const bf16x8 aw = __builtin_shufflevector(wlo, whi, 0, 1, 2, 3, 4, 5, 6, 7);
                    S[kt] = SC_MFMA(aw, bv, S[kt]); } }
            if (MODE) {
#pragma unroll
                for (int e = 0; e < 16; ++e) *(LAS float*)(lds + G::OFF_B + ((e & 3) + 8 * (e >> 2) + 4 * h) * G::RSO + (vcol0 + r) * 4) = o[e];
                __syncthreads();
                { const size_t m = (size_t)b * T + SCAN_TOK(ci, ei);
                  float v[16];
#pragma unroll
                  for (int e4 = 0; e4 < 4; ++e4) { const f32x4 x = *(const LAS f32x4*)(lds + G::OFF_B + ei * G::RSO + (evc + 4 * e4) * 4); v[4 * e4] = x[0]; v[4 * e4 + 1] = x[1]; v[4 * e4 + 2] = x[2]; v[4 * e4 + 3] = x[3]; }
                  if (dd == 0) { bf16* og = sp.OG + m * (G::NHG * 256) + hg * 256 + evc;
                      v4u w0, w1; w0.x = cvtpk(v[0], v[1]); w0.y = cvtpk(v[2], v[3]); w0.z = cvtpk(v[4], v[5]); w0.w = cvtpk(v[6], v[7]); w1.x = cvtpk(v[8], v[9]); w1.y = cvtpk(v[10], v[11]); w1.z = cvtpk(v[12], v[13]); w1.w = cvtpk(v[14], v[15]);
                      *(GAS v4u*)og = w0; *(GAS v4u*)(og + 8) = w1; }
                  else { float ss = 0.f;
#pragma unroll
                      for (int e = 0; e < 4; ++e) { v[2 * e] += __uint_as_float(pog[0][e] << 16); v[2 * e + 1] += __uint_as_float(pog[0][e] & 0xffff0000u); v[8 + 2 * e] += __uint_as_float(pog[1][e] << 16); v[8 + 2 * e + 1] += __uint_as_float(pog[1][e] & 0xffff0000u); }
#pragma unroll
                      for (int e = 0; e < 16; ++e) ss += v[e] * v[e];
#pragma unroll
                      for (int o_ = 1; o_ < G::DVH / 16; o_ <<= 1) ss += __shfl_xor(ss, o_);
                      const float rstd = 1.f / sqrtf(ss * (1.f / G::DVH) + EPS);
                      bf16* mp = sp.MIX + m * NMIX + G::GOFF + h0 * G::DVH + evc; const float* gwp = sp.gnw + li * (4 * G::DVH) + h0 * G::DVH + evc;
                      float gt[16];
#pragma unroll
                      for (int e = 0; e < 4; ++e) { gt[2 * e] = __uint_as_float(pgt[0][e] << 16); gt[2 * e + 1] = __uint_as_float(pgt[0][e] & 0xffff0000u); gt[8 + 2 * e] = __uint_as_float(pgt[1][e] << 16); gt[8 + 2 * e + 1] = __uint_as_float(pgt[1][e] & 0xffff0000u); }
#pragma unroll
                      for (int e4 = 0; e4 < 4; ++e4) { const f32x4 gw4 = *(const GAS f32x4*)(gwp + 4 * e4);
#pragma unroll
                          for (int e = 0; e < 4; ++e) v[4 * e4 + e] = v[4 * e4 + e] * rstd * gw4[e] * siluf_(gt[4 * e4 + e]); }
                      v4u w0o, w1o; w0o.x = cvtpk(v[0], v[1]); w0o.y = cvtpk(v[2], v[3]); w0o.z = cvtpk(v[4], v[5]); w0o.w = cvtpk(v[6], v[7]); w1o.x = cvtpk(v[8], v[9]); w1o.y = cvtpk(v[10], v[11]); w1o.z = cvtpk(v[12], v[13]); w1o.w = cvtpk(v[14], v[15]);
                      *(GAS v4u*)mp = w0o; *(GAS v4u*)(mp + 8) = w1o; }
                }
                if (ci + 1 < G::NCH) SCAN_LOAD_EPI(ci + 1);
            }
            __syncthreads();
        }
#undef SCAN_LOAD_EPI
#undef SCAN_LOAD
#undef SCAN_TOK
        if (!MODE) {
            bf16* Lp = sp.L + ((((size_t)(b * 4 + h0 + hh) * G::NSC + sc) * 2 + dir) * G::L_ITEM) + (size_t)((vcol0 - hh * G::DVH) + r) * 128;
#pragma unroll
            for (int kt = 0; kt < 4; ++kt)
#pragma unroll
                for (int g4 = 0; g4 < 4; ++g4) { v2u w; w.x = cvtpk(S[kt][4 * g4], S[kt][4 * g4 + 1]); w.y = cvtpk(S[kt][4 * g4 + 2], S[kt][4 * g4 + 3]); *(GAS v2u*)(Lp + 32 * kt + 8 * g4 + 4 * h) = w; }
            if (ui0 + (NU - 1) * (NTHR / UPR) == 31) {
                float* ld = sp.LOGD + (((size_t)(b * 4 + h0 + (uc8 >> 7)) * G::NSC + sc) * 2 + dir) * 128 + (uc8 & 127);
                f32x4 l0 = {logd8[0], logd8[1], logd8[2], logd8[3]}, l1 = {logd8[4], logd8[5], logd8[6], logd8[7]};
                *(GAS f32x4*)ld = l0; *(GAS f32x4*)(ld + 4) = l1; }
        }
        if (MODE) { asm volatile("s_waitcnt vmcnt(0)" ::: "memory"); __syncthreads(); }
    }
}

template <int ODD, int MODE>
__device__ __forceinline__ void scan_item3(const Ctx& C, const ScanPtrs& sp, int li, int b, int hg, int sc, int dir0) {
    typedef Geo<ODD> G;
    constexpr int NU = G::KH / 128, UPR = G::KH / 8, RPU = NTHR / UPR;
    constexpr int OFF_B = 0, OFF_O = 32768, OFF_Q1 = OFF_O + 32 * G::RSO, OFF_Q2 = OFF_Q1 + 32 * G::RSK, OFF_K2 = OFF_Q2 + 32 * G::RSK, OFF_W = OFF_K2 + 32 * G::RSK,
                  OFF_V = OFF_W + 32 * G::RST, OFF_D = OFF_V + 32 * G::RSV, OFF_ER = OFF_D + 1024, OFF_EBR = OFF_ER + 1024, OFF_WUP = OFF_EBR + 1024, OFF_END3 = OFF_WUP + (ODD ? 16 * 512 + 512 : 1024);
    static_assert(OFF_END3 <= RING_BYTES, "scan v3 LDS map");
    const int tid0 = C.tid, wave = C.wave; int lane0 = C.lane; asm volatile("" : "+v"(lane0));
    int tid = tid0, lane = lane0; int r = lane & 31, h = lane >> 5, i16 = lane & 15, q4 = i16 >> 2, p4 = i16 & 3, g1 = (lane >> 4) & 1;
    const int hh = wave / (8 / G::NH), h0 = hg * G::NH;
    const int kc0 = hh * 128, vcol0 = wave * 32;
    LAS unsigned char* lds = C.lds;
    const int sc0 = sc * G::SCLEN;
    const bf16* Pb = sp.P + (size_t)b * T * G::NP;
    int uc8 = (tid % UPR) * 8, ui0 = tid / UPR, vi0 = tid >> 5, vc8 = (tid & 31) * 8, ei = tid >> 4, evc = (tid & 15) * 16;
    f32x16 S[4];
    for (int dd = 0; dd < (MODE ? 2 : 1); ++dd) {
        const int dir = MODE ? dd : dir0;
        float logd8[8];
#pragma unroll
        for (int e = 0; e < 8; ++e) logd8[e] = 0.f;
        if (!ODD) { if (tid < G::KH) { const int ch = h0 * 128 + tid; float lbv = 0.f;
                if (li == 1) lbv = 1.f / (1.f + __expf(sp.lbp[(0 * 2 + dir) * 512 + ch] - sp.lbp[(1 * 2 + dir) * 512 + ch]));
                *(LAS float*)(lds + OFF_WUP + tid * 4) = lbv; } }
        else {
            for (int u = tid; u < 16 * 128; u += NTHR) *(LAS float*)(lds + OFF_WUP + u * 4) = sp.wgu[((size_t)(li * 2 + dir) * 16 + (u >> 7)) * 512 + h0 * 128 + (u & 127)];
            if (tid < 128) *(LAS float*)(lds + OFF_WUP + 16 * 512 + tid * 4) = sp.bgp[(li * 2 + dir) * 512 + h0 * 128 + tid];
        }
        v4u pg[NU][ODD ? 2 : 1];
        v4u pk[NU], pq[NU], pv[2], pog[2] = {{0u, 0u, 0u, 0u}, {0u, 0u, 0u, 0u}}, pgt[2] = {{0u, 0u, 0u, 0u}, {0u, 0u, 0u, 0u}};
#define S3_TOK(ci_, i_) (dir ? (sc0 + G::SCLEN - 1 - 32 * (ci_) - (i_)) : (sc0 + 32 * (ci_) + (i_)))
#define S3_LOAD_G(ci_) do { _Pragma("unroll") for (int jj = 0; jj < NU; ++jj) { const bf16* row = Pb + (size_t)S3_TOK(ci_, ui0 + jj * RPU) * G::NP; \
            if (!ODD) pg[jj][0] = *(const GAS v4u*)(row + (dir ? E_ZB : E_ZF) + h0 * 128 + uc8); \
            else { pg[jj][0] = *(const GAS v4u*)(row + (dir ? O_RB : O_RF)); pg[jj][ODD ? 1 : 0] = *(const GAS v4u*)(row + (dir ? O_RB : O_RF) + 8); } } } while (0)
#define S3_LOAD_M(ci_) do { _Pragma("unroll") for (int jj = 0; jj < NU; ++jj) { const bf16* row = Pb + (size_t)S3_TOK(ci_, ui0 + jj * RPU) * G::NP; \
            if (ODD) pk[jj] = *(const GAS v4u*)(row + O_KC + h0 * 128 + uc8); \
            if (MODE) pq[jj] = *(const GAS v4u*)(row + G::QOFF + h0 * 128 + uc8); } \
            _Pragma("unroll") for (int jj = 0; jj < 2; ++jj) pv[jj] = *(const GAS v4u*)(Pb + (size_t)S3_TOK(ci_, vi0 + 16 * jj) * G::NP + G::VOFF + h0 * G::DVH + vc8); } while (0)
#define S3_LOAD_E(ci_) do { if (MODE && dd == 1) { const size_t m_ = (size_t)b * T + S3_TOK(ci_, ei); const bf16* og_ = sp.OG + m_ * (G::NHG * 256) + hg * 256 + evc; const bf16* mp_ = sp.MIX + m_ * NMIX + G::GOFF + h0 * G::DVH + evc; \
            pog[0] = *(const GAS v4u*)og_; pog[1] = *(const GAS v4u*)(og_ + 8); pgt[0] = *(const GAS v4u*)mp_; pgt[1] = *(const GAS v4u*)(mp_ + 8); } } while (0)
#define S3_STAGE_A() do { _Pragma("unroll") for (int jj = 0; jj < NU; ++jj) { const int i = ui0 + jj * RPU; float gl[8]; \
            if (!ODD) { const f32x4 l0_ = *(const LAS f32x4*)(lds + OFF_WUP + uc8 * 4), l1_ = *(const LAS f32x4*)(lds + OFF_WUP + uc8 * 4 + 16); const float lb8[8] = {l0_[0], l0_[1], l0_[2], l0_[3], l1_[0], l1_[1], l1_[2], l1_[3]}; \
                _Pragma("unroll") for (int e = 0; e < 4; ++e) { const float s0 = sigmoidf_(__uint_as_float(pg[jj][0][e] << 16)), s1 = sigmoidf_(__uint_as_float(pg[jj][0][e] & 0xffff0000u)); \
                    gl[2 * e] = __logf(fmaxf(lb8[2 * e] + (1.f - lb8[2 * e]) * s0, 1e-30f)); gl[2 * e + 1] = __logf(fmaxf(lb8[2 * e + 1] + (1.f - lb8[2 * e + 1]) * s1, 1e-30f)); \
                    } } \
            else { float rv[16]; \
                _Pragma("unroll") for (int e = 0; e < 4; ++e) { rv[2 * e] = __uint_as_float(pg[jj][0][e] << 16); rv[2 * e + 1] = __uint_as_float(pg[jj][0][e] & 0xffff0000u); rv[8 + 2 * e] = __uint_as_float(pg[jj][ODD ? 1 : 0][e] << 16); rv[8 + 2 * e + 1] = __uint_as_float(pg[jj][ODD ? 1 : 0][e] & 0xffff0000u); } \
                const f32x4 bb0 = *(const LAS f32x4*)(lds + OFF_WUP + 16 * 512 + uc8 * 4), bb1 = *(const LAS f32x4*)(lds + OFF_WUP + 16 * 512 + uc8 * 4 + 16); \
                float pre[8] = {bb0[0], bb0[1], bb0[2], bb0[3], bb1[0], bb1[1], bb1[2], bb1[3]}; \
                _Pragma("unroll") for (int rr = 0; rr < 16; ++rr) { const f32x4 w0 = *(const LAS f32x4*)(lds + OFF_WUP + rr * 512 + uc8 * 4), w1 = *(const LAS f32x4*)(lds + OFF_WUP + rr * 512 + uc8 * 4 + 16); \
                    pre[0] += rv[rr] * w0[0]; pre[1] += rv[rr] * w0[1]; pre[2] += rv[rr] * w0[2]; pre[3] += rv[rr] * w0[3]; pre[4] += rv[rr] * w1[0]; pre[5] += rv[rr] * w1[1]; pre[6] += rv[rr] * w1[2]; pre[7] += rv[rr] * w1[3]; } \
                _Pragma("unroll") for (int e = 0; e < 8; ++e) gl[e] = (fminf(pre[e], 0.f) - __logf(1.f + __expf(-fabsf(pre[e])))) * (1.f / 16.f); } \
            f32x4 o0 = {gl[0], gl[1], gl[2], gl[3]}, o1 = {gl[4], gl[5], gl[6], gl[7]}; \
            *(LAS f32x4*)(lds + OFF_B + i * G::RSB + uc8 * 4) = o0; *(LAS f32x4*)(lds + OFF_B + i * G::RSB + uc8 * 4 + 16) = o1; } } while (0)
#define S3_STAGE_B() do { if (tid < 2 * G::KH) { const int c = tid % G::KH, i0 = (tid / G::KH) * 16; float gv[16]; \
            _Pragma("unroll") for (int i = 0; i < 16; ++i) gv[i] = *(const LAS float*)(lds + OFF_B + (i0 + i) * G::RSB + c * 4); \
            _Pragma("unroll") for (int i = 1; i < 16; ++i) gv[i] += gv[i - 1]; \
            _Pragma("unroll") for (int i = 0; i < 16; ++i) *(LAS float*)(lds + OFF_B + (i0 + i) * G::RSB + c * 4) = gv[i]; \
            *(LAS float*)(lds + (i0 ? OFF_EBR : OFF_ER) + c * 4) = __expf(gv[15]); } } while (0)
        if (MODE) { const bf16* Lp = sp.L + ((((size_t)(b * 4 + h0 + hh) * G::NSC + sc) * 2 + dir) * G::L_ITEM) + (size_t)((vcol0 - hh * G::DVH) + r) * 128;
#pragma unroll
            for (int kt = 0; kt < 4; ++kt)
#pragma unroll
                for (int g4 = 0; g4 < 4; ++g4) { const v2u w = *(const GAS v2u*)(Lp + 32 * kt + 8 * g4 + 4 * h);
                    S[kt][4 * g4 + 0] = __uint_as_float(w.x << 16); S[kt][4 * g4 + 1] = __uint_as_float(w.x & 0xffff0000u); S[kt][4 * g4 + 2] = __uint_as_float(w.y << 16); S[kt][4 * g4 + 3] = __uint_as_float(w.y & 0xffff0000u); } }
        else {
#pragma unroll
            for (int kt = 0; kt < 4; ++kt)
#pragma unroll
                for (int e = 0; e < 16; ++e) S[kt][e] = 0.f; }
        S3_LOAD_G(0); S3_LOAD_M(0); S3_LOAD_E(0);
        __syncthreads();
        S3_STAGE_A();
        S3_LOAD_G(1);
        __syncthreads();
        S3_STAGE_B();
        __syncthreads();
#pragma unroll 1
        for (int ci = 0; ci < G::NCH; ++ci) {
            tid = tid0; lane = lane0; asm volatile("" : "+v"(tid), "+v"(lane));
            r = lane & 31; h = lane >> 5; i16 = lane & 15; q4 = i16 >> 2; p4 = i16 & 3; g1 = (lane >> 4) & 1;
            uc8 = (tid % UPR) * 8; ui0 = tid / UPR; vi0 = tid >> 5; vc8 = (tid & 31) * 8; ei = tid >> 4; evc = (tid & 15) * 16;
#pragma unroll
            for (int jj = 0; jj < NU; ++jj) { const int i = ui0 + jj * RPU;
                const f32x4 b0 = *(const LAS f32x4*)(lds + OFF_B + i * G::RSB + uc8 * 4), b1 = *(const LAS f32x4*)(lds + OFF_B + i * G::RSB + uc8 * 4 + 16);
                const f32x4 r0 = *(const LAS f32x4*)(lds + OFF_B + 15 * G::RSB + uc8 * 4), r1 = *(const LAS f32x4*)(lds + OFF_B + 15 * G::RSB + uc8 * 4 + 16);
                const f32x4 er0 = *(const LAS f32x4*)(lds + OFF_ER + uc8 * 4), er1 = *(const LAS f32x4*)(lds + OFF_ER + uc8 * 4 + 16);
                const f32x4 eb0 = *(const LAS f32x4*)(lds + OFF_EBR + uc8 * 4), eb1 = *(const LAS f32x4*)(lds + OFF_EBR + uc8 * 4 + 16);
                const float rr[8] = {r0[0], r0[1], r0[2], r0[3], r1[0], r1[1], r1[2], r1[3]}, bl[8] = {b0[0], b0[1], b0[2], b0[3], b1[0], b1[1], b1[2], b1[3]};
                const float er[8] = {er0[0], er0[1], er0[2], er0[3], er1[0], er1[1], er1[2], er1[3]}, ebr[8] = {eb0[0], eb0[1], eb0[2], eb0[3], eb1[0], eb1[1], eb1[2], eb1[3]};
                float dl[8];
#pragma unroll
                for (int e = 0; e < 8; ++e) dl[e] = (i >= 16) ? bl[e] : bl[e] - rr[e];
                float qq[8], kx[8];
                if (ODD) {
#pragma unroll
                    for (int e = 0; e < 4; ++e) { kx[2 * e] = __uint_as_float(pk[jj][e] << 16); kx[2 * e + 1] = __uint_as_float(pk[jj][e] & 0xffff0000u); } }
                else { f32x4 p0 = {0.f, 0.f, 0.f, 0.f}, p1 = {0.f, 0.f, 0.f, 0.f};
                    if ((i & 15) != 0) { p0 = *(const LAS f32x4*)(lds + OFF_B + (i - 1) * G::RSB + uc8 * 4); p1 = *(const LAS f32x4*)(lds + OFF_B + (i - 1) * G::RSB + uc8 * 4 + 16); }
                    const float pb[8] = {p0[0], p0[1], p0[2], p0[3], p1[0], p1[1], p1[2], p1[3]};
#pragma unroll
                    for (int e = 0; e < 8; ++e) kx[e] = 1.f - __expf(bl[e] - pb[e]); }
                if (MODE) {
#pragma unroll
                    for (int e = 0; e < 4; ++e) { const float q0 = __uint_as_float(pq[jj][e] << 16), q1 = __uint_as_float(pq[jj][e] & 0xffff0000u);
                        qq[2 * e] = ODD ? q0 * 0.08838834764831845f : siluf_(q0); qq[2 * e + 1] = ODD ? q1 * 0.08838834764831845f : siluf_(q1); } }
                float k2[8], q2[8];
#pragma unroll
                for (int e = 0; e < 8; ++e) { const float e1 = __expf(fminf(fmaxf(dl[e], -80.f), 80.f)); k2[e] = kx[e] * __builtin_amdgcn_rcpf(e1); if (MODE) q2[e] = qq[e] * e1; }
                v4u w;
                w.x = cvtpk(k2[0] * ebr[0], k2[1] * ebr[1]); w.y = cvtpk(k2[2] * ebr[2], k2[3] * ebr[3]); w.z = cvtpk(k2[4] * ebr[4], k2[5] * ebr[5]); w.w = cvtpk(k2[6] * ebr[6], k2[7] * ebr[7]);
                *(LAS v4u*)(lds + OFF_W + i * G::RST + uc8 * 2) = w;
                if (i == 31) { f32x4 d0 = {er[0] * ebr[0], er[1] * ebr[1], er[2] * ebr[2], er[3] * ebr[3]}, d1 = {er[4] * ebr[4], er[5] * ebr[5], er[6] * ebr[6], er[7] * ebr[7]};
                    *(LAS f32x4*)(lds + OFF_D + uc8 * 4) = d0; *(LAS f32x4*)(lds + OFF_D + uc8 * 4 + 16) = d1;
#pragma unroll
                    for (int e = 0; e < 8; ++e) logd8[e] += bl[e] + rr[e]; }
                if (MODE) {
                    w.x = cvtpk(q2[0] * er[0], q2[1] * er[1]); w.y = cvtpk(q2[2] * er[2], q2[3] * er[3]); w.z = cvtpk(q2[4] * er[4], q2[5] * er[5]); w.w = cvtpk(q2[6] * er[6], q2[7] * er[7]);
                    *(LAS v4u*)(lds + OFF_Q1 + i * G::RSK + uc8 * 2) = w;
                    w.x = cvtpk(q2[0], q2[1]); w.y = cvtpk(q2[2], q2[3]); w.z = cvtpk(q2[4], q2[5]); w.w = cvtpk(q2[6], q2[7]);
                    *(LAS v4u*)(lds + OFF_Q2 + i * G::RSK + uc8 * 2) = w;
                    w.x = cvtpk(k2[0], k2[1]); w.y = cvtpk(k2[2], k2[3]); w.z = cvtpk(k2[4], k2[5]); w.w = cvtpk(k2[6], k2[7]);
                    *(LAS v4u*)(lds + OFF_K2 + i * G::RSK + uc8 * 2) = w;
                }
            }
#pragma unroll
            for (int jj = 0; jj < 2; ++jj) *(LAS v4u*)(lds + OFF_V + (vi0 + 16 * jj) * G::RSV + vc8 * 2) = pv[jj];
            { const int cn1 = (ci + 1 < G::NCH) ? ci + 1 : G::NCH - 1; S3_LOAD_M(cn1); }
            __syncthreads();
            f32x16 o;
            if (MODE) {
#pragma unroll
                for (int e = 0; e < 16; ++e) o[e] = 0.f;
#pragma unroll
                for (int kt = 0; kt < 4; ++kt)
#pragma unroll
                    for (int st = 0; st < 2; ++st) { const LAS unsigned char* qp = lds + OFF_Q1 + r * G::RSK + (kc0 + 32 * kt + 16 * st + 4 * h) * 2;
                        const s16x4 lo = *(const LAS s16x4*)qp, hi = *(const LAS s16x4*)(qp + 16);
                        const bf16x8 a = __builtin_shufflevector(lo, hi, 0, 1, 2, 3, 4, 5, 6, 7);
                        o = SC_MFMA(a, pack8(S[kt], st), o); }
                f32x16 at;
#pragma unroll
                for (int e = 0; e < 16; ++e) at[e] = 0.f;
#pragma unroll
                for (int ks = 0; ks < 8; ++ks) { const bf16x8 a = *(const LAS bf16x8*)(lds + OFF_K2 + r * G::RSK + (kc0 + 16 * ks + 8 * h) * 2), bq = *(const LAS bf16x8*)(lds + OFF_Q2 + r * G::RSK + (kc0 + 16 * ks + 8 * h) * 2);
                    at = SC_MFMA(a, bq, at); }
#pragma unroll
                for (int e = 0; e < 16; ++e) { const int srow = (e & 3) + 8 * (e >> 2) + 4 * h; at[e] = (srow <= r) ? at[e] : 0.f; }
#pragma unroll
                for (int st = 0; st < 2; ++st) { const LAS unsigned char* vp = lds + OFF_V + (16 * st + 4 * h + q4) * G::RSV + (vcol0 + 16 * g1 + 4 * p4) * 2;
                    const s16x4 lo = trd(vp), hi = trd(vp + 8 * G::RSV);
                    const bf16x8 bv = __builtin_shufflevector(lo, hi, 0, 1, 2, 3, 4, 5, 6, 7);
                    o = SC_MFMA(pack8(at, st), bv, o); }
            }
#pragma unroll
            for (int kt = 0; kt < 4; ++kt)
#pragma unroll
                for (int g4 = 0; g4 < 4; ++g4) { const f32x4 dv = *(const LAS f32x4*)(lds + OFF_D + (kc0 + 32 * kt + 8 * g4 + 4 * h) * 4);
#pragma unroll
                    for (int e = 0; e < 4; ++e) S[kt][4 * g4 + e] *= dv[e]; }
#pragma unroll
            for (int st = 0; st < 2; ++st) { const LAS unsigned char* vp = lds + OFF_V + (16 * st + 8 * h + q4) * G::RSV + (vcol0 + 16 * g1 + 4 * p4) * 2;
                const s16x4 vlo = trd(vp), vhi = trd(vp + 4 * G::RSV);
                const bf16x8 bv = __builtin_shufflevector(vlo, vhi, 0, 1, 2, 3, 4, 5, 6, 7);
#pragma unroll
                for (int kt = 0; kt < 4; ++kt) { const LAS unsigned char* wp = lds + OFF_W + (16 * st + 8 * h + q4) * G::RST + (kc0 + 32 * kt + 16 * g1 + 4 * p4) * 2;
                    const s16x4 wlo = trd(wp), whi = trd(wp + 4 * G::RST);
                    const bf16x8 aw = __builtin_shufflevector(wlo, whi, 0, 1, 2, 3, 4, 5, 6, 7);
                    S[kt] = SC_MFMA(aw, bv, S[kt]); } }
            if (MODE) {
#pragma unroll
                for (int e = 0; e < 16; ++e) *(LAS float*)(lds + OFF_O + ((e & 3) + 8 * (e >> 2) + 4 * h) * G::RSO + (vcol0 + r) * 4) = o[e]; }
            { S3_STAGE_A(); const int cn2 = (ci + 2 < G::NCH) ? ci + 2 : G::NCH - 1; S3_LOAD_G(cn2); }
            __syncthreads();
            S3_STAGE_B();
            if (MODE) {
                const size_t m = (size_t)b * T + S3_TOK(ci, ei);
                float v[16];
#pragma unroll
                for (int e4 = 0; e4 < 4; ++e4) { const f32x4 x = *(const LAS f32x4*)(lds + OFF_O + ei * G::RSO + (evc + 4 * e4) * 4); v[4 * e4] = x[0]; v[4 * e4 + 1] = x[1]; v[4 * e4 + 2] = x[2]; v[4 * e4 + 3] = x[3]; }
                if (dd == 0) { bf16* og = sp.OG + m * (G::NHG * 256) + hg * 256 + evc;
                    v4u w0, w1; w0.x = cvtpk(v[0], v[1]); w0.y = cvtpk(v[2], v[3]); w0.z = cvtpk(v[4], v[5]); w0.w = cvtpk(v[6], v[7]); w1.x = cvtpk(v[8], v[9]); w1.y = cvtpk(v[10], v[11]); w1.z = cvtpk(v[12], v[13]); w1.w = cvtpk(v[14], v[15]);
                    *(GAS v4u*)og = w0; *(GAS v4u*)(og + 8) = w1; }
                else { float ss = 0.f;
#pragma unroll
                    for (int e = 0; e < 4; ++e) { v[2 * e] += __uint_as_float(pog[0][e] << 16); v[2 * e + 1] += __uint_as_float(pog[0][e] & 0xffff0000u); v[8 + 2 * e] += __uint_as_float(pog[1][e] << 16); v[8 + 2 * e + 1] += __uint_as_float(pog[1][e] & 0xffff0000u); }
#pragma unroll
                    for (int e = 0; e < 16; ++e) ss += v[e] * v[e];
#pragma unroll
                    for (int o_ = 1; o_ < G::DVH / 16; o_ <<= 1) ss += __shfl_xor(ss, o_);
                    const float rstd = 1.f / sqrtf(ss * (1.f / G::DVH) + EPS);
                    bf16* mp = sp.MIX + m * NMIX + G::GOFF + h0 * G::DVH + evc; const float* gwp = sp.gnw + li * (4 * G::DVH) + h0 * G::DVH + evc;
                    float gt[16];
#pragma unroll
                    for (int e = 0; e < 4; ++e) { gt[2 * e] = __uint_as_float(pgt[0][e] << 16); gt[2 * e + 1] = __uint_as_float(pgt[0][e] & 0xffff0000u); gt[8 + 2 * e] = __uint_as_float(pgt[1][e] << 16); gt[8 + 2 * e + 1] = __uint_as_float(pgt[1][e] & 0xffff0000u); }
#pragma unroll
                    for (int e4 = 0; e4 < 4; ++e4) { const f32x4 gw4 = *(const GAS f32x4*)(gwp + 4 * e4);
#pragma unroll
                        for (int e = 0; e < 4; ++e) v[4 * e4 + e] = v[4 * e4 + e] * rstd * gw4[e] * siluf_(gt[4 * e4 + e]); }
                    v4u w0o, w1o; w0o.x = cvtpk(v[0], v[1]); w0o.y = cvtpk(v[2], v[3]); w0o.z = cvtpk(v[4], v[5]); w0o.w = cvtpk(v[6], v[7]); w1o.x = cvtpk(v[8], v[9]); w1o.y = cvtpk(v[10], v[11]); w1o.z = cvtpk(v[12], v[13]); w1o.w = cvtpk(v[14], v[15]);
                    *(GAS v4u*)mp = w0o; *(GAS v4u*)(mp + 8) = w1o; }
                { const int cn1 = (ci + 1 < G::NCH) ? ci + 1 : G::NCH - 1; S3_LOAD_E(cn1); }
            }
            __syncthreads();
        }
#undef S3_STAGE_B
#undef S3_STAGE_A
#undef S3_LOAD_E
#undef S3_LOAD_M
#undef S3_LOAD_G
#undef S3_TOK
        if (!MODE) {
            bf16* Lp = sp.L + ((((size_t)(b * 4 + h0 + hh) * G::NSC + sc) * 2 + dir) * G::L_ITEM) + (size_t)((vcol0 - hh * G::DVH) + r) * 128;
#pragma unroll
            for (int kt = 0; kt < 4; ++kt)
#pragma unroll
                for (int g4 = 0; g4 < 4; ++g4) { v2u w; w.x = cvtpk(S[kt][4 * g4], S[kt][4 * g4 + 1]); w.y = cvtpk(S[kt][4 * g4 + 2], S[kt][4 * g4 + 3]); *(GAS v2u*)(Lp + 32 * kt + 8 * g4 + 4 * h) = w; }
            if (ui0 + (NU - 1) * RPU == 31) {
                float* ld = sp.LOGD + (((size_t)(b * 4 + h0 + (uc8 >> 7)) * G::NSC + sc) * 2 + dir) * 128 + (uc8 & 127);
                f32x4 l0 = {logd8[0], logd8[1], logd8[2], logd8[3]}, l1 = {logd8[4], logd8[5], logd8[6], logd8[7]};
                *(GAS f32x4*)ld = l0; *(GAS f32x4*)(ld + 4) = l1; }
        }
        if (MODE) { asm volatile("s_waitcnt vmcnt(0)" ::: "memory"); __syncthreads(); }
    }
}

template <int ODD>
__device__ __forceinline__ void scan_combine(const Ctx& C, const ScanPtrs& sp) {
    typedef Geo<ODD> G;
    const int nunits = 16 * 2 * G::DVH * 16;
    for (int u = C.bid * NTHR + C.tid; u < nunits; u += C.G * NTHR) {
        const int k8 = (u & 15) * 8, j = (u >> 4) % G::DVH, dir = ((u >> 4) / G::DVH) & 1, bh = (u >> 4) / (G::DVH * 2);
        float S[8];
#pragma unroll
        for (int e = 0; e < 8; ++e) S[e] = 0.f;
#pragma unroll 4
        for (int s = 0; s < G::NSC; ++s) { const int sc = dir ? (G::NSC - 1 - s) : s;
            bf16* p = sp.L + (((size_t)bh * G::NSC + sc) * 2 + dir) * G::L_ITEM + (size_t)j * 128 + k8;
            const float* ld = sp.LOGD + (((size_t)bh * G::NSC + sc) * 2 + dir) * 128 + k8;
            const v4u w = *(const GAS v4u*)p; const f32x4 d0 = *(const GAS f32x4*)ld, d1 = *(const GAS f32x4*)(ld + 4);
            v4u o; o.x = cvtpk(S[0], S[1]); o.y = cvtpk(S[2], S[3]); o.z = cvtpk(S[4], S[5]); o.w = cvtpk(S[6], S[7]);
            *(GAS v4u*)p = o;
            const float dd[8] = {d0[0], d0[1], d0[2], d0[3], d1[0], d1[1], d1[2], d1[3]};
#pragma unroll
            for (int e = 0; e < 4; ++e) { S[2 * e] = __expf(dd[2 * e]) * S[2 * e] + __uint_as_float(w[e] << 16); S[2 * e + 1] = __expf(dd[2 * e + 1]) * S[2 * e + 1] + __uint_as_float(w[e] & 0xffff0000u); }
        }
    }
}
}

namespace attn {
using scan::bf16x8; using scan::s16x4; using scan::f32x16; using scan::cvtpk; using scan::trd; using scan::pack8;
constexpr int WK_RS = 144, WV_RS = 192, WK_OFF = 0, WV_OFF = 384 * WK_RS;
static_assert(WV_OFF + 384 * WV_RS <= RING_BYTES, "window attention LDS");
constexpr int MK_RS = 272, MV_RS = 520, MK_OFF = 0, MV_OFF = 256 * MK_RS;
static_assert(MV_OFF + 128 * MV_RS <= RING_BYTES + 8192, "memory attention LDS");

__device__ __forceinline__ void winattn_unit(const Ctx& C, const bf16* P, bf16* MIX, const float* sink8, int b, int n, int c) {
    const int tid = C.tid, wave = C.wave; int lane = C.lane; asm volatile("" : "+v"(lane));
    const int r = lane & 31, h = lane >> 5, i16 = lane & 15, q4 = i16 >> 2, p4 = i16 & 3, g1 = (lane >> 4) & 1;
    LAS unsigned char* lds = C.lds;
    const int hq = 4 * n + (wave >> 1);
    bf16x8 qf[2][4];
#pragma unroll
    for (int tt = 0; tt < 2; ++tt)
#pragma unroll
        for (int ks = 0; ks < 4; ++ks) qf[tt][ks] = *(const GAS bf16x8*)(P + ((size_t)b * T + 128 * c + 32 * (2 * (wave & 1) + tt) + r) * NP_E + E_QA + hq * 64 + 16 * ks + 8 * h);
    { v4u kv[6], vv[6];
#pragma unroll
      for (int it = 0; it < 6; ++it) { const int u = tid + it * NTHR, j = u >> 3, c8 = (u & 7) * 8, s = 128 * (c - 1) + j, sc_ = s < 0 ? 0 : (s >= T ? T - 1 : s);
          const bf16* row = P + (size_t)(b * T + sc_) * NP_E; kv[it] = *(const GAS v4u*)(row + E_KA + n * 64 + c8); vv[it] = *(const GAS v4u*)(row + E_VA + n * 64 + c8); }
#pragma unroll
      for (int it = 0; it < 6; ++it) { const int u = tid + it * NTHR, j = u >> 3, c8 = (u & 7) * 8, s = 128 * (c - 1) + j; const bool ok = (s >= 0) && (s < T); const v4u z = {0u, 0u, 0u, 0u};
          *(LAS v4u*)(lds + WK_OFF + j * WK_RS + c8 * 2) = ok ? kv[it] : z; *(LAS v4u*)(lds + WV_OFF + j * WV_RS + c8 * 2) = ok ? vv[it] : z; } }
    __syncthreads();
    const float slope = exp2f(-(float)(hq + 1)), sk = sink8[hq];
    const bool edge = (c == 0) || (c == T / 128 - 1);
#pragma unroll
    for (int tt = 0; tt < 2; ++tt) {
        const int qt = 2 * (wave & 1) + tt; const int t = 128 * c + 32 * qt + r; const size_t m = (size_t)b * T + t;
        bf16* mp = MIX + m * NMIX + X_GA + hq * 64;
        v2u gv[2][4];
#pragma unroll
        for (int dt = 0; dt < 2; ++dt)
#pragma unroll
            for (int g4 = 0; g4 < 4; ++g4) gv[dt][g4] = *(const GAS v2u*)(mp + 32 * dt + 8 * g4 + 4 * h);
        f32x16 o[2];
#pragma unroll
        for (int dt = 0; dt < 2; ++dt)
#pragma unroll
            for (int e = 0; e < 16; ++e) o[dt][e] = 0.f;
        float mrun = sk, lrun = 0.f;
        const float basef = (float)(128 + r - 4 * h);
#pragma unroll 1
        for (int kg = 0; kg < 3; ++kg) {
            f32x16 st[3];
#pragma unroll
            for (int k3 = 0; k3 < 3; ++k3) {
#pragma unroll
                for (int e = 0; e < 16; ++e) st[k3][e] = 0.f;
#pragma unroll
                for (int ks = 0; ks < 4; ++ks) { const bf16x8 a = *(const LAS bf16x8*)(lds + WK_OFF + (32 * (qt + 3 * kg + k3) + r) * WK_RS + (16 * ks + 8 * h) * 2); st[k3] = SC_MFMA(a, qf[tt][ks], st[k3]); } }
            float mx = -3e38f;
            const float kgf = basef - 96.f * (float)kg;
#pragma unroll
            for (int k3 = 0; k3 < 3; ++k3)
#pragma unroll
                for (int e = 0; e < 16; ++e) { const float dist = fabsf(kgf - (float)(32 * k3 + (e & 3) + 8 * (e >> 2)));
                    bool valid = dist <= 128.f;
                    if (edge) { const int s = 128 * (c - 1) + 32 * (qt + 3 * kg + k3) + (e & 3) + 8 * (e >> 2) + 4 * h; valid = valid && (s >= 0) && (s < T); }
                    const float val = valid ? (st[k3][e] * 0.125f - slope * dist) : -3e38f; st[k3][e] = val; mx = fmaxf(mx, val); }
            mx = fmaxf(mx, __shfl_xor(mx, 32));
            const float mnew = fmaxf(mrun, mx), alpha = __expf(mrun - mnew);
            mrun = mnew; lrun *= alpha;
#pragma unroll
            for (int dt = 0; dt < 2; ++dt)
#pragma unroll
                for (int e = 0; e < 16; ++e) o[dt][e] *= alpha;
#pragma unroll
            for (int k3 = 0; k3 < 3; ++k3)
#pragma unroll
                for (int e = 0; e < 16; ++e) { const float p = __expf(st[k3][e] - mnew); st[k3][e] = p; lrun += p; }
#pragma unroll
            for (int k3 = 0; k3 < 3; ++k3)
#pragma unroll
                for (int s2 = 0; s2 < 2; ++s2) { const bf16x8 bx = pack8(st[k3], s2);
#pragma unroll
                    for (int dt = 0; dt < 2; ++dt) { const LAS unsigned char* vp = lds + WV_OFF + (32 * (qt + 3 * kg + k3) + 16 * s2 + 4 * h + q4) * WV_RS + (32 * dt + 16 * g1 + 4 * p4) * 2;
                        const s16x4 lo = trd(vp), hi = trd(vp + 8 * WV_RS);
                        const bf16x8 a = __builtin_shufflevector(lo, hi, 0, 1, 2, 3, 4, 5, 6, 7);
                        o[dt] = SC_MFMA(a, bx, o[dt]); } }
        }
        const float inv = __builtin_amdgcn_rcpf(lrun + __shfl_xor(lrun, 32) + __expf(sk - mrun));
#pragma unroll
        for (int dt = 0; dt < 2; ++dt)
#pragma unroll
            for (int g4 = 0; g4 < 4; ++g4) { const int d = 32 * dt + 8 * g4 + 4 * h; const v2u g = gv[dt][g4];
                const float g0 = __uint_as_float(g.x << 16), g1f = __uint_as_float(g.x & 0xffff0000u), g2 = __uint_as_float(g.y << 16), g3 = __uint_as_float(g.y & 0xffff0000u);
                v2u w; w.x = cvtpk(o[dt][4 * g4] * inv * siluf_(g0), o[dt][4 * g4 + 1] * inv * siluf_(g1f)); w.y = cvtpk(o[dt][4 * g4 + 2] * inv * siluf_(g2), o[dt][4 * g4 + 3] * inv * siluf_(g3));
                *(GAS v2u*)(mp + d) = w; }
    }
    __syncthreads();
}

__device__ __forceinline__ void memattn_unit(const Ctx& C, const bf16* P, int NP, int QOFF, bf16* MIX, const bf16* MK, const bf16* MVT, int b, int hh, int tb) {
    const int tid = C.tid, wave = C.wave; int lane = C.lane; asm volatile("" : "+v"(lane));
    const int r = lane & 31, h = lane >> 5;
    LAS unsigned char* lds = C.lds;
    const size_t m = (size_t)b * T + tb * 256 + wave * 32 + r;
    bf16x8 qf[8];
#pragma unroll
    for (int ks = 0; ks < 8; ++ks) qf[ks] = *(const GAS bf16x8*)(P + m * NP + QOFF + hh * 128 + 16 * ks + 8 * h);
    { v4u kv[8], vv[8];
#pragma unroll
      for (int it = 0; it < 8; ++it) { const int u = tid + it * NTHR; kv[it] = *(const GAS v4u*)(MK + (size_t)(b * NMEM + (u >> 4)) * 512 + hh * 128 + (u & 15) * 8);
          vv[it] = *(const GAS v4u*)(MVT + (size_t)(hh * 128 + (u >> 5)) * 1024 + b * NMEM + (u & 31) * 8); }
#pragma unroll
      for (int it = 0; it < 8; ++it) { const int u = tid + it * NTHR; *(LAS v4u*)(lds + MK_OFF + (u >> 4) * MK_RS + (u & 15) * 16) = kv[it];
          v2u w0 = {vv[it].x, vv[it].y}, w1 = {vv[it].z, vv[it].w};
          *(LAS v2u*)(lds + MV_OFF + (u >> 5) * MV_RS + (u & 31) * 16) = w0; *(LAS v2u*)(lds + MV_OFF + (u >> 5) * MV_RS + (u & 31) * 16 + 8) = w1; } }
    __syncthreads();
    f32x16 st[8];
#pragma unroll
    for (int kt = 0; kt < 8; ++kt) {
#pragma unroll
        for (int e = 0; e < 16; ++e) st[kt][e] = 0.f;
#pragma unroll
        for (int ks = 0; ks < 8; ++ks) { const bf16x8 a = *(const LAS bf16x8*)(lds + MK_OFF + (32 * kt + r) * MK_RS + (16 * ks + 8 * h) * 2); st[kt] = SC_MFMA(a, qf[ks], st[kt]); } }
    bf16* mp = MIX + m * NMIX + X_GM + hh * 128;
    float mx = -3e38f;
#pragma unroll
    for (int kt = 0; kt < 8; ++kt)
#pragma unroll
        for (int e = 0; e < 16; ++e) mx = fmaxf(mx, st[kt][e]);
    mx = fmaxf(mx, __shfl_xor(mx, 32));
    float sum = 0.f;
    bf16x8 pf[8][2];
#pragma unroll
    for (int kt = 0; kt < 8; ++kt) {
#pragma unroll
        for (int e = 0; e < 16; ++e) { const float p = __expf((st[kt][e] - mx) * 0.08838834764831845f); st[kt][e] = p; sum += p; }
        pf[kt][0] = pack8(st[kt], 0); pf[kt][1] = pack8(st[kt], 1); }
    sum += __shfl_xor(sum, 32);
    const float inv = __builtin_amdgcn_rcpf(sum);
#pragma unroll
    for (int dh = 0; dh < 2; ++dh) {
        v2u gv[2][4];
#pragma unroll
        for (int d2 = 0; d2 < 2; ++d2)
#pragma unroll
            for (int g4 = 0; g4 < 4; ++g4) gv[d2][g4] = *(const GAS v2u*)(mp + 32 * (2 * dh + d2) + 8 * g4 + 4 * h);
        f32x16 o[2];
#pragma unroll
        for (int d2 = 0; d2 < 2; ++d2)
#pragma unroll
            for (int e = 0; e < 16; ++e) o[d2][e] = 0.f;
#pragma unroll
        for (int kt = 0; kt < 8; ++kt)
#pragma unroll
            for (int s2 = 0; s2 < 2; ++s2)
#pragma unroll
                for (int d2 = 0; d2 < 2; ++d2) { const LAS unsigned char* vp = lds + MV_OFF + (32 * (2 * dh + d2) + r) * MV_RS + (32 * kt + 16 * s2 + 4 * h) * 2;
                    const s16x4 lo = *(const LAS s16x4*)vp, hi = *(const LAS s16x4*)(vp + 16);
                    const bf16x8 a = __builtin_shufflevector(lo, hi, 0, 1, 2, 3, 4, 5, 6, 7);
                    o[d2] = SC_MFMA(a, pf[kt][s2], o[d2]); }
#pragma unroll
        for (int d2 = 0; d2 < 2; ++d2)
#pragma unroll
            for (int g4 = 0; g4 < 4; ++g4) { const int d = 32 * (2 * dh + d2) + 8 * g4 + 4 * h; const v2u g = gv[d2][g4];
                const float g0 = __uint_as_float(g.x << 16), g1f = __uint_as_float(g.x & 0xffff0000u), g2 = __uint_as_float(g.y << 16), g3 = __uint_as_float(g.y & 0xffff0000u);
                v2u w; w.x = cvtpk(o[d2][4 * g4] * inv * siluf_(g0), o[d2][4 * g4 + 1] * inv * siluf_(g1f)); w.y = cvtpk(o[d2][4 * g4 + 2] * inv * siluf_(g2), o[d2][4 * g4 + 3] * inv * siluf_(g3));
                *(GAS v2u*)(mp + d) = w; }
    }
    __syncthreads();
}
}

constexpr int STEPS_PER_LAYER = 6, NSTEPS = 2 + DEPTH * STEPS_PER_LAYER;

__global__ void __launch_bounds__(NTHR, 2) mk_fwd(Args args) {
    extern __shared__ __attribute__((aligned(16))) unsigned char lds_raw[];
    Ctx C;
    C.lds = (LAS unsigned char*)lds_raw;
    C.tid = threadIdx.x; C.lane = C.tid & 63; C.wave = __builtin_amdgcn_readfirstlane(C.tid >> 6);
    C.G = gridDim.x; C.bid = blockIdx.x;
    C.out = args.out; C.ws = args.ws;
    volatile LAS unsigned* MISC = (volatile LAS unsigned*)(C.lds + MISC_OFF);
    for (int u = C.tid; u < (LDS_BYTES - RING_BYTES) / 4; u += NTHR) ((LAS unsigned*)(C.lds + RING_BYTES))[u] = 0u;
    __syncthreads();
    XcdBarrier bar; bar.bar = (unsigned*)(C.ws + WS_CTL) + CW_BAR; bar.x = 0; bar.st = nullptr;
    const int lo = args.ph_lo, hi = args.ph_hi;
    if (hi - lo > 1) bar = xcd_barrier_post((unsigned*)(C.ws + WS_CTL) + CW_BAR, MISC + 8);
    int step = 0; bool run_ = false;
#define PHASE_BEGIN { int _st = step; asm volatile("" : "+s"(_st)); run_ = (_st >= lo && _st < hi); } if (run_) { { unsigned char* _w = args.ws; float* _o = args.out; asm volatile("" : "+s"(_w), "+s"(_o)); C.ws = _w; C.out = _o; \
        int _t = threadIdx.x; asm volatile("" : "+v"(_t)); C.tid = _t; C.lane = _t & 63; C.wave = __builtin_amdgcn_readfirstlane(_t >> 6); \
        gw = C.bid * NWAVES + C.wave; wscr = (LAS float*)(C.lds + C.wave * 16384); \
        P = (bf16*)(C.ws + WS_P); MIX = (bf16*)(C.ws + WS_MIX); HN = (bf16*)(C.ws + WS_HN); }
#define PHASE_END   if (step + 1 < hi) xcd_barrier(bar); } ++step;

    int gw = C.bid * NWAVES + C.wave; const int NGW = C.G * NWAVES;
    LAS float* wscr = (LAS float*)(C.lds + C.wave * 16384);
    bf16* P = (bf16*)(C.ws + WS_P); bf16* MIX = (bf16*)(C.ws + WS_MIX); bf16* HN = (bf16*)(C.ws + WS_HN);

    PHASE_BEGIN if (TEST_MASK & 1) phase_prep(C, args); PHASE_END
    PHASE_BEGIN
#pragma unroll 1
        for (int l = 0; l < DEPTH; ++l) {
            const bf16* WKV = (const bf16*)(C.ws + WS_WKV) + (size_t)l * 1024 * 1024; const bf16* MEMN = (const bf16*)(C.ws + WS_MEMN);
#if USE_PG8
            { pg8::Gemm g{MEMN, WKV, 1024, 512, 1024}; pg8::StaticOrder S; S.init(1024, 512, C.G, (C.bid + C.G - 16 * l) % C.G);
              pg8::EpiProj e{(bf16*)(C.ws + WS_MEMK) + (size_t)l * 1024 * 512, nullptr, 512, 1 << 20};
              pg8::gemm_phase<pg8::EpiProj, pg8::StaticOrder, false, true>(C.lds, g, S, e); }
            { pg8::Gemm g{WKV + (size_t)512 * 1024, MEMN, 512, 1024, 1024}; pg8::StaticOrder S; S.init(512, 1024, C.G, (C.bid + C.G - 16 * l - 8) % C.G);
              pg8::EpiProj e{(bf16*)(C.ws + WS_MEMVT) + (size_t)l * 512 * 1024, nullptr, 1024, 1 << 20};
              pg8::gemm_phase<pg8::EpiProj, pg8::StaticOrder, false, true>(C.lds, g, S, e); }
#else
            EpiStoreBf16 ek{(bf16*)(C.ws + WS_MEMK) + (size_t)l * 1024 * 512, 512};
            gemm_naive(C, MEMN, 1024, WKV, 1024, 1024, 512, 1024, (C.bid + 32 * l) % C.G, C.G, ek);
            EpiStoreBf16 ev{(bf16*)(C.ws + WS_MEMVT) + (size_t)l * 512 * 1024, 1024};
            gemm_naive(C, WKV + (size_t)512 * 1024, 1024, MEMN, 1024, 512, 1024, 1024, (C.bid + 32 * l + 128) % C.G, C.G, ev);
#endif
        }
    PHASE_END

#pragma unroll 1
    for (int l = 0; l < DEPTH; ++l) {
        const int odd = l & 1, li = l >> 1;
        PHASE_BEGIN
#if USE_PG8
            pg8::Gemm g{HN, (const bf16*)(C.ws + WS_WIN), M, odd ? NIN_O : NIN_E, 1024}; pg8::StaticOrder S; S.init(M, odd ? NIN_O : NIN_E, C.G, C.bid);
            pg8::EpiProj e{P, MIX, odd ? NP_O : NP_E, (odd ? NP_O : NP_E) / 256};
            pg8::gemm_phase<pg8::EpiProj, pg8::StaticOrder, true, true>(C.lds, g, S, e);
#else
            EpiInProj e{P, MIX, odd ? NP_O : NP_E};
            gemm_naive(C, HN, 1024, (const bf16*)(C.ws + WS_WIN), 1024, M, odd ? NIN_O : NIN_E, 1024, C.bid, C.G, e);
#endif
        PHASE_END
        PHASE_BEGIN
#if USE_MFMA_SCAN
            { scan::ScanPtrs sp{P, MIX, (bf16*)(C.ws + (odd ? WS_L_O : WS_L_E)), (float*)(C.ws + WS_LOGD), (bf16*)(C.ws + (odd ? WS_OG_O : WS_OG_E)), args.in[5], args.in[10], args.in[11], odd ? args.in[12] : args.in[6]};
              const int NHG = odd ? 4 : 2, NSC = odd ? 16 : 32;
              for (int it = C.bid; it < BATCH * NHG * NSC * 2; it += C.G) { const int dir = it & 1, sc = (it >> 1) % NSC, hg = ((it >> 1) / NSC) % NHG, b = (it >> 1) / (NSC * NHG);
                  if (odd) scan::scan_item3<1, 0>(C, sp, li, b, hg, sc, dir); else scan::scan_item3<0, 0>(C, sp, li, b, hg, sc, dir); } }
            const int nscan = 0;
#if USE_MFMA_ATTN
            if (!odd) for (int it = C.bid; it < BATCH * 2 * 32; it += C.G) { const int c = it & 31, n = (it >> 5) & 1, b = it >> 6; attn::winattn_unit(C, P, MIX, args.in[4] + li * 8, b, n, c); }
            for (int it = C.bid; it < BATCH * 4 * 16; it += C.G) { const int tb = it & 15, hh = (it >> 4) & 3, b = it >> 6;
                attn::memattn_unit(C, P, odd ? NP_O : NP_E, odd ? O_QM : E_QM, MIX, (const bf16*)(C.ws + WS_MEMK) + (size_t)l * 1024 * 512, (const bf16*)(C.ws + WS_MEMVT) + (size_t)l * 512 * 1024, b, hh, tb); }
#endif
#else
            const int nscan = odd ? 128 : 64;
#endif
            if (gw < nscan) { if (TEST_MASK & 4) { if (odd) naive_scan_item<1>(C, args.in[5], args.in[10], args.in[11], l, gw, wscr); else naive_scan_item<0>(C, args.in[5], args.in[10], args.in[11], l, gw, wscr); } }
            else {
                const int w2 = gw - nscan, NW2 = NGW - nscan;
                const int nA = (odd || USE_MFMA_ATTN) ? 0 : M * 8, nM = USE_MFMA_ATTN ? 0 : M * 4, nW = (l + 1 < DEPTH) ? win_items(l + 1) : 0;
                for (int it = w2; it < nA + nM + nW; it += NW2) {
                    if (it < nA) naive_winattn_item(C, args.in[4] + li * 8, it, wscr);
                    else if (it < nA + nM) naive_memattn_item(C, l, it - nA, wscr);
                    else win_item(C, args.in[3], args.in[9], l + 1, it - nA - nM, wscr);
                }
            }
        PHASE_END
        PHASE_BEGIN
#if USE_MFMA_SCAN
            { scan::ScanPtrs sp{P, MIX, (bf16*)(C.ws + (odd ? WS_L_O : WS_L_E)), (float*)(C.ws + WS_LOGD), (bf16*)(C.ws + (odd ? WS_OG_O : WS_OG_E)), args.in[5], args.in[10], args.in[11], odd ? args.in[12] : args.in[6]};
              if (odd) scan::scan_combine<1>(C, sp); else scan::scan_combine<0>(C, sp); }
#else
            for (int it = gw; it < M * 4; it += NGW) { if (odd) naive_gnorm_item<1>(C, args.in[12], l, it); else naive_gnorm_item<0>(C, args.in[6], l, it); }
#endif
        PHASE_END
        PHASE_BEGIN
#if USE_MFMA_SCAN
            { scan::ScanPtrs sp{P, MIX, (bf16*)(C.ws + (odd ? WS_L_O : WS_L_E)), (float*)(C.ws + WS_LOGD), (bf16*)(C.ws + (odd ? WS_OG_O : WS_OG_E)), args.in[5], args.in[10], args.in[11], odd ? args.in[12] : args.in[6]};
              const int NHG = odd ? 4 : 2, NSC = odd ? 16 : 32;
              for (int it = C.bid; it < BATCH * NHG * NSC; it += C.G) { const int sc = it % NSC, hg = (it / NSC) % NHG, b = it / (NSC * NHG);
                  if (odd) scan::scan_item3<1, 1>(C, sp, li, b, hg, sc, 0); else scan::scan_item3<0, 1>(C, sp, li, b, hg, sc, 0); } }
#endif
        PHASE_END
        PHASE_BEGIN
#if USE_PG8
            pg8::Gemm g{MIX, (const bf16*)(C.ws + WS_WOUT) + (size_t)l * 1024 * 1536, M, 1024, 1536}; pg8::StaticOrder S; S.init(M, 1024, C.G, C.bid);
            pg8::EpiResidF32 e{l == 0 ? args.in[0] : C.out, C.out};
            pg8::gemm_phase<pg8::EpiResidF32, pg8::StaticOrder, false, true>(C.lds, g, S, e);
#else
            EpiResid e{l == 0 ? args.in[0] : C.out, C.out};
            gemm_naive(C, MIX, NMIX, (const bf16*)(C.ws + WS_WOUT) + (size_t)l * 1024 * 1536, 1536, M, 1024, 1536, C.bid, C.G, e);
#endif
        PHASE_END
        PHASE_BEGIN
            if (!(TEST_MASK & 32)) {} else if (l + 1 < DEPTH) { const float* g = ((l + 1) & 1) ? args.in[8] + ((l + 1) >> 1) * D : args.in[2] + ((l + 1) >> 1) * D;
                for (int r = gw; r < M; r += NGW) rms_row_to_bf16(C.out + (size_t)r * D, g, HN + (size_t)r * D, C.lane); }
            else { for (int r = gw; r < M; r += NGW) rms_row_to_f32(C.out + (size_t)r * D, args.in[16], C.out + (size_t)r * D, C.lane); }
        PHASE_END
    }
#undef PHASE_BEGIN
#undef PHASE_END
}

extern "C" void kernel_launch(void* const* d_in, const int* in_sizes, int n_in, void* d_out, int out_size, void* d_ws, size_t ws_size, hipStream_t stream) {
    static int grid = 0;
    if (grid == 0) {
        if (n_in != 17 || out_size != M * D || ws_size < WS_END) { fprintf(stderr, "kernel_launch: unexpected shapes n_in %d out %d ws %zu\n", n_in, out_size, ws_size); grid = -1; return; }
        int dev = 0, cus = 0, per_cu = 0;
        if (hipGetDevice(&dev) != hipSuccess || hipDeviceGetAttribute(&cus, hipDeviceAttributeMultiprocessorCount, dev) != hipSuccess) { grid = -1; return; }
        if (hipFuncSetAttribute((const void*)mk_fwd, hipFuncAttributeMaxDynamicSharedMemorySize, LDS_BYTES) != hipSuccess) { fprintf(stderr, "kernel_launch: hipFuncSetAttribute failed\n"); grid = -1; return; }
        if (hipOccupancyMaxActiveBlocksPerMultiprocessor(&per_cu, (const void*)mk_fwd, NTHR, LDS_BYTES) != hipSuccess || per_cu < 1)
            fprintf(stderr, "kernel_launch: occupancy query reports %d blocks per CU\n", per_cu);
        (void)hipGetLastError();
        grid = cus;
    }
    if (grid < 0) return;
    if (hipMemsetAsync((char*)d_ws + WS_CTL, 0, CTL_ZERO_BYTES, stream) != hipSuccess) return;
    Args a{};
    for (int i = 0; i < 17; ++i) a.in[i] = (const float*)d_in[i];
    a.out = (float*)d_out; a.ws = (unsigned char*)d_ws;
#if MK_ONE_LAUNCH
    a.ph_lo = 0; a.ph_hi = NSTEPS;
    hipLaunchKernelGGL(mk_fwd, dim3(grid), dim3(NTHR), LDS_BYTES, stream, a);
#else
    for (int s = 0; s < NSTEPS; ++s) { a.ph_lo = s; a.ph_hi = s + 1; hipLaunchKernelGGL(mk_fwd, dim3(grid), dim3(NTHR), LDS_BYTES, stream, a); }
#endif
}
```
